# Optimizing an MI355X kernel written in HIP

```python
import jax
import jax.numpy as jnp
from jax import lax
import numpy as np

D_MODEL = 1024
BATCH = 8
SEQ = 4096
DEPTH = 2
DEC_BATCH = 4
DEC_SEQ = 8192
PAST_LEN = 128

N_EVEN = (DEPTH + 1) // 2
N_ODD = DEPTH // 2
D_CONV = D_MODEL // 2
D_FOURIER = D_MODEL // 2
FOURIER_GROUPS = 4
FOURIER_GROUP_DIM = D_FOURIER // FOURIER_GROUPS
D_IN_EVEN = 3 * D_CONV + D_FOURIER
HEAD_SIZE = 64
N_HEADS = D_MODEL // HEAD_SIZE
N_DIRS = 2
D_DECAY_LORA = 64
D_AAA_LORA = 64
D_GATE_LORA = 128
D_FF = 2816
CONV_WIDTH = 3
NORM_EPS = 1e-6
GN_EPS = 64e-5
L2_EPS = 1e-12

kernel_name = 'hybrid_bidir_conv_fourier_rwkv7_encoder'


def rms_norm(x, g):
    xf = x.astype(jnp.float32)
    y = xf * lax.rsqrt(jnp.mean(xf * xf, axis=-1, keepdims=True) + NORM_EPS)
    return (y * g.astype(jnp.float32)).astype(x.dtype)


def shift_prev(x):
    return jnp.pad(x[:, :-1], ((0, 0), (1, 0), (0, 0)))


def shift_next(x):
    return jnp.pad(x[:, 1:], ((0, 0), (0, 1), (0, 0)))


def dwconv_centred(x, w):
    half = CONV_WIDTH // 2
    seq = x.shape[1]
    xp = jnp.pad(x, ((0, 0), (half, half), (0, 0)))
    return sum(xp[:, j:j + seq] * w[j] for j in range(CONV_WIDTH))


def conv_fourier_mixer(h, w_in, conv_w, w_out):
    bsz, seq, _ = h.shape
    proj = h @ w_in
    gate_b, gate_c, u, f = jnp.split(proj, [D_CONV, 2 * D_CONV, 3 * D_CONV], axis=-1)
    y_conv = gate_b * dwconv_centred(gate_c * u, conv_w)
    fg = f.astype(jnp.float32).reshape(bsz, seq, FOURIER_GROUPS, FOURIER_GROUP_DIM)
    y_four = jnp.real(jnp.fft.fft2(fg, axes=(1, 3), norm='ortho'))
    y_four = y_four.reshape(bsz, seq, D_FOURIER).astype(h.dtype)
    return jnp.concatenate([y_conv, y_four], axis=-1) @ w_out


def wkv7_step(state, inp):
    r, decay, k, v, a, b = inp
    sa = jnp.einsum('zbhij,zbhj->zbhi', state, a)
    state = state * decay[..., None, :] + sa[..., :, None] * b[..., None, :] + v[..., :, None] * k[..., None, :]
    y = jnp.einsum('zbhij,zbhj->zbhi', state, r)
    return state, y


def time_major(z):
    n_dir, bsz, seq, _ = z.shape
    z = jnp.stack([z[0], jnp.flip(z[1], axis=1)]).astype(jnp.float32)
    return jnp.moveaxis(z.reshape(n_dir, bsz, seq, N_HEADS, HEAD_SIZE), 2, 0)


def both_dirs(z):
    return jnp.stack([z, z])


def rwkv7_bidir_mixer(h, mu, mu_dir, w_r, w_k, w_v, w_o, w0, w1, w2, a0, a1, a2, g1, g2, k_k, k_a, r_k, gn_w, gn_b):
    bsz, seq, _ = h.shape
    prev, nxt = shift_prev(h), shift_next(h)
    xx_c = 0.5 * (prev + nxt) - h
    r = (h + xx_c * mu[0]) @ w_r
    k = (h + xx_c * mu[1]) @ w_k
    v = (h + xx_c * mu[2]) @ w_v
    g = jax.nn.sigmoid((h + xx_c * mu[3]) @ g1) @ g2
    xx_d = jnp.stack([prev - h, nxt - h])
    xw = h + xx_d * mu_dir[:, 0, None, None, :]
    xa = h + xx_d * mu_dir[:, 1, None, None, :]
    w_lora = jnp.einsum('zbtr,zrd->zbtd', jnp.tanh(jnp.einsum('zbtd,zdr->zbtr', xw, w1)), w2)
    log_w = -jax.nn.softplus(-(w0[:, None, None, :] + w_lora).astype(jnp.float32)) - 0.5
    decay = jnp.exp(-jnp.exp(log_w))
    a = jax.nn.sigmoid(a0[:, None, None, :] + jnp.einsum('zbtr,zrd->zbtd', jnp.einsum('zbtd,zdr->zbtr', xa, a1), a2))
    kk = (k * k_k).astype(jnp.float32).reshape(bsz, seq, N_HEADS, HEAD_SIZE)
    kk = (kk / jnp.maximum(jnp.linalg.norm(kk, axis=-1, keepdims=True), L2_EPS)).reshape(bsz, seq, D_MODEL)
    k_dir = k * (1.0 + (a - 1.0) * k_a)
    scan_in = (time_major(both_dirs(r)), time_major(decay), time_major(k_dir),
               time_major(both_dirs(v)), time_major(both_dirs(-kk)), time_major(kk * a))
    state0 = jnp.zeros((N_DIRS, bsz, N_HEADS, HEAD_SIZE, HEAD_SIZE), jnp.float32)
    _, ys = lax.scan(wkv7_step, state0, scan_in)
    ys = jnp.moveaxis(ys, 0, 2)
    y = ys[0] + jnp.flip(ys[1], axis=1)
    mean = jnp.mean(y, axis=-1, keepdims=True)
    var = jnp.mean(jnp.square(y - mean), axis=-1, keepdims=True)
    y = ((y - mean) * lax.rsqrt(var + GN_EPS)).reshape(bsz, seq, D_MODEL) * gn_w.astype(jnp.float32) + gn_b.astype(jnp.float32)
    r_h = r.astype(jnp.float32).reshape(bsz, seq, N_HEADS, HEAD_SIZE)
    k_h = k_dir.astype(jnp.float32).reshape(N_DIRS, bsz, seq, N_HEADS, HEAD_SIZE)
    v_h = v.astype(jnp.float32).reshape(bsz, seq, N_HEADS, HEAD_SIZE)
    bonus = jnp.sum(r_h * k_h * r_k.astype(jnp.float32), axis=(0, -1))[..., None] * v_h
    y = (y + bonus.reshape(bsz, seq, D_MODEL)).astype(h.dtype)
    return (y * g) @ w_o


def conv_glu_ffn(h, w_up, conv_w, conv_b, w_down):
    u = dwconv_centred(h @ w_up, conv_w) + conv_b
    gate, val = jnp.split(u, 2, axis=-1)
    return (jax.nn.silu(gate) * val) @ w_down


def encoder_trunk(x, p):
    for layer in range(DEPTH):
        i = layer // 2
        h = rms_norm(x, p['norm_mix'][layer])
        if layer % 2 == 0:
            x = x + conv_fourier_mixer(h, p['cf_w_in'][i], p['cf_conv'][i], p['cf_w_out'][i])
        else:
            x = x + rwkv7_bidir_mixer(
                h, p['rw_mu'][i], p['rw_mu_dir'][i], p['rw_w_r'][i], p['rw_w_k'][i], p['rw_w_v'][i],
                p['rw_w_o'][i], p['rw_w0'][i], p['rw_w1'][i], p['rw_w2'][i], p['rw_a0'][i], p['rw_a1'][i],
                p['rw_a2'][i], p['rw_g1'][i], p['rw_g2'][i], p['rw_k_k'][i], p['rw_k_a'][i], p['rw_r_k'][i],
                p['rw_gn_w'][i], p['rw_gn_b'][i])
        h = rms_norm(x, p['norm_ffn'][layer])
        x = x + conv_glu_ffn(h, p['ffn_w_up'][layer], p['ffn_conv'][layer], p['ffn_conv_b'][layer], p['ffn_w_down'][layer])
    return rms_norm(x, p['norm_final'])


def setup_inputs(seed: int = 0) -> dict:
    key = jax.random.key(seed)
    ks = iter(jax.random.split(key, 32))
    f32 = jnp.float32
    D = D_MODEL

    def nrm(shape, scale):
        return jax.random.normal(next(ks), shape, f32) * scale

    def unif(shape, lo, hi):
        return jax.random.uniform(next(ks), shape, f32, lo, hi)

    return {
        'x_prompt': nrm((BATCH, SEQ, D), 1.0),
        'x_sample': nrm((DEC_BATCH, DEC_SEQ, D), 1.0),
        'norm_mix': 1.0 + nrm((DEPTH, D), 0.02),
        'norm_ffn': 1.0 + nrm((DEPTH, D), 0.02),
        'norm_final': 1.0 + nrm((D,), 0.02),
        'cf_w_in': nrm((N_EVEN, D, D_IN_EVEN), D ** -0.5),
        'cf_conv': nrm((N_EVEN, CONV_WIDTH, D_CONV), CONV_WIDTH ** -0.5),
        'cf_w_out': nrm((N_EVEN, D, D), D ** -0.5),
        'rw_mu': unif((N_ODD, 4, D), 0.0, 1.0),
        'rw_mu_dir': unif((N_ODD, N_DIRS, 2, D), 0.0, 1.0),
        'rw_w_r': nrm((N_ODD, D, D), D ** -0.5),
        'rw_w_k': nrm((N_ODD, D, D), D ** -0.5),
        'rw_w_v': nrm((N_ODD, D, D), D ** -0.5),
        'rw_w_o': nrm((N_ODD, D, D), D ** -0.5),
        'rw_w0': unif((N_ODD, N_DIRS, D), -6.0, -1.0),
        'rw_w1': nrm((N_ODD, N_DIRS, D, D_DECAY_LORA), D ** -0.5),
        'rw_w2': nrm((N_ODD, N_DIRS, D_DECAY_LORA, D), 0.5 * D_DECAY_LORA ** -0.5),
        'rw_a0': nrm((N_ODD, N_DIRS, D), 0.1),
        'rw_a1': nrm((N_ODD, N_DIRS, D, D_AAA_LORA), D ** -0.5),
        'rw_a2': nrm((N_ODD, N_DIRS, D_AAA_LORA, D), 0.5 * D_AAA_LORA ** -0.5),
        'rw_g1': nrm((N_ODD, D, D_GATE_LORA), D ** -0.5),
        'rw_g2': nrm((N_ODD, D_GATE_LORA, D), D_GATE_LORA ** -0.5),
        'rw_k_k': 0.85 + nrm((N_ODD, D), 0.02),
        'rw_k_a': 1.0 + nrm((N_ODD, D), 0.02),
        'rw_r_k': nrm((N_ODD, N_HEADS, HEAD_SIZE), 0.1),
        'rw_gn_w': 1.0 + nrm((N_ODD, D), 0.02),
        'rw_gn_b': nrm((N_ODD, D), 0.02),
        'ffn_w_up': nrm((DEPTH, D, 2 * D_FF), D ** -0.5),
        'ffn_conv': nrm((DEPTH, CONV_WIDTH, 2 * D_FF), CONV_WIDTH ** -0.5),
        'ffn_conv_b': nrm((DEPTH, 2 * D_FF), 0.02),
        'ffn_w_down': nrm((DEPTH, D_FF, D), D_FF ** -0.5),
    }


def reference(x_prompt, x_sample, norm_mix, norm_ffn, norm_final, cf_w_in, cf_conv, cf_w_out,
              rw_mu, rw_mu_dir, rw_w_r, rw_w_k, rw_w_v, rw_w_o, rw_w0, rw_w1, rw_w2, rw_a0, rw_a1, rw_a2,
              rw_g1, rw_g2, rw_k_k, rw_k_a, rw_r_k, rw_gn_w, rw_gn_b,
              ffn_w_up, ffn_conv, ffn_conv_b, ffn_w_down):
    p = dict(norm_mix=norm_mix, norm_ffn=norm_ffn, norm_final=norm_final,
             cf_w_in=cf_w_in, cf_conv=cf_conv, cf_w_out=cf_w_out,
             rw_mu=rw_mu, rw_mu_dir=rw_mu_dir, rw_w_r=rw_w_r, rw_w_k=rw_w_k, rw_w_v=rw_w_v, rw_w_o=rw_w_o,
             rw_w0=rw_w0, rw_w1=rw_w1, rw_w2=rw_w2, rw_a0=rw_a0, rw_a1=rw_a1, rw_a2=rw_a2,
             rw_g1=rw_g1, rw_g2=rw_g2, rw_k_k=rw_k_k, rw_k_a=rw_k_a, rw_r_k=rw_r_k,
             rw_gn_w=rw_gn_w, rw_gn_b=rw_gn_b,
             ffn_w_up=ffn_w_up, ffn_conv=ffn_conv, ffn_conv_b=ffn_conv_b, ffn_w_down=ffn_w_down)
    y_prompt = encoder_trunk(x_prompt, p)
    y_sample = encoder_trunk(x_sample, p)
    return (y_prompt, y_sample)
```

```cpp
#include <hip/hip_runtime.h>
#include <hip/hip_cooperative_groups.h>
#include <cstdio>
namespace cg = cooperative_groups;

#ifndef PROBE_DUP
#define PROBE_DUP 0
#define PROBE_LO 0
#define PROBE_HI 0
#endif
#ifndef MK_PER_PHASE
#define MK_PER_PHASE 0
#endif

#ifndef TESTMASK
#define TESTMASK 0xFFFFFFF
#endif
#define TM(k) ((TESTMASK >> (k)) & 1)
#define LAS __attribute__((address_space(3)))
typedef unsigned short u16;
typedef short bf16x8 __attribute__((ext_vector_type(8)));
typedef float f32x4 __attribute__((ext_vector_type(4)));
typedef unsigned u32x4 __attribute__((ext_vector_type(4)));
typedef unsigned u32x2 __attribute__((ext_vector_type(2)));

__device__ __forceinline__ int opaque_tid() { int t = threadIdx.x; asm volatile("" : "+v"(t)); return t; }
constexpr int LDS_BYTES = 160 * 1024;
constexpr int LDS_TAB = LDS_BYTES - 512;
__device__ __forceinline__ const float* in_ptr(LAS unsigned char* lds, int i) {
    const LAS unsigned* t = (const LAS unsigned*)(lds + LDS_TAB) + 2 * i; const unsigned lo = __builtin_amdgcn_readfirstlane(t[0]), hi = __builtin_amdgcn_readfirstlane(t[1]);
    return (const float*)(((unsigned long long)hi << 32) | lo); }
#define IN(i) in_ptr(lds, (i))
constexpr size_t MiB = 1ull << 20;
constexpr int HT = 32768;
constexpr size_t OFF_WC = 0;
constexpr size_t OFF_WF = OFF_WC + 1536ull * 1024 * 2;
constexpr size_t OFF_WEFF = OFF_WF + 512ull * 1024 * 2;
constexpr size_t OFF_DFTA = OFF_WEFF + 1024ull * 1536 * 2;
constexpr size_t OFF_WUP = OFF_DFTA + 512ull * 512 * 2;
constexpr size_t OFF_WDN = OFF_WUP + 2ull * 5632 * 1024 * 2;
constexpr size_t OFF_WRKV = OFF_WDN + 2ull * 1024 * 2816 * 2;
constexpr size_t OFF_WLORA = OFF_WRKV + 3072ull * 1024 * 2;
constexpr size_t OFF_WRKV_END = OFF_WRKV + 3072ull * 2048 * 2;
constexpr size_t OFF_WUP2 = OFF_WRKV_END + 768ull * 1024 * 2;
constexpr size_t OFF_WG2 = OFF_WUP2 + 4096ull * 256 * 2;
constexpr size_t OFF_WO = OFF_WG2 + 1024ull * 256 * 2;
constexpr size_t OFF_WEND = OFF_WO + 1024ull * 1024 * 2;
static_assert(OFF_WEND <= 60 * MiB, "weights region");
constexpr size_t OFF_X = 64 * MiB;
constexpr size_t OFF_R0 = 192 * MiB;
constexpr size_t WS_NEED = 512 * MiB;
constexpr size_t OFF_H = OFF_R0;
constexpr size_t OFF_YP = OFF_R0;
constexpr size_t OFF_CAT = OFF_R0 + 128 * MiB;
constexpr size_t OUT_PROJ = 0;
constexpr size_t OUT_FT = 192 * MiB;
constexpr size_t OFF_U = OFF_R0 + 128 * MiB;
constexpr size_t OUT_ACT = 0;
constexpr size_t OFF_HH = OFF_R0;
constexpr size_t OUT_RKV = 0;
constexpr size_t OUT_P = 192 * MiB;
constexpr size_t OUT_Y = 192 * MiB;
constexpr size_t OFF_D4 = OFF_R0;
constexpr size_t OFF_L = OFF_R0 + 256 * MiB;
constexpr size_t OFF_LG = OFF_R0 + 272 * MiB;
constexpr size_t OFF_INV = OFF_R0 + 288 * MiB;
constexpr size_t OFF_BON = OFF_R0 + 290 * MiB;
constexpr size_t OFF_G = OFF_R0;
constexpr size_t OFF_YG = OFF_R0 + 64 * MiB;

constexpr size_t OFF_HSLOT = 60 * MiB;
constexpr size_t OFF_BAR = 59 * MiB;
struct P { const float* in[31]; float* out; unsigned char* ws; int ph_lo, ph_hi; };

__device__ __forceinline__ float bflo(unsigned w) { return __uint_as_float(w << 16); }
__device__ __forceinline__ float bfhi(unsigned w) { return __uint_as_float(w & 0xffff0000u); }
__device__ __forceinline__ float bf2f(u16 v) { return __uint_as_float((unsigned)v << 16); }
__device__ __forceinline__ unsigned pk2(float lo, float hi) { unsigned r; asm("v_cvt_pk_bf16_f32 %0, %1, %2" : "=v"(r) : "v"(lo), "v"(hi)); return r; }
__device__ __forceinline__ u16 f2bf(float v) { return (u16)(pk2(v, 0.f) & 0xffffu); }
__device__ __forceinline__ u32x4 pk8(const float* v) { u32x4 o; o.x = pk2(v[0], v[1]); o.y = pk2(v[2], v[3]); o.z = pk2(v[4], v[5]); o.w = pk2(v[6], v[7]); return o; }
__device__ __forceinline__ void unpk8(u32x4 w, float* v) { v[0] = bflo(w.x); v[1] = bfhi(w.x); v[2] = bflo(w.y); v[3] = bfhi(w.y); v[4] = bflo(w.z); v[5] = bfhi(w.z); v[6] = bflo(w.w); v[7] = bfhi(w.w); }
#define DPP_ADD(v, ctrl) v += __int_as_float(__builtin_amdgcn_update_dpp(0, __float_as_int(v), ctrl, 0xF, 0xF, true))
__device__ __forceinline__ float allreduce16(float v) { DPP_ADD(v, 0xB1); DPP_ADD(v, 0x4E); DPP_ADD(v, 0x141); DPP_ADD(v, 0x140); return v; }
__device__ __forceinline__ float wave_sum(float v) {
    v = allreduce16(v);
    const float a = __int_as_float(__builtin_amdgcn_readlane(__float_as_int(v), 0)), b = __int_as_float(__builtin_amdgcn_readlane(__float_as_int(v), 16)),
                c = __int_as_float(__builtin_amdgcn_readlane(__float_as_int(v), 32)), d = __int_as_float(__builtin_amdgcn_readlane(__float_as_int(v), 48));
    return (a + b) + (c + d); }
__device__ __forceinline__ float allreduce4(float v) { DPP_ADD(v, 0xB1); DPP_ADD(v, 0x4E); return v; }
__device__ __forceinline__ float sigmoidf_(float x) { return __builtin_amdgcn_rcpf(1.f + __expf(-x)); }
__device__ __forceinline__ int seqT(int t) { return t < HT ? 4096 : 8192; }

#define XB_XCNT(j)  (256  + 64 * (j))
#define XB_XSUB(j)  (1280 + 64 * (j))
#define XB_XGEN(j)  (2304 + 64 * (j))
#define XB_TOP      3328
#define XB_TOPGEN   3392
#define XCD_BAR_WORDS 3456
__device__ __forceinline__ unsigned xb_ld(unsigned* p)              { return __hip_atomic_load(p, __ATOMIC_RELAXED, __HIP_MEMORY_SCOPE_AGENT); }
__device__ __forceinline__ unsigned xb_add(unsigned* p, unsigned v) { return __hip_atomic_fetch_add(p, v, __ATOMIC_RELAXED, __HIP_MEMORY_SCOPE_AGENT); }
__device__ __forceinline__ unsigned xb_xcc_id() { return (unsigned)__builtin_amdgcn_s_getreg((3 << 11) | 20) & 0xFu; }
__device__ __forceinline__ void grid_bar(unsigned* bar, volatile LAS unsigned* st) {
    asm volatile("s_waitcnt vmcnt(0)" ::: "memory");
    __syncthreads();
    if (threadIdx.x == 0) {
        __builtin_amdgcn_s_waitcnt(0);
        const unsigned x = xb_xcc_id();
        unsigned nloc = st[0], nx = st[1]; const unsigned gen = st[2]; st[2] = gen + 1u;
        if (nloc == 0u) {
            for (;;) { unsigned sum = 0u, cnt = 0u, mine = 0u;
#pragma unroll 1
                for (unsigned j = 0; j < 16; ++j) { const unsigned c = xb_ld(&bar[XB_XCNT(j)]); sum += c; cnt += (c > 0u) ? 1u : 0u; mine = (j == x) ? c : mine; }
                if (sum == gridDim.x) { nloc = mine; nx = cnt; break; }
                __builtin_amdgcn_s_sleep(1); }
            st[0] = nloc; st[1] = nx; }
        const unsigned old = xb_add(&bar[XB_XSUB(x)], 1u);
        if (old + 1u == (gen + 1u) * nloc) {
            __builtin_amdgcn_fence(__ATOMIC_RELEASE, "agent");
            asm volatile("s_waitcnt vmcnt(0)" ::: "memory");
            const unsigned og = xb_add(&bar[XB_TOP], 1u);
            if (og + 1u == (gen + 1u) * nx) xb_add(&bar[XB_TOPGEN], 1u);
            else while (xb_ld(&bar[XB_TOPGEN]) == gen) __builtin_amdgcn_s_sleep(1);
            __builtin_amdgcn_fence(__ATOMIC_ACQUIRE, "agent");
            xb_add(&bar[XB_XGEN(x)], 1u);
            asm volatile("s_waitcnt vmcnt(0)" ::: "memory");
        } else {
            while (xb_ld(&bar[XB_XGEN(x)]) == gen) __builtin_amdgcn_s_sleep(1);
            __builtin_amdgcn_fence(__ATOMIC_ACQUIRE, "agent");
            asm volatile("s_waitcnt vmcnt(0)" ::: "memory");
        }
    }
    __syncthreads();
}
constexpr int HTB = 128 * 64 * 2;
__device__ __forceinline__ int lds_byte(int r, int c) { const int st = (r >> 4) * 2 + (c >> 5), rr = r & 15, cc = c & 31, ob = rr * 64 + cc * 2; return st * 1024 + (ob ^ (((ob >> 9) & 1) << 5)); }
__device__ __forceinline__ void stage_rc(int b, int& R, int& C) { const int st = b / 1024, sb = b % 1024, swz = sb ^ (((sb >> 9) & 1) << 5); R = (st >> 1) * 16 + swz / 64; C = (st & 1) * 32 + (swz % 64) / 2; }
__device__ __forceinline__ int perm32(int rho) { const int n = rho >> 4, i = rho & 15; return 8 * (i >> 2) + 4 * n + (i & 3); }
struct Unit { int pm, pn; };
__device__ __forceinline__ bool next_unit(int i, int nM, int nN, Unit& u) {
    const int nwg = nM * nN; const long L = (long)i * (long)gridDim.x + blockIdx.x; if (L >= nwg) return false;
    int wgid = (int)L; { const int q = nwg / 8, r = nwg % 8, xcd = wgid % 8, off = wgid / 8; wgid = (xcd < r ? xcd * (q + 1) : r * (q + 1) + (xcd - r) * q) + off; }
    const int nig = 8 * nN, gid = wgid / nig, fm = gid * 8, gsz = (nM - fm) < 8 ? (nM - fm) : 8;
    u.pm = fm + ((wgid % nig) % gsz); u.pn = (wgid % nig) / gsz; return true;
}

template <class Epi>
__device__ __forceinline__ void gemm_phase(LAS unsigned char* lds, const u16* A, int lda, const u16* Bt, int ldb, int nM, int nN, int K, const Epi& E, int ashift = 31, size_t astride = 0) {
    int tid = opaque_tid();
    const int wid = __builtin_amdgcn_readfirstlane(tid >> 6), lane = tid & 63, wr = wid >> 2, wc = wid & 3, fr = lane & 15, fq = lane >> 4;
    const int nt = K / 64;
    unsigned voffA[2], voffB[2];
#pragma unroll
    for (int i = 0; i < 2; ++i) { int R, C; stage_rc(tid * 16 + i * 8192, R, C); const int Rb = (R & ~31) + perm32(R & 31);
        voffA[i] = (unsigned)(R * lda + C) * 2u; voffB[i] = (unsigned)(Rb * ldb + C) * 2u; }
    const size_t kstep = 128;
    const size_t hstepA = (size_t)128 * lda * 2, hstepB = (size_t)128 * ldb * 2, tstepA = 2 * hstepA, tstepB = 2 * hstepB;
    const unsigned ldsw = (unsigned)wid * 1024u;
    const int aoff = lds_byte(wr * 64 + fr, fq * 8), boff = lds_byte(wc * 32 + fr, fq * 8);
#define G_SA(b, h) (((b) * 2 + (h)) * HTB)
#define G_SB(b, h) ((4 + (b) * 2 + (h)) * HTB)
#define G_STAGE(bufoff, gbase, voff) do { _Pragma("unroll") for (int _i = 0; _i < 2; ++_i) \
        __builtin_amdgcn_global_load_lds((const unsigned*)((const char*)(gbase) + (voff)[_i]), (LAS unsigned*)(lds + (bufoff) + ldsw + _i * 8192), 16, 0, 0); } while (0)
#define G_LDA(dst, b, h) do { _Pragma("unroll") for (int m = 0; m < 4; ++m) _Pragma("unroll") for (int k = 0; k < 2; ++k) dst[m][k] = *(const LAS bf16x8*)(lds + G_SA(b, h) + aoff + m * 2048 + k * 1024); } while (0)
#define G_LDB(dst, b, h) do { _Pragma("unroll") for (int n = 0; n < 2; ++n) _Pragma("unroll") for (int k = 0; k < 2; ++k) dst[n][k] = *(const LAS bf16x8*)(lds + G_SB(b, h) + boff + n * 2048 + k * 1024); } while (0)
#define G_MMA(ai, bj, At, Bt_) do { __builtin_amdgcn_s_setprio(1); _Pragma("unroll") for (int m = 0; m < 4; ++m) _Pragma("unroll") for (int n = 0; n < 2; ++n) _Pragma("unroll") for (int k = 0; k < 2; ++k) \
        acc[ai][bj][m][n] = __builtin_amdgcn_mfma_f32_16x16x32_bf16(Bt_[n][k], At[m][k], acc[ai][bj][m][n], 0, 0, 0); __builtin_amdgcn_s_setprio(0); } while (0)
#define G_WAIT_V(n) asm volatile("s_waitcnt vmcnt(" #n ")" ::: "memory")
#define G_WAIT_L(n) asm volatile("s_waitcnt lgkmcnt(" #n ")" ::: "memory")
#define G_BAR __builtin_amdgcn_s_barrier()
#define G_SCHED __builtin_amdgcn_sched_barrier(0)
    Unit cur, nxt; int ui = 0;
    if (!next_unit(0, nM, nN, cur)) return;
    f32x4 acc[2][2][4][2];
#pragma unroll
    for (int a = 0; a < 2; ++a)
#pragma unroll
        for (int b = 0; b < 2; ++b)
#pragma unroll
            for (int m = 0; m < 4; ++m)
#pragma unroll
                for (int n = 0; n < 2; ++n) acc[a][b][m][n] = (f32x4){0.f, 0.f, 0.f, 0.f};
    bf16x8 At[4][2], B0[2][2], B1[2][2];
    const char* cA = (const char*)A + (size_t)(cur.pn >> ashift) * astride + (size_t)cur.pm * tstepA; const char* cB = (const char*)Bt + (size_t)cur.pn * tstepB;
    G_STAGE(G_SB(0, 0), cB, voffB); G_STAGE(G_SA(0, 0), cA, voffA); G_STAGE(G_SB(0, 1), cB + hstepB, voffB); G_STAGE(G_SA(0, 1), cA + hstepA, voffA);
    if (wr == 1) G_BAR;
    G_WAIT_V(4); G_BAR;
    G_STAGE(G_SB(1, 0), cB + kstep, voffB); G_STAGE(G_SA(1, 0), cA + kstep, voffA); G_STAGE(G_SB(1, 1), cB + hstepB + kstep, voffB);
    G_WAIT_V(6); G_BAR;
    for (;;) {
        const bool has_next = next_unit(ui + 1, nM, nN, nxt);
        const char* nA = has_next ? (const char*)A + (size_t)(nxt.pn >> ashift) * astride + (size_t)nxt.pm * tstepA : cA; const char* nB = has_next ? (const char*)Bt + (size_t)nxt.pn * tstepB : cB;
        for (int t = 0; t < nt; t += 2) {
            const bool last = (t == nt - 2);
            const char* a1 = cA + (size_t)(t + 1) * kstep;
            const char* a2 = last ? nA : cA + (size_t)(t + 2) * kstep; const char* b2 = last ? nB : cB + (size_t)(t + 2) * kstep;
            const char* a3 = a2 + kstep; const char* b3 = b2 + kstep;
            G_LDB(B0, 0, 0); G_SCHED; G_LDA(At, 0, 0); G_STAGE(G_SA(1, 1), a1 + hstepA, voffA);
            G_WAIT_L(8); G_BAR; G_WAIT_L(0); G_MMA(0, 0, At, B0); G_BAR; G_SCHED;
            G_LDB(B1, 0, 1); G_STAGE(G_SB(0, 0), b2, voffB);
            G_BAR; G_WAIT_L(0); G_MMA(0, 1, At, B1); G_BAR;
            G_LDA(At, 0, 1); G_STAGE(G_SA(0, 0), a2, voffA);
            G_BAR; G_WAIT_L(0); G_MMA(1, 0, At, B0); G_BAR; G_SCHED;
            G_STAGE(G_SB(0, 1), b2 + hstepB, voffB);
            G_WAIT_V(6); G_BAR; G_MMA(1, 1, At, B1); G_BAR;
            G_LDB(B0, 1, 0); G_SCHED; G_LDA(At, 1, 0); G_STAGE(G_SA(0, 1), a2 + hstepA, voffA);
            G_WAIT_L(8); G_BAR; G_WAIT_L(0); G_MMA(0, 0, At, B0); G_BAR; G_SCHED;
            G_LDB(B1, 1, 1); G_STAGE(G_SB(1, 0), b3, voffB);
            G_BAR; G_WAIT_L(0); G_MMA(0, 1, At, B1); G_BAR;
            G_LDA(At, 1, 1); G_STAGE(G_SA(1, 0), a3, voffA);
            G_BAR; G_WAIT_L(0); G_MMA(1, 0, At, B0); G_BAR; G_SCHED;
            G_STAGE(G_SB(1, 1), b3 + hstepB, voffB);
            G_WAIT_V(6); G_BAR; G_MMA(1, 1, At, B1); G_BAR;
        }
        {
            const int row0 = cur.pm * 256 + wr * 64 + fr, col0 = cur.pn * 256 + wc * 32 + 8 * fq;
            if constexpr (Epi::PRE == 1) {
#pragma unroll
                for (int ai = 0; ai < 2; ++ai) { u32x4 pre[8];
#pragma unroll
                    for (int m = 0; m < 4; ++m)
#pragma unroll
                        for (int bj = 0; bj < 2; ++bj) pre[m * 2 + bj] = E.pre(row0 + ai * 128 + m * 16, col0 + bj * 128);
#pragma unroll
                    for (int m = 0; m < 4; ++m)
#pragma unroll
                        for (int bj = 0; bj < 2; ++bj) E.store(row0 + ai * 128 + m * 16, col0 + bj * 128, acc[ai][bj][m][0], acc[ai][bj][m][1], pre[m * 2 + bj]); } }
            else if constexpr (Epi::PRE == 2) {
#pragma unroll
                for (int bj = 0; bj < 2; ++bj) { f32x4 cb0, cb1; E.cpre(col0 + bj * 128, cb0, cb1);
#pragma unroll
                    for (int ai = 0; ai < 2; ++ai)
#pragma unroll
                        for (int m = 0; m < 4; ++m) E.store(row0 + ai * 128 + m * 16, col0 + bj * 128, acc[ai][bj][m][0], acc[ai][bj][m][1], cb0, cb1); } }
            else if constexpr (Epi::PRE == 3) {
#pragma unroll
                for (int ai = 0; ai < 2; ++ai)
#pragma unroll
                    for (int mp = 0; mp < 2; ++mp) { f32x4 pa[4], pb[4];
#pragma unroll
                        for (int mm = 0; mm < 2; ++mm)
#pragma unroll
                            for (int bj = 0; bj < 2; ++bj) E.pre2(row0 + ai * 128 + (2 * mp + mm) * 16, col0 + bj * 128, pa[mm * 2 + bj], pb[mm * 2 + bj]);
#pragma unroll
                        for (int mm = 0; mm < 2; ++mm)
#pragma unroll
                            for (int bj = 0; bj < 2; ++bj) E.store(row0 + ai * 128 + (2 * mp + mm) * 16, col0 + bj * 128, acc[ai][bj][2 * mp + mm][0], acc[ai][bj][2 * mp + mm][1], pa[mm * 2 + bj], pb[mm * 2 + bj]); } }
            else {
#pragma unroll
                for (int ai = 0; ai < 2; ++ai)
#pragma unroll
                    for (int m = 0; m < 4; ++m)
#pragma unroll
                        for (int bj = 0; bj < 2; ++bj) E.store(row0 + ai * 128 + m * 16, col0 + bj * 128, acc[ai][bj][m][0], acc[ai][bj][m][1]); }
        }
        if (!has_next) break;
#pragma unroll
        for (int a = 0; a < 2; ++a)
#pragma unroll
            for (int b = 0; b < 2; ++b)
#pragma unroll
                for (int m = 0; m < 4; ++m)
#pragma unroll
                    for (int n = 0; n < 2; ++n) acc[a][b][m][n] = (f32x4){0.f, 0.f, 0.f, 0.f};
        cur = nxt; cA = nA; cB = nB; ++ui;
    }
    G_WAIT_V(0);
    if (wr == 0) G_BAR;
    G_BAR;
#undef G_SA
#undef G_SB
#undef G_STAGE
#undef G_LDA
#undef G_LDB
#undef G_MMA
#undef G_WAIT_V
#undef G_WAIT_L
#undef G_BAR
#undef G_SCHED
}

__device__ __forceinline__ u32x4 pkv(f32x4 v0, f32x4 v1) { u32x4 w; w.x = pk2(v0.x, v0.y); w.y = pk2(v0.z, v0.w); w.z = pk2(v1.x, v1.y); w.w = pk2(v1.z, v1.w); return w; }
struct EpiPlain { static constexpr int PRE = 0; u16* O; size_t ld;
    __device__ __forceinline__ void store(int row, int col, f32x4 v0, f32x4 v1) const { *(u32x4*)(O + (size_t)row * ld + col) = pkv(v0, v1); } };
struct EpiSplit { static constexpr int PRE = 0; u16* O; size_t stride;
    __device__ __forceinline__ void store(int row, int col, f32x4 v0, f32x4 v1) const { const int t = col >> 10; *(u32x4*)(O + (size_t)t * stride + (size_t)row * 1024 + (col & 1023)) = pkv(v0, v1); } };
struct EpiRkvP { static constexpr int PRE = 0; u16* O; size_t stride; u16* Pb;
    __device__ __forceinline__ void store(int row, int col, f32x4 v0, f32x4 v1) const { const int t = col >> 10;
        u16* dst = (t < 3) ? O + (size_t)t * stride + (size_t)row * 1024 + (col & 1023) : Pb + (size_t)row * 768 + (col - 3072);
        *(u32x4*)dst = pkv(v0, v1); } };
struct EpiDft { static constexpr int PRE = 0; u16* CAT;
    __device__ __forceinline__ void store(int row, int col, f32x4 v0, f32x4 v1) const {
        const int ri = row >> 8, k1 = row & 255; int tok;
        if (col < 65536) { const int b = col >> 13, k2 = (col >> 9) & 15; tok = b * 4096 + k1 * 16 + k2; }
        else { const int n2 = col - 65536; const int b = n2 >> 14, k2 = (n2 >> 9) & 31; tok = HT + b * 8192 + k1 * 32 + k2; }
        const int ch = col & 511;
        *(u32x4*)(CAT + (size_t)tok * 1536 + 512 + ri * 512 + ch) = pkv(v0, v1); } };
struct EpiOut0 { static constexpr int PRE = 3; const float* xp; const float* xs; u16* X;
    __device__ __forceinline__ void pre2(int row, int col, f32x4& a, f32x4& b) const {
        const float* src = (row < HT ? xp + (size_t)row * 1024 : xs + (size_t)(row - HT) * 1024) + col; a = *(const f32x4*)src; b = *(const f32x4*)(src + 4); }
    __device__ __forceinline__ void store(int row, int col, f32x4 v0, f32x4 v1, f32x4 a, f32x4 b) const { *(u32x4*)(X + (size_t)row * 1024 + col) = pkv(a + v0, b + v1); } };
struct EpiResid { static constexpr int PRE = 1; u16* X;
    __device__ __forceinline__ u32x4 pre(int row, int col) const { return *(const u32x4*)(X + (size_t)row * 1024 + col); }
    __device__ __forceinline__ void store(int row, int col, f32x4 v0, f32x4 v1, u32x4 w) const {
        f32x4 a = {bflo(w.x), bfhi(w.x), bflo(w.y), bfhi(w.y)}, b = {bflo(w.z), bfhi(w.z), bflo(w.w), bfhi(w.w)};
        *(u32x4*)(X + (size_t)row * 1024 + col) = pkv(a + v0, b + v1); } };
struct EpiUp2 { static constexpr int PRE = 2; u16* D4; const float* w0; const float* a0;
    __device__ __forceinline__ void cpre(int col, f32x4& b0, f32x4& b1) const { const int gi = col >> 10, c = col & 1023; const float* bias = (gi < 2 ? w0 + gi * 1024 : a0 + (gi - 2) * 1024) + c; b0 = *(const f32x4*)bias; b1 = *(const f32x4*)(bias + 4); }
    __device__ __forceinline__ void store(int row, int col, f32x4 v0, f32x4 v1, f32x4 b0, f32x4 b1) const {
        const int gi = col >> 10, c = col & 1023; const float sc = gi < 2 ? -0.60653066f : 1.f; f32x4 x0 = v0 + b0, x1 = v1 + b1;
#pragma unroll
        for (int j = 0; j < 4; ++j) { x0[j] = sc * __builtin_amdgcn_rcpf(1.f + __expf(-x0[j])); x1[j] = sc * __builtin_amdgcn_rcpf(1.f + __expf(-x1[j])); }
        *(u32x4*)(D4 + (size_t)gi * ((size_t)HT * 1024) + (size_t)row * 1024 + c) = pkv(x0, x1); } };
struct Job { const float* src; const float* vec; u16* dst; int ldsrc, lddst, K, N; float c0, c1; };
__device__ __forceinline__ bool get_job(unsigned char* ws, unsigned char* ob, LAS unsigned char* lds, int j, Job& jb) {
    jb.vec = nullptr; jb.c0 = 1.f; jb.c1 = 0.f;
    if (j == 0) { jb.src = IN(5); jb.ldsrc = 2048; jb.dst = (u16*)(ws + OFF_WC); jb.lddst = 1024; jb.K = 1024; jb.N = 1536; return true; }
    if (j == 1) { jb.src = IN(5) + 1536; jb.ldsrc = 2048; jb.dst = (u16*)(ws + OFF_WF); jb.lddst = 1024; jb.K = 1024; jb.N = 512; return true; }
    if (j == 2) { jb.src = IN(7); jb.ldsrc = 1024; jb.dst = (u16*)(ws + OFF_WEFF); jb.lddst = 1536; jb.K = 512; jb.N = 1024; return true; }
    if (j < 5) { const int l = j - 3; jb.src = IN(27) + (size_t)l * 1024 * 5632; jb.ldsrc = 5632; jb.dst = (u16*)(ws + OFF_WUP) + (size_t)l * 5632 * 1024; jb.lddst = 1024; jb.K = 1024; jb.N = 5632; return true; }
    if (j < 7) { const int l = j - 5; jb.src = IN(30) + (size_t)l * 2816 * 1024; jb.ldsrc = 1024; jb.dst = (u16*)(ws + OFF_WDN) + (size_t)l * 1024 * 2816; jb.lddst = 2816; jb.K = 2816; jb.N = 1024; return true; }
    if (j < 10) { const int q = j - 7; jb.src = IN(10 + q); jb.ldsrc = 1024; jb.dst = (u16*)(ws + OFF_WRKV) + (size_t)q * 1024 * 1024; jb.lddst = 1024; jb.K = 1024; jb.N = 1024; return true; }
    if (j < 13) { jb.src = IN(10); jb.ldsrc = 1024; jb.dst = (u16*)(ws + OFF_WRKV); jb.lddst = 1024; jb.K = 0; jb.N = 32; return true; }
    if (j < 21) { const int i = (j - 13) >> 1, part = (j - 13) & 1, z = i & 1, which = i >> 1; jb.src = IN(which ? 18 : 15) + (size_t)z * 1024 * 64; jb.ldsrc = 64; jb.vec = IN(9) + (z * 2 + which) * 1024;
        jb.c0 = part ? 0.f : 1.f; jb.c1 = part ? 1.f : -1.f; jb.dst = (u16*)(ws + OFF_WLORA) + (size_t)(i * 128 + part * 64) * 1024; jb.lddst = 1024; jb.K = 1024; jb.N = 64; return true; }
    if (j < 23) { const int part = j - 21; jb.src = IN(20); jb.ldsrc = 128; jb.vec = IN(8) + 3 * 1024; jb.c0 = part ? 0.f : 1.f; jb.c1 = part ? 0.5f : -1.f;
        jb.dst = (u16*)(ws + OFF_WLORA) + (size_t)(512 + part * 128) * 1024; jb.lddst = 1024; jb.K = 1024; jb.N = 128; return true; }
    if (j == 23) { jb.src = IN(13); jb.ldsrc = 1024; jb.dst = (u16*)(ws + OFF_WO); jb.lddst = 1024; jb.K = 1024; jb.N = 1024; return true; }
    return false;
}
__device__ __forceinline__ void tr_item(const Job& jb, LAS float* scr, int item, int lane) {
    const int nblk = jb.N / 32, kb = item / nblk, nb = item % nblk, k0 = 64 * kb, n0 = 32 * nb;
#pragma unroll 8
    for (int i = 0; i < 32; ++i) { const int kk = 2 * i + (lane >> 5); const float s = jb.vec ? jb.c0 + jb.c1 * jb.vec[k0 + kk] : 1.f;
        scr[kk * 33 + (lane & 31)] = jb.src[(size_t)(k0 + kk) * jb.ldsrc + n0 + (lane & 31)] * s; }
    asm volatile("s_waitcnt lgkmcnt(0)" ::: "memory");
    const int c = lane & 7;
#pragma unroll
    for (int j = 0; j < 4; ++j) { const int n = (lane >> 3) + 8 * j; const LAS float* s = scr + (8 * c) * 33 + n;
        u32x4 o; o.x = pk2(s[0 * 33], s[1 * 33]); o.y = pk2(s[2 * 33], s[3 * 33]); o.z = pk2(s[4 * 33], s[5 * 33]); o.w = pk2(s[6 * 33], s[7 * 33]);
        *(u32x4*)(jb.dst + (size_t)(n0 + n) * jb.lddst + k0 + 8 * c) = o; }
    asm volatile("s_waitcnt lgkmcnt(0)" ::: "memory");
}
__device__ __forceinline__ void prep_phase(unsigned char* ws, unsigned char* ob, LAS unsigned char* lds) {
    const int tid = opaque_tid(), lane = tid & 63, wave = tid >> 6;
    LAS float* scr = (LAS float*)(lds + wave * 16384);
    const int gw = blockIdx.x * 8 + wave, NGW = gridDim.x * 8;
    int base = 0;
    for (int j = 0; j < 24; ++j) { Job jb; get_job(ws, ob, lds, j, jb); const int cnt = (jb.K / 64) * (jb.N / 32);
        int first = (gw - base % NGW + NGW) % NGW;
        for (int it = first; it < cnt; it += NGW) tr_item(jb, scr, it, lane);
        base += cnt; }
    const size_t gt = (size_t)blockIdx.x * 512 + tid, NT = (size_t)gridDim.x * 512;
    {
        u16* WE = (u16*)(ws + OFF_WEFF); const float* wo = IN(7);
        for (size_t i = gt; i < 512ull * 1024; i += NT) { const int d = (int)(i & 1023), gc = (int)(i >> 10), g = gc >> 7, c = gc & 127;
            float sr = 0.f, si = 0.f;
            for (int c2 = 0; c2 < 128; ++c2) { const float fr = (float)((c * c2) & 127) * (1.f / 128.f); const float w = wo[(size_t)(512 + 128 * g + c2) * 1024 + d];
                sr += __builtin_amdgcn_cosf(fr) * w; si += __builtin_amdgcn_sinf(fr) * w; }
            WE[(size_t)d * 1536 + 512 + gc] = f2bf(sr * 0.08838834764f); WE[(size_t)d * 1536 + 1024 + gc] = f2bf(si * 0.08838834764f); }
    }
    {
        u16* DA = (u16*)(ws + OFF_DFTA);
        for (size_t i = gt; i < 512ull * 512; i += NT) { const int kk = (int)(i & 511), m = (int)(i >> 9); const int rio = m >> 8, k1 = m & 255, rii = kk >> 8, t1 = kk & 255;
            const float fr = (float)((k1 * t1) & 255) * (1.f / 256.f); const float c = __builtin_amdgcn_cosf(fr), s = __builtin_amdgcn_sinf(fr);
            DA[i] = f2bf(rio == rii ? c : (rio == 0 ? s : -s)); }
    }
    {
        u16* W2 = (u16*)(ws + OFF_WUP2);
        for (size_t i = gt; i < 4096ull * 256; i += NT) { const int k = (int)(i & 255), n = (int)(i >> 8), gi = n >> 10, c = n & 1023; float v = 0.f;
            if ((k >> 6) == gi) { const int z = gi & 1; const float* src = (gi < 2 ? IN(16) : IN(19)) + (size_t)z * 64 * 1024; v = src[(size_t)(k & 63) * 1024 + c]; }
            W2[i] = f2bf(v); }
        u16* WG = (u16*)(ws + OFF_WG2);
        for (size_t i = gt; i < 1024ull * 256; i += NT) { const int k = (int)(i & 255), n = (int)(i >> 8); WG[i] = f2bf(k < 128 ? IN(21)[(size_t)k * 1024 + n] : 0.f); }
    }
}

__device__ __forceinline__ void load_row_bf(const u16* row, int lane, float* v) { unpk8(*(const u32x4*)(row + 8 * lane), v); unpk8(*(const u32x4*)(row + 512 + 8 * lane), v + 8); }
__device__ __forceinline__ float rstd_of(const float* v) { float s = 0.f;
#pragma unroll
    for (int j = 0; j < 16; ++j) s += v[j] * v[j];
    return 1.f / sqrtf(wave_sum(s) * (1.f / 1024.f) + 1e-6f); }
__device__ __forceinline__ void norm0_phase(unsigned char* ws, unsigned char* ob, LAS unsigned char* lds) {
    const int tix = opaque_tid(); const int lane = tix & 63, gw = blockIdx.x * 8 + (tix >> 6), NGW = gridDim.x * 8;
    u16* H = (u16*)(ws + OFF_H); const float* g = IN(2);
    f32x4 gv[4];
#pragma unroll
    for (int j = 0; j < 4; ++j) gv[j] = *(const f32x4*)(g + 4 * lane + 256 * j);
    for (int t = gw; t < 65536; t += NGW) { const float* xr = t < HT ? IN(0) + (size_t)t * 1024 : IN(1) + (size_t)(t - HT) * 1024;
        f32x4 v[4]; float s = 0.f;
#pragma unroll
        for (int j = 0; j < 4; ++j) { v[j] = *(const f32x4*)(xr + 4 * lane + 256 * j); s += v[j].x * v[j].x + v[j].y * v[j].y + v[j].z * v[j].z + v[j].w * v[j].w; }
        const float r = 1.f / sqrtf(wave_sum(s) * (1.f / 1024.f) + 1e-6f);
#pragma unroll
        for (int j = 0; j < 4; ++j) { const f32x4 o = v[j] * r * gv[j]; u32x2 w; w.x = pk2(o.x, o.y); w.y = pk2(o.z, o.w); *(u32x2*)(H + (size_t)t * 1024 + 4 * lane + 256 * j) = w; } }
}
__device__ __forceinline__ void normx_phase(unsigned char* ws, unsigned char* ob, const float* g, int mode) {
    const int tix = opaque_tid(); const int lane = tix & 63, gw = blockIdx.x * 8 + (tix >> 6), NGW = gridDim.x * 8;
    const u16* X = (const u16*)(ws + OFF_X); u16* H = (u16*)(ws + OFF_H);
    float gv[16];
#pragma unroll
    for (int j = 0; j < 2; ++j)
#pragma unroll
        for (int e = 0; e < 8; ++e) gv[8 * j + e] = g[8 * lane + 512 * j + e];
    for (int t = gw; t < 65536; t += NGW) { float v[16]; load_row_bf(X + (size_t)t * 1024, lane, v); const float r = rstd_of(v);
#pragma unroll
        for (int j = 0; j < 16; ++j) v[j] = v[j] * r * gv[j];
        if (mode == 0) { *(u32x4*)(H + (size_t)t * 1024 + 8 * lane) = pk8(v); *(u32x4*)(H + (size_t)t * 1024 + 512 + 8 * lane) = pk8(v + 8); }
        else { float* o = ((float*)ob) + (size_t)t * 1024;
#pragma unroll
            for (int j = 0; j < 2; ++j) { __builtin_nontemporal_store((f32x4){v[8 * j], v[8 * j + 1], v[8 * j + 2], v[8 * j + 3]}, (f32x4*)(o + 8 * lane + 512 * j)); __builtin_nontemporal_store((f32x4){v[8 * j + 4], v[8 * j + 5], v[8 * j + 6], v[8 * j + 7]}, (f32x4*)(o + 8 * lane + 512 * j + 4)); } } }
}
__device__ __forceinline__ void norm1_phase(unsigned char* ws, unsigned char* ob, LAS unsigned char* lds, int hf) {
    const int tix = opaque_tid(); const int lane = tix & 63, gw = blockIdx.x * 8 + (tix >> 6), NGW = gridDim.x * 8;
    const u16* X = (const u16*)(ws + OFF_X) + (size_t)hf * HT * 1024; u16* XO = (u16*)(ws + OFF_HH); const float* g = IN(2) + 1024; const float* mu = IN(8);
    const int T = hf ? 8192 : 4096;
    float gv[16], m1[3][16], m2[3][16];
#pragma unroll
    for (int j = 0; j < 2; ++j)
#pragma unroll
        for (int e = 0; e < 8; ++e) { gv[8 * j + e] = g[8 * lane + 512 * j + e];
#pragma unroll
            for (int q = 0; q < 3; ++q) { const float mm = mu[q * 1024 + 8 * lane + 512 * j + e]; m1[q][8 * j + e] = 1.f - mm; m2[q][8 * j + e] = 0.5f * mm; } }
    for (int r0 = gw * 8; r0 < HT; r0 += NGW * 8) {
        const int pos0 = r0 & (T - 1);
        float pv[16], cv[16], nv[16];
        if (pos0 > 0) { load_row_bf(X + (size_t)(r0 - 1) * 1024, lane, pv); const float r = rstd_of(pv);
#pragma unroll
            for (int j = 0; j < 16; ++j) pv[j] = pv[j] * r * gv[j]; }
        else {
#pragma unroll
            for (int j = 0; j < 16; ++j) pv[j] = 0.f; }
        { load_row_bf(X + (size_t)r0 * 1024, lane, cv); const float r = rstd_of(cv);
#pragma unroll
            for (int j = 0; j < 16; ++j) cv[j] = cv[j] * r * gv[j]; }
        u32x4 nq0 = *(const u32x4*)(X + (size_t)(r0 + 1) * 1024 + 8 * lane), nq1 = *(const u32x4*)(X + (size_t)(r0 + 1) * 1024 + 512 + 8 * lane);
#pragma unroll 2
        for (int i = 0; i < 8; ++i) { const int t = r0 + i; const bool hn = (pos0 + i) < T - 1;
            if (hn) { unpk8(nq0, nv); unpk8(nq1, nv + 8); const float r = rstd_of(nv);
#pragma unroll
                for (int j = 0; j < 16; ++j) nv[j] = nv[j] * r * gv[j]; }
            else {
#pragma unroll
                for (int j = 0; j < 16; ++j) nv[j] = 0.f; }
            if (i < 7 && (pos0 + i + 1) < T - 1) { nq0 = *(const u32x4*)(X + (size_t)(t + 2) * 1024 + 8 * lane); nq1 = *(const u32x4*)(X + (size_t)(t + 2) * 1024 + 512 + 8 * lane); }
            u16* o = XO + (size_t)t * 1024;
#pragma unroll
            for (int q = 0; q < 3; ++q) { float m[16];
#pragma unroll
                for (int j = 0; j < 16; ++j) m[j] = cv[j] * m1[q][j] + m2[q][j] * (pv[j] + nv[j]);
                *(u32x4*)(o + (size_t)q * HT * 1024 + 8 * lane) = pk8(m); *(u32x4*)(o + (size_t)q * HT * 1024 + 512 + 8 * lane) = pk8(m + 8); }
            *(u32x4*)(o + 3ull * HT * 1024 + 8 * lane) = pk8(cv); *(u32x4*)(o + 3ull * HT * 1024 + 512 + 8 * lane) = pk8(cv + 8);
#pragma unroll
            for (int j = 0; j < 16; ++j) { pv[j] = cv[j]; cv[j] = nv[j]; } } }
}

__device__ __forceinline__ void yconv_phase(unsigned char* ws, unsigned char* ob, LAS unsigned char* lds) {
    const int tix = opaque_tid(); const int lane = tix & 63, gw = blockIdx.x * 8 + (tix >> 6), NGW = gridDim.x * 8;
    const u16* PR = (const u16*)(ob + OUT_PROJ); u16* CAT = (u16*)(ws + OFF_CAT); const float* cw = IN(6);
    float w[3][8];
#pragma unroll
    for (int j = 0; j < 3; ++j)
#pragma unroll
        for (int e = 0; e < 8; ++e) w[j][e] = cw[j * 512 + 8 * lane + e];
    for (int t = gw; t < 65536; t += NGW) { const int T = seqT(t), pos = t & (T - 1);
        float acc[8], gb[8];
#pragma unroll
        for (int e = 0; e < 8; ++e) acc[e] = 0.f;
#pragma unroll
        for (int j = 0; j < 3; ++j) { const int pp = pos + j - 1; if (pp < 0 || pp >= T) continue;
            const u16* r = PR + (size_t)(t + j - 1) * 1536 + 8 * lane; float a[8], b[8]; unpk8(*(const u32x4*)(r + 512), a); unpk8(*(const u32x4*)(r + 1024), b);
#pragma unroll
            for (int e = 0; e < 8; ++e) acc[e] += w[j][e] * a[e] * b[e]; }
        unpk8(*(const u32x4*)(PR + (size_t)t * 1536 + 8 * lane), gb);
#pragma unroll
        for (int e = 0; e < 8; ++e) acc[e] *= gb[e];
        *(u32x4*)(CAT + (size_t)t * 1536 + 8 * lane) = pk8(acc); }
}
template <int T2>
__device__ __forceinline__ void stageA_item(const u16* FT, u16* YP, int tokbase, size_t nbase, int ch, int t1) {
    constexpr float C32[32] = {1.000000000f, 0.980785280f, 0.923879533f, 0.831469612f, 0.707106781f, 0.555570233f, 0.382683432f, 0.195090322f, 0.000000000f, -0.195090322f, -0.382683432f, -0.555570233f, -0.707106781f, -0.831469612f, -0.923879533f, -0.980785280f, -1.000000000f, -0.980785280f, -0.923879533f, -0.831469612f, -0.707106781f, -0.555570233f, -0.382683432f, -0.195090322f, -0.000000000f, 0.195090322f, 0.382683432f, 0.555570233f, 0.707106781f, 0.831469612f, 0.923879533f, 0.980785280f};
    constexpr float S32[32] = {0.000000000f, 0.195090322f, 0.382683432f, 0.555570233f, 0.707106781f, 0.831469612f, 0.923879533f, 0.980785280f, 1.000000000f, 0.980785280f, 0.923879533f, 0.831469612f, 0.707106781f, 0.555570233f, 0.382683432f, 0.195090322f, 0.000000000f, -0.195090322f, -0.382683432f, -0.555570233f, -0.707106781f, -0.831469612f, -0.923879533f, -0.980785280f, -1.000000000f, -0.980785280f, -0.923879533f, -0.831469612f, -0.707106781f, -0.555570233f, -0.382683432f, -0.195090322f};
    float xv[T2];
#pragma unroll
    for (int t2 = 0; t2 < T2; ++t2) xv[t2] = bf2f(FT[(size_t)ch * 65536 + tokbase + t1 + 256 * t2]);
    const float invs = 1.f / sqrtf((float)(256 * T2));
#pragma unroll
    for (int k2 = 0; k2 <= T2 / 2; ++k2) { float yr = 0.f, yi = 0.f;
#pragma unroll
        for (int t2 = 0; t2 < T2; ++t2) { const int j = ((k2 * t2) & (T2 - 1)) * (32 / T2); yr += xv[t2] * C32[j]; yi -= xv[t2] * S32[j]; }
#pragma unroll
        for (int mir = 0; mir < 2; ++mir) { const int kk = mir ? T2 - k2 : k2; if (mir && (k2 == 0 || k2 == T2 / 2)) continue; const float yim = mir ? -yi : yi;
            const float fr = (float)(kk * t1) * (1.f / (256.f * T2)); const float c = __builtin_amdgcn_cosf(fr), sn = __builtin_amdgcn_sinf(fr);
            u16* o = YP + (nbase + (size_t)kk * 512 + ch) * 512 + t1;
            o[0] = f2bf((yr * c + yim * sn) * invs); o[256] = f2bf((yim * c - yr * sn) * invs); } }
}
__device__ __forceinline__ void stageA_phase(unsigned char* ws, unsigned char* ob, LAS unsigned char* lds) {
    const int tid = opaque_tid();
    const u16* FT = (const u16*)(ob + OUT_FT); u16* YP = (u16*)(ws + OFF_YP);
    for (int it = blockIdx.x; it < 12 * 256; it += gridDim.x) { const int sq = it >> 8, ch = 2 * (it & 255) + (tid >> 8), t1 = tid & 255;
        if (sq < 8) stageA_item<16>(FT, YP, sq * 4096, (size_t)sq * 16 * 512, ch, t1);
        else stageA_item<32>(FT, YP, HT + (sq - 8) * 8192, 65536 + (size_t)(sq - 8) * 32 * 512, ch, t1); }
}

__device__ __forceinline__ void act_phase(unsigned char* ws, unsigned char* ob, LAS unsigned char* lds, int l, int chunk) {
    const u16* U = (const u16*)(ws + OFF_U); u16* ACT = (u16*)(ob + OUT_ACT);
    const float* cw = IN(28) + (size_t)l * 3 * 5632; const float* cb = IN(29) + (size_t)l * 5632;
    const size_t gt = (size_t)blockIdx.x * 512 + opaque_tid(), NT = (size_t)gridDim.x * 512;
    for (size_t i = gt; i < 1024ull * 352; i += NT) {
        const int rbk = (int)(i / 352), c = 8 * (int)(i % 352), row0 = rbk * 16; const int tg0 = chunk * 16384 + row0, T = seqT(tg0), pos0 = tg0 & (T - 1);
        float wg[3][8], wv[3][8], bg[8], bv[8];
#pragma unroll
        for (int j = 0; j < 3; ++j) { const f32x4 a0 = *(const f32x4*)(cw + j * 5632 + c), a1 = *(const f32x4*)(cw + j * 5632 + c + 4), b0 = *(const f32x4*)(cw + j * 5632 + 2816 + c), b1 = *(const f32x4*)(cw + j * 5632 + 2816 + c + 4);
            wg[j][0] = a0.x; wg[j][1] = a0.y; wg[j][2] = a0.z; wg[j][3] = a0.w; wg[j][4] = a1.x; wg[j][5] = a1.y; wg[j][6] = a1.z; wg[j][7] = a1.w;
            wv[j][0] = b0.x; wv[j][1] = b0.y; wv[j][2] = b0.z; wv[j][3] = b0.w; wv[j][4] = b1.x; wv[j][5] = b1.y; wv[j][6] = b1.z; wv[j][7] = b1.w; }
        { const f32x4 a0 = *(const f32x4*)(cb + c), a1 = *(const f32x4*)(cb + c + 4), b0 = *(const f32x4*)(cb + 2816 + c), b1 = *(const f32x4*)(cb + 2816 + c + 4);
            bg[0] = a0.x; bg[1] = a0.y; bg[2] = a0.z; bg[3] = a0.w; bg[4] = a1.x; bg[5] = a1.y; bg[6] = a1.z; bg[7] = a1.w;
            bv[0] = b0.x; bv[1] = b0.y; bv[2] = b0.z; bv[3] = b0.w; bv[4] = b1.x; bv[5] = b1.y; bv[6] = b1.z; bv[7] = b1.w; }
        float pg[8], pv[8], cg_[8], cv[8];
        const u16* r = U + (size_t)row0 * 5632 + c;
        u32x4 bufg[2][4], bufv[2][4];
        const bool tail_ok = pos0 + 16 < T;
#define ACT_LOAD(g_, b_) do { _Pragma("unroll") for (int k = 0; k < 4; ++k) { const int rn = 4 * (g_) + k + 1; \
            if (rn < 16 || tail_ok) { bufg[b_][k] = *(const u32x4*)(r + (size_t)rn * 5632); bufv[b_][k] = *(const u32x4*)(r + (size_t)rn * 5632 + 2816); } \
            else { bufg[b_][k] = (u32x4){0u, 0u, 0u, 0u}; bufv[b_][k] = (u32x4){0u, 0u, 0u, 0u}; } } } while (0)
        ACT_LOAD(0, 0);
        if (pos0 > 0) { unpk8(*(const u32x4*)(r - 5632), pg); unpk8(*(const u32x4*)(r - 5632 + 2816), pv); }
        else {
#pragma unroll
            for (int e = 0; e < 8; ++e) { pg[e] = 0.f; pv[e] = 0.f; } }
        unpk8(*(const u32x4*)r, cg_); unpk8(*(const u32x4*)(r + 2816), cv);
#pragma unroll
        for (int g = 0; g < 4; ++g) {
            if (g < 3) ACT_LOAD(g + 1, (g + 1) & 1);
#pragma unroll
            for (int k = 0; k < 4; ++k) { float ng[8], nv[8], o[8]; unpk8(bufg[g & 1][k], ng); unpk8(bufv[g & 1][k], nv);
#pragma unroll
                for (int e = 0; e < 8; ++e) { const float gg = bg[e] + wg[0][e] * pg[e] + wg[1][e] * cg_[e] + wg[2][e] * ng[e]; const float v = bv[e] + wv[0][e] * pv[e] + wv[1][e] * cv[e] + wv[2][e] * nv[e];
                    o[e] = gg * sigmoidf_(gg) * v; pg[e] = cg_[e]; pv[e] = cv[e]; cg_[e] = ng[e]; cv[e] = nv[e]; }
                *(u32x4*)(ACT + (size_t)(row0 + 4 * g + k) * 2816 + c) = pk8(o); } }
#undef ACT_LOAD
    }
}

__device__ __forceinline__ void lprep_phase(unsigned char* ws, unsigned char* ob, int hf) {
    const int tix = opaque_tid(); const int lane = tix & 63, gw = blockIdx.x * 8 + (tix >> 6), NGW = gridDim.x * 8;
    const u16* PB = (const u16*)(ob + OUT_P); u16* L = (u16*)(ws + OFF_L); u16* LG = (u16*)(ws + OFF_LG);
    const int T = hf ? 8192 : 4096;
    for (int t = gw; t < HT; t += NGW) { const int pos = t & (T - 1); const u16* r = PB + (size_t)t * 768; float a[8], b[8];
        if (lane < 32) { const int i = lane >> 3, r0 = (lane & 7) * 8, sh = (i & 1) ? 1 : -1; const bool ok = (i & 1) ? (pos < T - 1) : (pos > 0);
            unpk8(*(const u32x4*)(r + i * 128 + r0), a);
            if (ok) { unpk8(*(const u32x4*)(r + sh * 768 + i * 128 + 64 + r0), b);
#pragma unroll
                for (int e = 0; e < 8; ++e) a[e] += b[e]; }
            if (i < 2) {
#pragma unroll
                for (int e = 0; e < 8; ++e) a[e] = 1.f - 2.f * __builtin_amdgcn_rcpf(1.f + __expf(2.f * a[e])); }
            *(u32x4*)(L + (size_t)t * 256 + 8 * lane) = pk8(a); }
        else if (lane < 48) { const int r0 = (lane - 32) * 8; unpk8(*(const u32x4*)(r + 512 + r0), a);
            if (pos > 0) { unpk8(*(const u32x4*)(r - 768 + 640 + r0), b);
#pragma unroll
                for (int e = 0; e < 8; ++e) a[e] += b[e]; }
            if (pos < T - 1) { unpk8(*(const u32x4*)(r + 768 + 640 + r0), b);
#pragma unroll
                for (int e = 0; e < 8; ++e) a[e] += b[e]; }
#pragma unroll
            for (int e = 0; e < 8; ++e) a[e] = sigmoidf_(a[e]);
            *(u32x4*)(LG + (size_t)t * 256 + r0) = pk8(a); }
        else { unsigned zz = 0u; asm volatile("" : "+v"(zz)); *(u32x4*)(LG + (size_t)t * 256 + 128 + (lane - 48) * 8) = (u32x4){zz, zz, zz, zz}; } }
}
__device__ __forceinline__ void rwprep_phase(unsigned char* ws, unsigned char* ob, LAS unsigned char* lds) {
    const int tix = opaque_tid(); const int lane = tix & 63, gw = blockIdx.x * 8 + (tix >> 6), NGW = gridDim.x * 8;
    const u16* R = (const u16*)(ob + OUT_RKV); const u16* Kp = R + (size_t)HT * 1024;
    const u16* A0 = (const u16*)(ws + OFF_D4) + 2ull * HT * 1024; const u16* A1 = A0 + (size_t)HT * 1024;
    float* INV = (float*)(ws + OFF_INV); float* BON = (float*)(ws + OFF_BON);
    const float* kkp = IN(22) + 16 * lane; const float* kap = IN(23) + 16 * lane; const float* rkp = IN(24) + 16 * lane;
    float kk[16], ka[16], rk[16];
#pragma unroll
    for (int e = 0; e < 16; ++e) { kk[e] = kkp[e]; ka[e] = kap[e]; rk[e] = rkp[e]; }
    for (int t0 = gw; t0 < HT; t0 += 2 * NGW) {
        u32x4 q[2][8];
#pragma unroll
        for (int u2 = 0; u2 < 2; ++u2) { const int t = t0 + u2 * NGW; if (t < HT) { const size_t o = (size_t)t * 1024 + 16 * lane;
            q[u2][0] = *(const u32x4*)(Kp + o); q[u2][1] = *(const u32x4*)(Kp + o + 8); q[u2][2] = *(const u32x4*)(R + o); q[u2][3] = *(const u32x4*)(R + o + 8);
            q[u2][4] = *(const u32x4*)(A0 + o); q[u2][5] = *(const u32x4*)(A0 + o + 8); q[u2][6] = *(const u32x4*)(A1 + o); q[u2][7] = *(const u32x4*)(A1 + o + 8); } }
#pragma unroll
        for (int u2 = 0; u2 < 2; ++u2) { const int t = t0 + u2 * NGW; if (t < HT) { float k[16], r[16], a0[16], a1[16];
            unpk8(q[u2][0], k); unpk8(q[u2][1], k + 8); unpk8(q[u2][2], r); unpk8(q[u2][3], r + 8); unpk8(q[u2][4], a0); unpk8(q[u2][5], a0 + 8); unpk8(q[u2][6], a1); unpk8(q[u2][7], a1 + 8);
            float ss = 0.f, bn = 0.f;
#pragma unroll
            for (int e = 0; e < 16; ++e) { const float qq = k[e] * kk[e]; ss += qq * qq; bn += r[e] * k[e] * rk[e] * (2.f + (a0[e] + a1[e] - 2.f) * ka[e]); }
            ss = allreduce4(ss); bn = allreduce4(bn);
            if ((lane & 3) == 0) { INV[(size_t)t * 16 + (lane >> 2)] = 1.f / fmaxf(sqrtf(ss), 1e-12f); BON[(size_t)t * 16 + (lane >> 2)] = bn; } } } }
}
__device__ __forceinline__ void gn_phase(unsigned char* ws, unsigned char* ob, LAS unsigned char* lds) {
    const int tix = opaque_tid(); const int lane = tix & 63, gw = blockIdx.x * 8 + (tix >> 6), NGW = gridDim.x * 8;
    const u16* Y = (const u16*)(ob + OUT_Y); const u16* V = (const u16*)(ob + OUT_RKV) + 2ull * HT * 1024;
    const u16* G = (const u16*)(ws + OFF_G); u16* YG = (u16*)(ws + OFF_YG); const float* BON = (const float*)(ws + OFF_BON); const u16* YB = (const u16*)(ws + OFF_D4) + 3ull * HT * 1024;
    float gw_[16], gb_[16];
#pragma unroll
    for (int e = 0; e < 16; ++e) { gw_[e] = IN(25)[16 * lane + e]; gb_[e] = IN(26)[16 * lane + e]; }
    for (int t0 = gw; t0 < HT; t0 += 2 * NGW) {
        u32x4 q[2][8]; float bnv[2] = {0.f, 0.f};
#pragma unroll
        for (int u2 = 0; u2 < 2; ++u2) { const int t = t0 + u2 * NGW; if (t < HT) { const size_t o = (size_t)t * 1024 + 16 * lane;
            q[u2][0] = *(const u32x4*)(Y + o); q[u2][1] = *(const u32x4*)(Y + o + 8); q[u2][2] = *(const u32x4*)(YB + o); q[u2][3] = *(const u32x4*)(YB + o + 8);
            q[u2][4] = *(const u32x4*)(V + o); q[u2][5] = *(const u32x4*)(V + o + 8); q[u2][6] = *(const u32x4*)(G + o); q[u2][7] = *(const u32x4*)(G + o + 8); bnv[u2] = BON[(size_t)t * 16 + (lane >> 2)]; } }
#pragma unroll
        for (int u2 = 0; u2 < 2; ++u2) { const int t = t0 + u2 * NGW; if (t < HT) { const size_t o = (size_t)t * 1024 + 16 * lane; float y[16], yb[16], v[16], g[16];
            unpk8(q[u2][0], y); unpk8(q[u2][1], y + 8); unpk8(q[u2][2], yb); unpk8(q[u2][3], yb + 8); unpk8(q[u2][4], v); unpk8(q[u2][5], v + 8); unpk8(q[u2][6], g); unpk8(q[u2][7], g + 8);
            float s = 0.f;
#pragma unroll
            for (int e = 0; e < 16; ++e) { y[e] += yb[e]; s += y[e]; }
            const float mean = allreduce4(s) * (1.f / 64.f); float qv = 0.f;
#pragma unroll
            for (int e = 0; e < 16; ++e) { y[e] -= mean; qv += y[e] * y[e]; }
            const float rstd = 1.f / sqrtf(allreduce4(qv) * (1.f / 64.f) + 64e-5f); const float bn = bnv[u2];
#pragma unroll
            for (int e = 0; e < 16; ++e) y[e] = (y[e] * rstd * gw_[e] + gb_[e] + bn * v[e]) * g[e];
            *(u32x4*)(YG + o) = pk8(y); *(u32x4*)(YG + o + 8) = pk8(y + 8); } } }
}

typedef float f32x16 __attribute__((ext_vector_type(16)));
#define MFMA32(a, b, c) __builtin_amdgcn_mfma_f32_32x32x16_bf16((a), (b), (c), 0, 0, 0)
__device__ __forceinline__ unsigned pkc(float lo, float hi) { typedef __bf16 bf2 __attribute__((ext_vector_type(2))); typedef float f2 __attribute__((ext_vector_type(2))); const f2 v = {lo, hi}; const bf2 b = __builtin_convertvector(v, bf2); return __builtin_bit_cast(unsigned, b); }
__device__ __forceinline__ u16 bfc(float v) { return (u16)(pkc(v, 0.f) & 0xffffu); }
__device__ __forceinline__ bf16x8 pack_lo(const f32x16& x) { u32x4 p; p.x = pkc(x[0], x[1]); p.y = pkc(x[2], x[3]); p.z = pkc(x[4], x[5]); p.w = pkc(x[6], x[7]); return __builtin_bit_cast(bf16x8, p); }
__device__ __forceinline__ bf16x8 pack_hi(const f32x16& x) { u32x4 p; p.x = pkc(x[8], x[9]); p.y = pkc(x[10], x[11]); p.z = pkc(x[12], x[13]); p.w = pkc(x[14], x[15]); return __builtin_bit_cast(bf16x8, p); }
constexpr int SL_QS = 1056;
constexpr int SL_AR = 0, SL_BK = 4 * SL_QS, SL_BT = 8 * SL_QS, SL_KT = SL_BT + 2048, SL_VT = SL_KT + 2048, SL_MK = SL_VT + 2048, SL_T2 = SL_MK + 1024, SL_WL = SL_T2 + 1024, SL_SIZE = SL_WL + 256;
static_assert(SL_VT >= 10240 && 8 * SL_SIZE <= LDS_TAB, "scan slot layout");
__device__ __forceinline__ void scan_phase(unsigned char* ws, unsigned char* ob, LAS unsigned char* lds, int hf) {
    const int T = hf ? 8192 : 4096, nunits = (hf ? 4 : 8) * 16 * 2, nblk = T / 16, nbatch = nblk / 8;
    const int tid = opaque_tid(), lane = tid & 63, wave = __builtin_amdgcn_readfirstlane(tid >> 6), r = lane & 31, h = lane >> 5;
    const u16* R = (const u16*)(ob + OUT_RKV); const u16* Kp = R + (size_t)HT * 1024; const u16* V = Kp + (size_t)HT * 1024;
    const u16* D4 = (const u16*)(ws + OFF_D4); const float* INV = (const float*)(ws + OFF_INV);
    const int ci = wave;
    const int jb = lane >> 5, jl = lane & 31, js = jl >> 4, jh = (jl >> 2) & 1, je = ((jl >> 3) & 1) * 4 + (jl & 3);
    const unsigned posj = (unsigned)((jb * 2 + js) * SL_QS + jh * 16 + je * 2);
    LAS unsigned char* sb = lds + wave * SL_SIZE;
#define SC_BAR() do { asm volatile("s_waitcnt lgkmcnt(0)" ::: "memory"); __builtin_amdgcn_s_barrier(); asm volatile("" ::: "memory"); } while (0)
    const int nroles = (hf && gridDim.x >= 256) ? 2 : 1;
    const int bx = blockIdx.x, role = nroles == 2 ? ((bx >> 3) & 1) : 0, u0 = nroles == 2 ? (((bx >> 4) << 3) | (bx & 7)) : bx;
    unsigned* hflag = (unsigned*)(ws + OFF_BAR + 16384); float* hslot = (float*)(ws + OFF_HSLOT);
    for (int u = u0; u < nunits; u += (nroles == 2 ? 1 << 30 : (int)gridDim.x)) {
        if (nroles == 2 && bx >= 256) break;
        const int z = u & 1, hd = (u >> 1) & 15, b = u >> 5; const size_t seqbase = (size_t)b * T;
        u16* Y = z ? (u16*)(ws + OFF_D4) + 3ull * HT * 1024 : (u16*)(ob + OUT_Y);
        const float kkc = IN(22)[hd * 64 + lane], kac = IN(23)[hd * 64 + lane];
        f32x16 X0, X1;
#pragma unroll
        for (int g = 0; g < 16; ++g) { X0[g] = 0.f; X1[g] = 0.f; }
        const unsigned lanepart = (unsigned)((hd * 64 + 8 * (lane & 7)) * 2); const u16* Dz = D4 + (size_t)z * HT * 1024; const u16* Az = D4 + (size_t)(2 + z) * HT * 1024;
        u32x4 graw[5][2]; float inv = 0.f;
#define SC_LOAD(bt_) do { int nb_ = (bt_); asm volatile("" : "+s"(nb_)); const int n_ = nb_ * 8 + ci;     \
            _Pragma("unroll") for (int i2 = 0; i2 < 2; ++i2) { const int t_ = (lane >> 3) + 8 * i2; const int tl_ = z ? (T - 1 - (16 * n_ + t_)) : (16 * n_ + t_); \
                const unsigned off_ = (unsigned)(((int)seqbase + tl_) * 2048) + lanepart;            \
                graw[0][i2] = *(const u32x4*)((const char*)R + off_); graw[1][i2] = *(const u32x4*)((const char*)Kp + off_); graw[2][i2] = *(const u32x4*)((const char*)V + off_); \
                graw[3][i2] = *(const u32x4*)((const char*)Dz + off_); graw[4][i2] = *(const u32x4*)((const char*)Az + off_); } \
            { const int t_ = lane & 15; const int tl_ = z ? (T - 1 - (16 * n_ + t_)) : (16 * n_ + t_); inv = *(const float*)((const char*)INV + (unsigned)((((int)seqbase + tl_) * 16 + hd) * 4)); } } while (0)
        SC_LOAD(role);
        __syncthreads();
        for (int bt = role; bt < nbatch; bt += nroles) {
            {
#pragma unroll
                for (int a5 = 0; a5 < 5; ++a5) { *(LAS u32x4*)(sb + a5 * 2048 + lane * 16) = graw[a5][0]; *(LAS u32x4*)(sb + a5 * 2048 + 1024 + lane * 16) = graw[a5][1]; }
                asm volatile("s_waitcnt lgkmcnt(0)" ::: "memory");
                unsigned rr[16], kr[16], lr[16], ar[16], vr[16];
#pragma unroll
                for (int t = 0; t < 16; ++t) { rr[t] = *(const LAS u16*)(sb + 0 * 2048 + t * 128 + 2 * lane); kr[t] = *(const LAS u16*)(sb + 1 * 2048 + t * 128 + 2 * lane); vr[t] = *(const LAS u16*)(sb + 2 * 2048 + t * 128 + 2 * lane);
                    lr[t] = *(const LAS u16*)(sb + 3 * 2048 + t * 128 + 2 * lane); ar[t] = *(const LAS u16*)(sb + 4 * 2048 + t * 128 + 2 * lane); }
                asm volatile("s_waitcnt lgkmcnt(0)" ::: "memory");
#define PK16(a_, t0_) ((a_)[t0_] | ((a_)[(t0_) + 1] << 16))
                *(LAS u32x4*)(sb + SL_VT + lane * 32) = (u32x4){PK16(vr, 0), PK16(vr, 2), PK16(vr, 8), PK16(vr, 10)}; *(LAS u32x4*)(sb + SL_VT + lane * 32 + 16) = (u32x4){PK16(vr, 4), PK16(vr, 6), PK16(vr, 12), PK16(vr, 14)};
                float L = 0.f, Eprev = 1.f; unsigned b16[8], k16[8];
#pragma unroll
                for (int t = 0; t < 16; ++t) { const float invt = __int_as_float(__builtin_amdgcn_readlane(__float_as_int(inv), t));
                    const float kf = __uint_as_float(kr[t] << 16), rf = __uint_as_float(rr[t] << 16), lw = __uint_as_float(lr[t] << 16), af = __uint_as_float(ar[t] << 16);
                    const float kk_ = kf * kkc * invt; L += lw; const float E = __expf(L), Einv = __builtin_amdgcn_rcpf(E);
                    const u16 At = bfc(-kk_ * Eprev), Rt = bfc(rf * E), Bt = bfc(kk_ * af * Einv), Kt = bfc(kf * (1.f + (af - 1.f) * kac) * Einv); Eprev = E;
                    constexpr int dummy = 0; (void)dummy;
                    const int ht = (t >> 2) & 1, et = ((t >> 3) & 1) * 4 + (t & 3);
                    *(LAS u16*)(sb + SL_AR + posj + 32 * t) = At; *(LAS u16*)(sb + SL_AR + posj + 32 * (16 + t)) = Rt;
                    *(LAS u16*)(sb + SL_BK + posj + 32 * t) = Bt; *(LAS u16*)(sb + SL_BK + posj + 32 * (16 + t)) = Kt;
                    if (t & 1) { b16[t >> 1] |= (unsigned)Bt << 16; k16[t >> 1] |= (unsigned)Kt << 16; } else { b16[t >> 1] = Bt; k16[t >> 1] = Kt; } (void)ht; (void)et; }
                *(LAS u32x4*)(sb + SL_BT + lane * 32) = (u32x4){b16[0], b16[1], b16[4], b16[5]}; *(LAS u32x4*)(sb + SL_BT + lane * 32 + 16) = (u32x4){b16[2], b16[3], b16[6], b16[7]};
                *(LAS u32x4*)(sb + SL_KT + lane * 32) = (u32x4){k16[0], k16[1], k16[4], k16[5]}; *(LAS u32x4*)(sb + SL_KT + lane * 32 + 16) = (u32x4){k16[2], k16[3], k16[6], k16[7]};
#undef PK16
                *(LAS float*)(sb + SL_WL + 4 * lane) = Eprev; }
            if (bt + nroles < nbatch) SC_LOAD(bt + nroles);
            asm volatile("s_waitcnt lgkmcnt(0)" ::: "memory");
            {   f32x16 M;
#pragma unroll
                for (int g = 0; g < 16; ++g) M[g] = 0.f;
#pragma unroll
                for (int q = 0; q < 4; ++q) { const bf16x8 a = *(const LAS bf16x8*)(sb + SL_AR + q * SL_QS + r * 32 + h * 16), bq = *(const LAS bf16x8*)(sb + SL_BK + q * SL_QS + r * 32 + h * 16); M = MFMA32(a, bq, M); }
                LAS float* Mf = (LAS float*)(sb + SL_BK);
                int rl = r, hl = h; asm volatile("" : "+v"(rl), "+v"(hl));
#pragma unroll
                for (int g = 0; g < 16; ++g) { const int tp = (g & 3) + 8 * (g >> 2) + 4 * hl, tt = tp & 15, ss = rl & 15; const bool keep = (tp < 16) ? (ss < tt) : (ss <= tt); Mf[tp * 32 + rl] = keep ? M[g] : 0.f; }
                asm volatile("s_waitcnt lgkmcnt(0)" ::: "memory");
                const int c = lane & 15, hc = (c >> 2) & 1, ec = ((c >> 3) & 1) * 4 + (c & 3); float x[16];
#pragma unroll
                for (int gq = 0; gq < 4; ++gq) { f32x4 mr[4][4];
#pragma unroll
                    for (int i = 0; i < 4; ++i)
#pragma unroll
                        for (int q4 = 0; q4 <= gq; ++q4) mr[i][q4] = *(const LAS f32x4*)(Mf + (4 * gq + i) * 32 + 4 * q4);
#pragma unroll
                    for (int i = 0; i < 4; ++i) { const int t = 4 * gq + i; float acc = (t == c) ? 1.f : 0.f;
#pragma unroll
                        for (int q4 = 0; q4 <= gq; ++q4)
#pragma unroll
                            for (int e = 0; e < 4; ++e) if (4 * q4 + e < t) acc += mr[i][q4][e] * x[4 * q4 + e];
                        x[t] = acc; if (lane < 16) *(LAS u16*)(sb + SL_T2 + (t * 2 + hc) * 16 + 2 * ec) = bfc(acc); } }
#pragma unroll
                for (int gq = 0; gq < 4; ++gq) { f32x4 mr[4][4];
#pragma unroll
                    for (int i = 0; i < 4; ++i)
#pragma unroll
                        for (int q4 = 0; q4 <= gq; ++q4) mr[i][q4] = *(const LAS f32x4*)(Mf + (16 + 4 * gq + i) * 32 + 4 * q4);
#pragma unroll
                    for (int i = 0; i < 4; ++i) { const int t = 4 * gq + i; float acc = 0.f;
#pragma unroll
                        for (int q4 = 0; q4 <= gq; ++q4)
#pragma unroll
                            for (int e = 0; e < 4; ++e) if (4 * q4 + e <= t) acc += mr[i][q4][e] * x[4 * q4 + e];
                        if (lane < 16) *(LAS u16*)(sb + SL_T2 + ((16 + t) * 2 + hc) * 16 + 2 * ec) = bfc(acc); } }
                {   const f32x4 m0 = *(const LAS f32x4*)(Mf + r * 32 + 16 + 4 * h), m1 = *(const LAS f32x4*)(Mf + r * 32 + 24 + 4 * h);
                    u32x4 w; w.x = pkc(m0.x, m0.y); w.y = pkc(m0.z, m0.w); w.z = pkc(m1.x, m1.y); w.w = pkc(m1.z, m1.w);
                    *(LAS u32x4*)(sb + SL_MK + (r * 2 + h) * 16) = w; }
            }
            SC_BAR();
            if (wave < 2) { const int ib = wave;
                if (nroles == 2 && bt > 0) {
                    unsigned* fl = hflag + (u * 2 + ib) * 16;
                    while (__hip_atomic_load(fl, __ATOMIC_RELAXED, __HIP_MEMORY_SCOPE_AGENT) < (unsigned)bt) __builtin_amdgcn_s_sleep(1);
                    const unsigned* sl = (const unsigned*)(hslot + (size_t)((u * 2 + ib) * 2 + (role ^ 1)) * 2048);
#pragma unroll
                    for (int g = 0; g < 16; ++g) { X0[g] = __uint_as_float(__hip_atomic_load(sl + g * 64 + lane, __ATOMIC_RELAXED, __HIP_MEMORY_SCOPE_AGENT)); X1[g] = __uint_as_float(__hip_atomic_load(sl + 1024 + g * 64 + lane, __ATOMIC_RELAXED, __HIP_MEMORY_SCOPE_AGENT)); } }
                for (int c2 = 0; c2 < 8; ++c2) { LAS unsigned char* s2 = lds + c2 * SL_SIZE;
                    const bf16x8 vfrag = *(const LAS bf16x8*)(s2 + SL_VT + (ib * 32 + r) * 32 + h * 16), mk = *(const LAS bf16x8*)(s2 + SL_MK + (r * 2 + h) * 16);
                    f32x16 out;
#pragma unroll
                    for (int g = 0; g < 16; ++g) out[g] = 0.f;
                    out = MFMA32(mk, vfrag, out);
                    out = MFMA32(*(const LAS bf16x8*)(s2 + SL_AR + 0 * SL_QS + r * 32 + h * 16), pack_lo(X0), out);
                    out = MFMA32(*(const LAS bf16x8*)(s2 + SL_AR + 1 * SL_QS + r * 32 + h * 16), pack_hi(X0), out);
                    out = MFMA32(*(const LAS bf16x8*)(s2 + SL_AR + 2 * SL_QS + r * 32 + h * 16), pack_lo(X1), out);
                    out = MFMA32(*(const LAS bf16x8*)(s2 + SL_AR + 3 * SL_QS + r * 32 + h * 16), pack_hi(X1), out);
                    f32x16 sat;
#pragma unroll
                    for (int g = 0; g < 16; ++g) sat[g] = 0.f;
                    sat = MFMA32(*(const LAS bf16x8*)(s2 + SL_T2 + (r * 2 + h) * 16), pack_lo(out), sat);
                    LAS float* yb = (LAS float*)(s2 + SL_BK);
#pragma unroll
                    for (int e = 0; e < 8; ++e) { const int tm = 8 * (e >> 2) + 4 * h + (e & 3); yb[tm * 64 + ib * 32 + r] = out[8 + e] + sat[8 + e]; }
                    const bf16x8 sfrag = pack_lo(sat);
                    X0 = MFMA32(*(const LAS bf16x8*)(s2 + SL_KT + r * 32 + h * 16), vfrag, X0);
                    X1 = MFMA32(*(const LAS bf16x8*)(s2 + SL_KT + (32 + r) * 32 + h * 16), vfrag, X1);
                    X0 = MFMA32(*(const LAS bf16x8*)(s2 + SL_BT + r * 32 + h * 16), sfrag, X0);
                    X1 = MFMA32(*(const LAS bf16x8*)(s2 + SL_BT + (32 + r) * 32 + h * 16), sfrag, X1);
#pragma unroll
                    for (int q4 = 0; q4 < 4; ++q4) { const f32x4 w0 = *(const LAS f32x4*)(s2 + SL_WL + (8 * q4 + 4 * h) * 4), w1 = *(const LAS f32x4*)(s2 + SL_WL + (32 + 8 * q4 + 4 * h) * 4);
#pragma unroll
                        for (int e = 0; e < 4; ++e) { X0[4 * q4 + e] *= w0[e]; X1[4 * q4 + e] *= w1[e]; } } }
                if (nroles == 2 && bt + 1 < nbatch) {
                    unsigned* sl = (unsigned*)(hslot + (size_t)((u * 2 + ib) * 2 + role) * 2048);
#pragma unroll
                    for (int g = 0; g < 16; ++g) { __hip_atomic_store(sl + g * 64 + lane, __float_as_uint(X0[g]), __ATOMIC_RELAXED, __HIP_MEMORY_SCOPE_AGENT); __hip_atomic_store(sl + 1024 + g * 64 + lane, __float_as_uint(X1[g]), __ATOMIC_RELAXED, __HIP_MEMORY_SCOPE_AGENT); }
                    asm volatile("s_waitcnt vmcnt(0)" ::: "memory");
                    if (lane == 0) __hip_atomic_store(hflag + (u * 2 + ib) * 16, (unsigned)(bt + 1), __ATOMIC_RELAXED, __HIP_MEMORY_SCOPE_AGENT); } }
            SC_BAR();
            int tf = tid; asm volatile("" : "+v"(tf));
#pragma unroll
            for (int k8 = 0; k8 < 8; ++k8) { const int idx = tf + 512 * k8, slot = idx >> 9, tm = (idx >> 5) & 15, cp = idx & 31; const int n = bt * 8 + slot;
                const int tl = z ? (T - 1 - (16 * n + tm)) : (16 * n + tm); unsigned* addr = (unsigned*)((char*)Y + (unsigned)((((int)seqbase + tl) * 1024 + hd * 64 + 2 * cp) * 2));
                const LAS float* yb = (const LAS float*)(lds + slot * SL_SIZE + SL_BK); *addr = pk2(yb[tm * 64 + 2 * cp], yb[tm * 64 + 2 * cp + 1]); }
            SC_BAR();
        }
#undef SC_LOAD
#undef SC_BAR
    }
}

enum { PH_PREP = 0, PH_L0_NORM, PH_L0_GEMM_IN, PH_L0_CONV_FFTA, PH_L0_GEMM_DFT, PH_L0_GEMM_OUT, PH_F0_NORM, PH_F0 = 7  , PH_L1 = 19  , PH_F1_NORM = 37, PH_F1 = 38  , PH_FINAL = 50, PH_COUNT = 51 };

__device__ __forceinline__ void ffn_phase(unsigned char* ws, unsigned char* ob, LAS unsigned char* lds, int l, int sub) {
    const int chunk = sub / 3, op = sub % 3;
    if (op == 0) { EpiPlain E{(u16*)(ws + OFF_U), 5632}; gemm_phase(lds, (const u16*)(ws + OFF_H) + (size_t)chunk * 16384 * 1024, 1024, (const u16*)(ws + OFF_WUP) + (size_t)l * 5632 * 1024, 1024, 64, 22, 1024, E); }
    else if (op == 1) act_phase(ws, ob, lds, l, chunk);
    else { EpiResid E{(u16*)(ws + OFF_X) + (size_t)chunk * 16384 * 1024}; gemm_phase(lds, (const u16*)(ob + OUT_ACT), 2816, (const u16*)(ws + OFF_WDN) + (size_t)l * 1024 * 2816, 2816, 64, 4, 2816, E); }
}

__global__ void __launch_bounds__(512, 2) mk_fwd(P p) {
    extern __shared__ __attribute__((aligned(16))) unsigned char smem[];
    LAS unsigned char* lds = (LAS unsigned char*)smem;
    if (threadIdx.x < 31) ((LAS unsigned long long*)(lds + LDS_TAB))[threadIdx.x] = (unsigned long long)p.in[threadIdx.x];
    if (threadIdx.x == 0) { volatile LAS unsigned* xst = (volatile LAS unsigned*)(lds + LDS_TAB + 256); xst[0] = 0u; xst[1] = 0u; xst[2] = 0u;
        (void)xb_add(&((unsigned*)(p.ws + OFF_BAR))[XB_XCNT(xb_xcc_id())], 1u); }
    __syncthreads();
    for (int ph = p.ph_lo; ph < p.ph_hi; ++ph) {
        size_t oz = 0; asm volatile("" : "+s"(oz));
        unsigned char* ws = p.ws + oz; unsigned char* ob = (unsigned char*)p.out + oz;
        if (TM(0) && ph == PH_PREP) { prep_phase(ws, ob, lds); __syncthreads(); norm0_phase(ws, ob, lds); }
        else if (ph == PH_L0_NORM) continue;
        else if (TM(2) && ph == PH_L0_GEMM_IN) {
            { EpiPlain E{(u16*)(ob + OUT_PROJ), 1536}; gemm_phase(lds, (const u16*)(ws + OFF_H), 1024, (const u16*)(ws + OFF_WC), 1024, 256, 6, 1024, E); }
            __syncthreads();
            { EpiPlain E{(u16*)(ob + OUT_FT), 65536}; gemm_phase(lds, (const u16*)(ws + OFF_WF), 1024, (const u16*)(ws + OFF_H), 1024, 2, 256, 1024, E); }
        }
        else if (TM(3) && ph == PH_L0_CONV_FFTA) { yconv_phase(ws, ob, lds); __syncthreads(); stageA_phase(ws, ob, lds); }
        else if (TM(4) && ph == PH_L0_GEMM_DFT) { EpiDft E{(u16*)(ws + OFF_CAT)}; gemm_phase(lds, (const u16*)(ws + OFF_DFTA), 512, (const u16*)(ws + OFF_YP), 512, 2, 512, 512, E); }
        else if (TM(5) && ph == PH_L0_GEMM_OUT) { EpiOut0 E{IN(0), IN(1), (u16*)(ws + OFF_X)}; gemm_phase(lds, (const u16*)(ws + OFF_CAT), 1536, (const u16*)(ws + OFF_WEFF), 1536, 256, 4, 1536, E); }
        else if (TM(6) && ph == PH_F0_NORM) normx_phase(ws, ob, IN(3), 0);
        else if (TM(7) && ph >= PH_F0 && ph < PH_F0 + 12) ffn_phase(ws, ob, lds, 0, ph - PH_F0);
        else if (TM(8) && ph >= PH_L1 && ph < PH_L1 + 18) { const int hf = (ph - PH_L1) / 9, op = (ph - PH_L1) % 9;
            if (TM(10) && op == 0) norm1_phase(ws, ob, lds, hf);
            else if (TM(11) && op == 1) {
                { EpiRkvP E{(u16*)(ob + OUT_RKV), (size_t)HT * 1024, (u16*)(ob + OUT_P)};
                    gemm_phase(lds, (const u16*)(ws + OFF_HH), 1024, (const u16*)(ws + OFF_WRKV), 1024, 128, 15, 1024, E, 2, (size_t)HT * 1024 * 2); }
            }
            else if (TM(12) && op == 2) lprep_phase(ws, ob, hf);
            else if (TM(13) && op == 3) { EpiUp2 E{(u16*)(ws + OFF_D4), IN(14), IN(17)}; gemm_phase(lds, (const u16*)(ws + OFF_L), 256, (const u16*)(ws + OFF_WUP2), 256, 128, 16, 256, E); }
            else if (TM(14) && op == 4) rwprep_phase(ws, ob, lds);
            else if (TM(15) && op == 5) scan_phase(ws, ob, lds, hf);
            else if (TM(16) && op == 6) { EpiPlain E{(u16*)(ws + OFF_G), 1024}; gemm_phase(lds, (const u16*)(ws + OFF_LG), 256, (const u16*)(ws + OFF_WG2), 256, 128, 4, 256, E); }
            else if (TM(17) && op == 7) gn_phase(ws, ob, lds);
            else if (TM(18)) { EpiResid E{(u16*)(ws + OFF_X) + (size_t)hf * HT * 1024}; gemm_phase(lds, (const u16*)(ws + OFF_YG), 1024, (const u16*)(ws + OFF_WO), 1024, 128, 4, 1024, E); }
        }
        else if (TM(6) && ph == PH_F1_NORM) normx_phase(ws, ob, IN(3) + 1024, 0);
        else if (TM(7) && ph >= PH_F1 && ph < PH_F1 + 12) ffn_phase(ws, ob, lds, 1, ph - PH_F1);
        else if (TM(9) && ph == PH_FINAL) normx_phase(ws, ob, IN(4), 1);
        if (ph + 1 < p.ph_hi) {
            if (p.ph_hi < 0) cg::this_grid().sync();
            grid_bar((unsigned*)(p.ws + OFF_BAR), (volatile LAS unsigned*)(lds + LDS_TAB + 256));
        }
    }
}

extern "C" void kernel_launch(void* const* d_in, const int* in_sizes, int n_in, void* d_out, int out_size, void* d_ws, size_t ws_size, hipStream_t stream) {
    static int grid = 0;
    if (grid == 0) {
        if (n_in != 31 || ws_size < WS_NEED || out_size != 65536 * 1024) { fprintf(stderr, "kernel_launch: unexpected shapes (n_in %d, ws %zu, out %d)\n", n_in, ws_size, out_size); grid = -1; return; }
        int dev = 0, cus = 0, per_cu = 0;
        hipGetDevice(&dev); hipDeviceGetAttribute(&cus, hipDeviceAttributeMultiprocessorCount, dev);
        if (hipFuncSetAttribute((const void*)mk_fwd, hipFuncAttributeMaxDynamicSharedMemorySize, LDS_BYTES) != hipSuccess) { fprintf(stderr, "kernel_launch: hipFuncSetAttribute failed\n"); grid = -1; return; }
        if (hipOccupancyMaxActiveBlocksPerMultiprocessor(&per_cu, (const void*)mk_fwd, 512, LDS_BYTES) != hipSuccess || per_cu < 1) { fprintf(stderr, "kernel_launch: occupancy query says %d\n", per_cu); per_cu = 1; }
        (void)hipGetLastError();
        grid = cus * per_cu;
    }
    if (grid < 0) return;
    if (hipMemsetAsync((unsigned char*)d_ws + OFF_BAR, 0, 16384 + 128 * 2 * 64, stream) != hipSuccess) { fprintf(stderr, "kernel_launch: memset failed\n"); return; }
    P p{};
    for (int i = 0; i < 31; ++i) p.in[i] = (const float*)d_in[i];
    p.out = (float*)d_out; p.ws = (unsigned char*)d_ws;
#if MK_PER_PHASE
    for (int ph = 0; ph < PH_COUNT; ++ph) { p.ph_lo = ph; p.ph_hi = ph + 1; hipLaunchKernelGGL(mk_fwd, dim3(grid), dim3(512), LDS_BYTES, stream, p); }
#else
    p.ph_lo = 0; p.ph_hi = PH_COUNT;
    void* args[] = {&p};
    hipError_t e = hipLaunchCooperativeKernel((const void*)mk_fwd, dim3(grid), dim3(512), args, LDS_BYTES, stream);
    if (e != hipSuccess) fprintf(stderr, "kernel_launch: cooperative launch failed: %s (grid %d)\n", hipGetErrorString(e), grid);
#endif
}
```

```cpp
#include <hip/hip_runtime.h>
#include <hip/hip_cooperative_groups.h>
#include <cstdio>
namespace cg = cooperative_groups;

#ifndef PROBE_DUP
#define PROBE_DUP 0
#define PROBE_LO 0
#define PROBE_HI 0
#endif
#ifndef MK_PER_PHASE
#define MK_PER_PHASE 0
#endif

#ifndef TESTMASK
#define TESTMASK 0xFFFFFFF
#endif
#define TM(k) ((TESTMASK >> (k)) & 1)
#define LAS __attribute__((address_space(3)))
typedef unsigned short u16;
typedef short bf16x8 __attribute__((ext_vector_type(8)));
typedef float f32x4 __attribute__((ext_vector_type(4)));
typedef unsigned u32x4 __attribute__((ext_vector_type(4)));
typedef unsigned u32x2 __attribute__((ext_vector_type(2)));

__device__ __forceinline__ int opaque_tid() { int t = threadIdx.x; asm volatile("" : "+v"(t)); return t; }
constexpr int LDS_BYTES = 160 * 1024;
constexpr int LDS_TAB = LDS_BYTES - 512;
__device__ __forceinline__ const float* in_ptr(LAS unsigned char* lds, int i) {
    const LAS unsigned* t = (const LAS unsigned*)(lds + LDS_TAB) + 2 * i; const unsigned lo = __builtin_amdgcn_readfirstlane(t[0]), hi = __builtin_amdgcn_readfirstlane(t[1]);
    return (const float*)(((unsigned long long)hi << 32) | lo); }
#define IN(i) in_ptr(lds, (i))
constexpr size_t MiB = 1ull << 20;
constexpr int HT = 32768;
constexpr size_t OFF_WC = 0;
constexpr size_t OFF_WF = OFF_WC + 1536ull * 1024 * 2;
constexpr size_t OFF_WEFF = OFF_WF + 512ull * 1024 * 2;
constexpr size_t OFF_DFTA = OFF_WEFF + 1024ull * 1536 * 2;
constexpr size_t OFF_WUP = OFF_DFTA + 512ull * 512 * 2;
constexpr size_t OFF_WDN = OFF_WUP + 2ull * 5632 * 1024 * 2;
constexpr size_t OFF_WRKV = OFF_WDN + 2ull * 1024 * 2816 * 2;
constexpr size_t OFF_WLORA = OFF_WRKV + 3072ull * 1024 * 2;
constexpr size_t OFF_WRKV_END = OFF_WRKV + 3072ull * 2048 * 2;
constexpr size_t OFF_WUP2 = OFF_WRKV_END + 768ull * 1024 * 2;
constexpr size_t OFF_WG2 = OFF_WUP2 + 4096ull * 256 * 2;
constexpr size_t OFF_WO = OFF_WG2 + 1024ull * 256 * 2;
constexpr size_t OFF_WEND = OFF_WO + 1024ull * 1024 * 2;
static_assert(OFF_WEND <= 60 * MiB, "weights region");
constexpr size_t OFF_X = 64 * MiB;
constexpr size_t OFF_R0 = 192 * MiB;
constexpr size_t WS_NEED = 512 * MiB;
constexpr size_t OFF_H = OFF_R0;
constexpr size_t OFF_YP = OFF_R0;
constexpr size_t OFF_CAT = OFF_R0 + 128 * MiB;
constexpr size_t OUT_PROJ = 0;
constexpr size_t OUT_FT = 192 * MiB;
constexpr size_t OFF_U = OFF_R0 + 128 * MiB;
constexpr size_t OUT_ACT = 0;
constexpr size_t OFF_HH = OFF_R0;
constexpr size_t OUT_RKV = 0;
constexpr size_t OUT_P = 192 * MiB;
constexpr size_t OUT_Y = 192 * MiB;
constexpr size_t OFF_D4 = OFF_R0;
constexpr size_t OFF_L = OFF_R0 + 256 * MiB;
constexpr size_t OFF_LG = OFF_R0 + 272 * MiB;
constexpr size_t OFF_INV = OFF_R0 + 288 * MiB;
constexpr size_t OFF_BON = OFF_R0 + 290 * MiB;
constexpr size_t OFF_G = OFF_R0;
constexpr size_t OFF_YG = OFF_R0 + 64 * MiB;

constexpr size_t OFF_HSLOT = 60 * MiB;
constexpr size_t OFF_BAR = 59 * MiB;
struct P { const float* in[31]; float* out; unsigned char* ws; int ph_lo, ph_hi; };

__device__ __forceinline__ float bflo(unsigned w) { return __uint_as_float(w << 16); }
__device__ __forceinline__ float bfhi(unsigned w) { return __uint_as_float(w & 0xffff0000u); }
__device__ __forceinline__ float bf2f(u16 v) { return __uint_as_float((unsigned)v << 16); }
__device__ __forceinline__ unsigned pk2(float lo, float hi) { unsigned r; asm("v_cvt_pk_bf16_f32 %0, %1, %2" : "=v"(r) : "v"(lo), "v"(hi)); return r; }
__device__ __forceinline__ u16 f2bf(float v) { return (u16)(pk2(v, 0.f) & 0xffffu); }
__device__ __forceinline__ u32x4 pk8(const float* v) { u32x4 o; o.x = pk2(v[0], v[1]); o.y = pk2(v[2], v[3]); o.z = pk2(v[4], v[5]); o.w = pk2(v[6], v[7]); return o; }
__device__ __forceinline__ void unpk8(u32x4 w, float* v) { v[0] = bflo(w.x); v[1] = bfhi(w.x); v[2] = bflo(w.y); v[3] = bfhi(w.y); v[4] = bflo(w.z); v[5] = bfhi(w.z); v[6] = bflo(w.w); v[7] = bfhi(w.w); }
#define DPP_ADD(v, ctrl) v += __int_as_float(__builtin_amdgcn_update_dpp(0, __float_as_int(v), ctrl, 0xF, 0xF, true))
__device__ __forceinline__ float allreduce16(float v) { DPP_ADD(v, 0xB1); DPP_ADD(v, 0x4E); DPP_ADD(v, 0x141); DPP_ADD(v, 0x140); return v; }
__device__ __forceinline__ float wave_sum(float v) {
    v = allreduce16(v);
    const float a = __int_as_float(__builtin_amdgcn_readlane(__float_as_int(v), 0)), b = __int_as_float(__builtin_amdgcn_readlane(__float_as_int(v), 16)),
                c = __int_as_float(__builtin_amdgcn_readlane(__float_as_int(v), 32)), d = __int_as_float(__builtin_amdgcn_readlane(__float_as_int(v), 48));
    return (a + b) + (c + d); }
__device__ __forceinline__ float allreduce4(float v) { DPP_ADD(v, 0xB1); DPP_ADD(v, 0x4E); return v; }
__device__ __forceinline__ float sigmoidf_(float x) { return __builtin_amdgcn_rcpf(1.f + __expf(-x)); }
__device__ __forceinline__ int seqT(int t) { return t < HT ? 4096 : 8192; }

#define XB_XCNT(j)  (256  + 64 * (j))
#define XB_XSUB(j)  (1280 + 64 * (j))
#define XB_XGEN(j)  (2304 + 64 * (j))
#define XB_TOP      3328
#define XB_TOPGEN   3392
#define XCD_BAR_WORDS 3456
__device__ __forceinline__ unsigned xb_ld(unsigned* p)              { return __hip_atomic_load(p, __ATOMIC_RELAXED, __HIP_MEMORY_SCOPE_AGENT); }
__device__ __forceinline__ unsigned xb_add(unsigned* p, unsigned v) { return __hip_atomic_fetch_add(p, v, __ATOMIC_RELAXED, __HIP_MEMORY_SCOPE_AGENT); }
__device__ __forceinline__ unsigned xb_xcc_id() { return (unsigned)__builtin_amdgcn_s_getreg((3 << 11) | 20) & 0xFu; }
__device__ __forceinline__ void grid_bar(unsigned* bar, volatile LAS unsigned* st) {
    asm volatile("s_waitcnt vmcnt(0)" ::: "memory");
    __syncthreads();
    if (threadIdx.x == 0) {
        __builtin_amdgcn_s_waitcnt(0);
        const unsigned x = xb_xcc_id();
        unsigned nloc = st[0], nx = st[1]; const unsigned gen = st[2]; st[2] = gen + 1u;
        if (nloc == 0u) {
            for (;;) { unsigned sum = 0u, cnt = 0u, mine = 0u;
#pragma unroll 1
                for (unsigned j = 0; j < 16; ++j) { const unsigned c = xb_ld(&bar[XB_XCNT(j)]); sum += c; cnt += (c > 0u) ? 1u : 0u; mine = (j == x) ? c : mine; }
                if (sum == gridDim.x) { nloc = mine; nx = cnt; break; }
                __builtin_amdgcn_s_sleep(1); }
            st[0] = nloc; st[1] = nx; }
        const unsigned old = xb_add(&bar[XB_XSUB(x)], 1u);
        if (old + 1u == (gen + 1u) * nloc) {
            __builtin_amdgcn_fence(__ATOMIC_RELEASE, "agent");
            asm volatile("s_waitcnt vmcnt(0)" ::: "memory");
            const unsigned og = xb_add(&bar[XB_TOP], 1u);
            if (og + 1u == (gen + 1u) * nx) xb_add(&bar[XB_TOPGEN], 1u);
            else while (xb_ld(&bar[XB_TOPGEN]) == gen) __builtin_amdgcn_s_sleep(1);
            __builtin_amdgcn_fence(__ATOMIC_ACQUIRE, "agent");
            xb_add(&bar[XB_XGEN(x)], 1u);
            asm volatile("s_waitcnt vmcnt(0)" ::: "memory");
        } else {
            while (xb_ld(&bar[XB_XGEN(x)]) == gen) __builtin_amdgcn_s_sleep(1);
            __builtin_amdgcn_fence(__ATOMIC_ACQUIRE, "agent");
            asm volatile("s_waitcnt vmcnt(0)" ::: "memory");
        }
    }
    __syncthreads();
}
constexpr int HTB = 128 * 64 * 2;
__device__ __forceinline__ int lds_byte(int r, int c) { const int st = (r >> 4) * 2 + (c >> 5), rr = r & 15, cc = c & 31, ob = rr * 64 + cc * 2; return st * 1024 + (ob ^ (((ob >> 9) & 1) << 5)); }
__device__ __forceinline__ void stage_rc(int b, int& R, int& C) { const int st = b / 1024, sb = b % 1024, swz = sb ^ (((sb >> 9) & 1) << 5); R = (st >> 1) * 16 + swz / 64; C = (st & 1) * 32 + (swz % 64) / 2; }
__device__ __forceinline__ int perm32(int rho) { const int n = rho >> 4, i = rho & 15; return 8 * (i >> 2) + 4 * n + (i & 3); }
struct Unit { int pm, pn; };
__device__ __forceinline__ bool next_unit(int i, int nM, int nN, Unit& u) {
    const int nwg = nM * nN; const long L = (long)i * (long)gridDim.x + blockIdx.x; if (L >= nwg) return false;
    int wgid = (int)L; { const int q = nwg / 8, r = nwg % 8, xcd = wgid % 8, off = wgid / 8; wgid = (xcd < r ? xcd * (q + 1) : r * (q + 1) + (xcd - r) * q) + off; }
    const int nig = 8 * nN, gid = wgid / nig, fm = gid * 8, gsz = (nM - fm) < 8 ? (nM - fm) : 8;
    u.pm = fm + ((wgid % nig) % gsz); u.pn = (wgid % nig) / gsz; return true;
}

template <class Epi>
__device__ __forceinline__ void gemm_phase(LAS unsigned char* lds, const u16* A, int lda, const u16* Bt, int ldb, int nM, int nN, int K, const Epi& E, int ashift = 31, size_t astride = 0) {
    int tid = opaque_tid();
    const int wid = __builtin_amdgcn_readfirstlane(tid >> 6), lane = tid & 63, wr = wid >> 2, wc = wid & 3, fr = lane & 15, fq = lane >> 4;
    const int nt = K / 64;
    unsigned voffA[2], voffB[2];
#pragma unroll
    for (int i = 0; i < 2; ++i) { int R, C; stage_rc(tid * 16 + i * 8192, R, C); const int Rb = (R & ~31) + perm32(R & 31);
        voffA[i] = (unsigned)(R * lda + C) * 2u; voffB[i] = (unsigned)(Rb * ldb + C) * 2u; }
    const size_t kstep = 128;
    const size_t hstepA = (size_t)128 * lda * 2, hstepB = (size_t)128 * ldb * 2, tstepA = 2 * hstepA, tstepB = 2 * hstepB;
    const unsigned ldsw = (unsigned)wid * 1024u;
    const int aoff = lds_byte(wr * 64 + fr, fq * 8), boff = lds_byte(wc * 32 + fr, fq * 8);
#define G_SA(b, h) (((b) * 2 + (h)) * HTB)
#define G_SB(b, h) ((4 + (b) * 2 + (h)) * HTB)
#define G_STAGE(bufoff, gbase, voff) do { _Pragma("unroll") for (int _i = 0; _i < 2; ++_i) \
        __builtin_amdgcn_global_load_lds((const unsigned*)((const char*)(gbase) + (voff)[_i]), (LAS unsigned*)(lds + (bufoff) + ldsw + _i * 8192), 16, 0, 0); } while (0)
#define G_LDA(dst, b, h) do { _Pragma("unroll") for (int m = 0; m < 4; ++m) _Pragma("unroll") for (int k = 0; k < 2; ++k) dst[m][k] = *(const LAS bf16x8*)(lds + G_SA(b, h) + aoff + m * 2048 + k * 1024); } while (0)
#define G_LDB(dst, b, h) do { _Pragma("unroll") for (int n = 0; n < 2; ++n) _Pragma("unroll") for (int k = 0; k < 2; ++k) dst[n][k] = *(const LAS bf16x8*)(lds + G_SB(b, h) + boff + n * 2048 + k * 1024); } while (0)
#define G_MMA(ai, bj, At, Bt_) do { __builtin_amdgcn_s_setprio(1); _Pragma("unroll") for (int m = 0; m < 4; ++m) _Pragma("unroll") for (int n = 0; n < 2; ++n) _Pragma("unroll") for (int k = 0; k < 2; ++k) \
        acc[ai][bj][m][n] = __builtin_amdgcn_mfma_f32_16x16x32_bf16(Bt_[n][k], At[m][k], acc[ai][bj][m][n], 0, 0, 0); __builtin_amdgcn_s_setprio(0); } while (0)
#define G_WAIT_V(n) asm volatile("s_waitcnt vmcnt(" #n ")" ::: "memory")
#define G_WAIT_L(n) asm volatile("s_waitcnt lgkmcnt(" #n ")" ::: "memory")
#define G_BAR __builtin_amdgcn_s_barrier()
#define G_SCHED __builtin_amdgcn_sched_barrier(0)
    Unit cur, nxt; int ui = 0;
    if (!next_unit(0, nM, nN, cur)) return;
    f32x4 acc[2][2][4][2];
#pragma unroll
    for (int a = 0; a < 2; ++a)
#pragma unroll
        for (int b = 0; b < 2; ++b)
#pragma unroll
            for (int m = 0; m < 4; ++m)
#pragma unroll
                for (int n = 0; n < 2; ++n) acc[a][b][m][n] = (f32x4){0.f, 0.f, 0.f, 0.f};
    bf16x8 At[4][2], B0[2][2], B1[2][2];
    const char* cA = (const char*)A + (size_t)(cur.pn >> ashift) * astride + (size_t)cur.pm * tstepA; const char* cB = (const char*)Bt + (size_t)cur.pn * tstepB;
    G_STAGE(G_SB(0, 0), cB, voffB); G_STAGE(G_SA(0, 0), cA, voffA); G_STAGE(G_SB(0, 1), cB + hstepB, voffB); G_STAGE(G_SA(0, 1), cA + hstepA, voffA);
    if (wr == 1) G_BAR;
    G_WAIT_V(4); G_BAR;
    G_STAGE(G_SB(1, 0), cB + kstep, voffB); G_STAGE(G_SA(1, 0), cA + kstep, voffA); G_STAGE(G_SB(1, 1), cB + hstepB + kstep, voffB);
    G_WAIT_V(6); G_BAR;
    for (;;) {
        const bool has_next = next_unit(ui + 1, nM, nN, nxt);
        const char* nA = has_next ? (const char*)A + (size_t)(nxt.pn >> ashift) * astride + (size_t)nxt.pm * tstepA : cA; const char* nB = has_next ? (const char*)Bt + (size_t)nxt.pn * tstepB : cB;
        for (int t = 0; t < nt; t += 2) {
            const bool last = (t == nt - 2);
            const char* a1 = cA + (size_t)(t + 1) * kstep;
            const char* a2 = last ? nA : cA + (size_t)(t + 2) * kstep; const char* b2 = last ? nB : cB + (size_t)(t + 2) * kstep;
            const char* a3 = a2 + kstep; const char* b3 = b2 + kstep;
            G_LDB(B0, 0, 0); G_SCHED; G_LDA(At, 0, 0); G_STAGE(G_SA(1, 1), a1 + hstepA, voffA);
            G_WAIT_L(8); G_BAR; G_WAIT_L(0); G_MMA(0, 0, At, B0); G_BAR; G_SCHED;
            G_LDB(B1, 0, 1); G_STAGE(G_SB(0, 0), b2, voffB);
            G_BAR; G_WAIT_L(0); G_MMA(0, 1, At, B1); G_BAR;
            G_LDA(At, 0, 1); G_STAGE(G_SA(0, 0), a2, voffA);
            G_BAR; G_WAIT_L(0); G_MMA(1, 0, At, B0); G_BAR; G_SCHED;
            G_STAGE(G_SB(0, 1), b2 + hstepB, voffB);
            G_WAIT_V(6); G_BAR; G_MMA(1, 1, At, B1); G_BAR;
            G_LDB(B0, 1, 0); G_SCHED; G_LDA(At, 1, 0); G_STAGE(G_SA(0, 1), a2 + hstepA, voffA);
            G_WAIT_L(8); G_BAR; G_WAIT_L(0); G_MMA(0, 0, At, B0); G_BAR; G_SCHED;
            G_LDB(B1, 1, 1); G_STAGE(G_SB(1, 0), b3, voffB);
            G_BAR; G_WAIT_L(0); G_MMA(0, 1, At, B1); G_BAR;
            G_LDA(At, 1, 1); G_STAGE(G_SA(1, 0), a3, voffA);
            G_BAR; G_WAIT_L(0); G_MMA(1, 0, At, B0); G_BAR; G_SCHED;
            G_STAGE(G_SB(1, 1), b3 + hstepB, voffB);
            G_WAIT_V(6); G_BAR; G_MMA(1, 1, At, B1); G_BAR;
        }
        {
            const int row0 = cur.pm * 256 + wr * 64 + fr, col0 = cur.pn * 256 + wc * 32 + 8 * fq;
            if constexpr (Epi::PRE == 1) {
#pragma unroll
                for (int ai = 0; ai < 2; ++ai) { u32x4 pre[8];
#pragma unroll
                    for (int m = 0; m < 4; ++m)
#pragma unroll
                        for (int bj = 0; bj < 2; ++bj) pre[m * 2 + bj] = E.pre(row0 + ai * 128 + m * 16, col0 + bj * 128);
#pragma unroll
                    for (int m = 0; m < 4; ++m)
#pragma unroll
                        for (int bj = 0; bj < 2; ++bj) E.store(row0 + ai * 128 + m * 16, col0 + bj * 128, acc[ai][bj][m][0], acc[ai][bj][m][1], pre[m * 2 + bj]); } }
            else if constexpr (Epi::PRE == 2) {
#pragma unroll
                for (int bj = 0; bj < 2; ++bj) { f32x4 cb0, cb1; E.cpre(col0 + bj * 128, cb0, cb1);
#pragma unroll
                    for (int ai = 0; ai < 2; ++ai)
#pragma unroll
                        for (int m = 0; m < 4; ++m) E.store(row0 + ai * 128 + m * 16, col0 + bj * 128, acc[ai][bj][m][0], acc[ai][bj][m][1], cb0, cb1); } }
            else if constexpr (Epi::PRE == 3) {
#pragma unroll
                for (int ai = 0; ai < 2; ++ai)
#pragma unroll
                    for (int mp = 0; mp < 2; ++mp) { f32x4 pa[4], pb[4];
#pragma unroll
                        for (int mm = 0; mm < 2; ++mm)
#pragma unroll
                            for (int bj = 0; bj < 2; ++bj) E.pre2(row0 + ai * 128 + (2 * mp + mm) * 16, col0 + bj * 128, pa[mm * 2 + bj], pb[mm * 2 + bj]);
#pragma unroll
                        for (int mm = 0; mm < 2; ++mm)
#pragma unroll
                            for (int bj = 0; bj < 2; ++bj) E.store(row0 + ai * 128 + (2 * mp + mm) * 16, col0 + bj * 128, acc[ai][bj][2 * mp + mm][0], acc[ai][bj][2 * mp + mm][1], pa[mm * 2 + bj], pb[mm * 2 + bj]); } }
            else {
#pragma unroll
                for (int ai = 0; ai < 2; ++ai)
#pragma unroll
                    for (int m = 0; m < 4; ++m)
#pragma unroll
                        for (int bj = 0; bj < 2; ++bj) E.store(row0 + ai * 128 + m * 16, col0 + bj * 128, acc[ai][bj][m][0], acc[ai][bj][m][1]); }
        }
        if (!has_next) break;
#pragma unroll
        for (int a = 0; a < 2; ++a)
#pragma unroll
            for (int b = 0; b < 2; ++b)
#pragma unroll
                for (int m = 0; m < 4; ++m)
#pragma unroll
                    for (int n = 0; n < 2; ++n) acc[a][b][m][n] = (f32x4){0.f, 0.f, 0.f, 0.f};
        cur = nxt; cA = nA; cB = nB; ++ui;
    }
    G_WAIT_V(0);
    if (wr == 0) G_BAR;
    G_BAR;
#undef G_SA
#undef G_SB
#undef G_STAGE
#undef G_LDA
#undef G_LDB
#undef G_MMA
#undef G_WAIT_V
#undef G_WAIT_L
#undef G_BAR
#undef G_SCHED
}

__device__ __forceinline__ u32x4 pkv(f32x4 v0, f32x4 v1) { u32x4 w; w.x = pk2(v0.x, v0.y); w.y = pk2(v0.z, v0.w); w.z = pk2(v1.x, v1.y); w.w = pk2(v1.z, v1.w); return w; }
struct EpiPlain { static constexpr int PRE = 0; u16* O; size_t ld;
    __device__ __forceinline__ void store(int row, int col, f32x4 v0, f32x4 v1) const { *(u32x4*)(O + (size_t)row * ld + col) = pkv(v0, v1); } };
struct EpiSplit { static constexpr int PRE = 0; u16* O; size_t stride;
    __device__ __forceinline__ void store(int row, int col, f32x4 v0, f32x4 v1) const { const int t = col >> 10; *(u32x4*)(O + (size_t)t * stride + (size_t)row * 1024 + (col & 1023)) = pkv(v0, v1); } };
struct EpiRkvP { static constexpr int PRE = 0; u16* O; size_t stride; u16* Pb;
    __device__ __forceinline__ void store(int row, int col, f32x4 v0, f32x4 v1) const { const int t = col >> 10;
        u16* dst = (t < 3) ? O + (size_t)t * stride + (size_t)row * 1024 + (col & 1023) : Pb + (size_t)row * 768 + (col - 3072);
        *(u32x4*)dst = pkv(v0, v1); } };
struct EpiDft { static constexpr int PRE = 0; u16* CAT;
    __device__ __forceinline__ void store(int row, int col, f32x4 v0, f32x4 v1) const {
        const int ri = row >> 8, k1 = row & 255; int tok;
        if (col < 65536) { const int b = col >> 13, k2 = (col >> 9) & 15; tok = b * 4096 + k1 * 16 + k2; }
        else { const int n2 = col - 65536; const int b = n2 >> 14, k2 = (n2 >> 9) & 31; tok = HT + b * 8192 + k1 * 32 + k2; }
        const int ch = col & 511;
        *(u32x4*)(CAT + (size_t)tok * 1536 + 512 + ri * 512 + ch) = pkv(v0, v1); } };
struct EpiOut0 { static constexpr int PRE = 3; const float* xp; const float* xs; u16* X;
    __device__ __forceinline__ void pre2(int row, int col, f32x4& a, f32x4& b) const {
        const float* src = (row < HT ? xp + (size_t)row * 1024 : xs + (size_t)(row - HT) * 1024) + col; a = *(const f32x4*)src; b = *(const f32x4*)(src + 4); }
    __device__ __forceinline__ void store(int row, int col, f32x4 v0, f32x4 v1, f32x4 a, f32x4 b) const { *(u32x4*)(X + (size_t)row * 1024 + col) = pkv(a + v0, b + v1); } };
struct EpiResid { static constexpr int PRE = 1; u16* X;
    __device__ __forceinline__ u32x4 pre(int row, int col) const { return *(const u32x4*)(X + (size_t)row * 1024 + col); }
    __device__ __forceinline__ void store(int row, int col, f32x4 v0, f32x4 v1, u32x4 w) const {
        f32x4 a = {bflo(w.x), bfhi(w.x), bflo(w.y), bfhi(w.y)}, b = {bflo(w.z), bfhi(w.z), bflo(w.w), bfhi(w.w)};
        *(u32x4*)(X + (size_t)row * 1024 + col) = pkv(a + v0, b + v1); } };
struct EpiUp2 { static constexpr int PRE = 2; u16* D4; const float* w0; const float* a0;
    __device__ __forceinline__ void cpre(int col, f32x4& b0, f32x4& b1) const { const int gi = col >> 10, c = col & 1023; const float* bias = (gi < 2 ? w0 + gi * 1024 : a0 + (gi - 2) * 1024) + c; b0 = *(const f32x4*)bias; b1 = *(const f32x4*)(bias + 4); }
    __device__ __forceinline__ void store(int row, int col, f32x4 v0, f32x4 v1, f32x4 b0, f32x4 b1) const {
        const int gi = col >> 10, c = col & 1023; const float sc = gi < 2 ? -0.60653066f : 1.f; f32x4 x0 = v0 + b0, x1 = v1 + b1;
#pragma unroll
        for (int j = 0; j < 4; ++j) { x0[j] = sc * __builtin_amdgcn_rcpf(1.f + __expf(-x0[j])); x1[j] = sc * __builtin_amdgcn_rcpf(1.f + __expf(-x1[j])); }
        *(u32x4*)(D4 + (size_t)gi * ((size_t)HT * 1024) + (size_t)row * 1024 + c) = pkv(x0, x1); } };
struct Job { const float* src; const float* vec; u16* dst; int ldsrc, lddst, K, N; float c0, c1; };
__device__ __forceinline__ bool get_job(unsigned char* ws, unsigned char* ob, LAS unsigned char* lds, int j, Job& jb) {
    jb.vec = nullptr; jb.c0 = 1.f; jb.c1 = 0.f;
    if (j == 0) { jb.src = IN(5); jb.ldsrc = 2048; jb.dst = (u16*)(ws + OFF_WC); jb.lddst = 1024; jb.K = 1024; jb.N = 1536; return true; }
    if (j == 1) { jb.src = IN(5) + 1536; jb.ldsrc = 2048; jb.dst = (u16*)(ws + OFF_WF); jb.lddst = 1024; jb.K = 1024; jb.N = 512; return true; }
    if (j == 2) { jb.src = IN(7); jb.ldsrc = 1024; jb.dst = (u16*)(ws + OFF_WEFF); jb.lddst = 1536; jb.K = 512; jb.N = 1024; return true; }
    if (j < 5) { const int l = j - 3; jb.src = IN(27) + (size_t)l * 1024 * 5632; jb.ldsrc = 5632; jb.dst = (u16*)(ws + OFF_WUP) + (size_t)l * 5632 * 1024; jb.lddst = 1024; jb.K = 1024; jb.N = 5632; return true; }
    if (j < 7) { const int l = j - 5; jb.src = IN(30) + (size_t)l * 2816 * 1024; jb.ldsrc = 1024; jb.dst = (u16*)(ws + OFF_WDN) + (size_t)l * 1024 * 2816; jb.lddst = 2816; jb.K = 2816; jb.N = 1024; return true; }
    if (j < 10) { const int q = j - 7; jb.src = IN(10 + q); jb.ldsrc = 1024; jb.dst = (u16*)(ws + OFF_WRKV) + (size_t)q * 1024 * 1024; jb.lddst = 1024; jb.K = 1024; jb.N = 1024; return true; }
    if (j < 13) { jb.src = IN(10); jb.ldsrc = 1024; jb.dst = (u16*)(ws + OFF_WRKV); jb.lddst = 1024; jb.K = 0; jb.N = 32; return true; }
    if (j < 21) { const int i = (j - 13) >> 1, part = (j - 13) & 1, z = i & 1, which = i >> 1; jb.src = IN(which ? 18 : 15) + (size_t)z * 1024 * 64; jb.ldsrc = 64; jb.vec = IN(9) + (z * 2 + which) * 1024;
        jb.c0 = part ? 0.f : 1.f; jb.c1 = part ? 1.f : -1.f; jb.dst = (u16*)(ws + OFF_WLORA) + (size_t)(i * 128 + part * 64) * 1024; jb.lddst = 1024; jb.K = 1024; jb.N = 64; return true; }
    if (j < 23) { const int part = j - 21; jb.src = IN(20); jb.ldsrc = 128; jb.vec = IN(8) + 3 * 1024; jb.c0 = part ? 0.f : 1.f; jb.c1 = part ? 0.5f : -1.f;
        jb.dst = (u16*)(ws + OFF_WLORA) + (size_t)(512 + part * 128) * 1024; jb.lddst = 1024; jb.K = 1024; jb.N = 128; return true; }
    if (j == 23) { jb.src = IN(13); jb.ldsrc = 1024; jb.dst = (u16*)(ws + OFF_WO); jb.lddst = 1024; jb.K = 1024; jb.N = 1024; return true; }
    return false;
}
__device__ __forceinline__ void tr_item(const Job& jb, LAS float* scr, int item, int lane) {
    const int nblk = jb.N / 32, kb = item / nblk, nb = item % nblk, k0 = 64 * kb, n0 = 32 * nb;
#pragma unroll 8
    for (int i = 0; i < 32; ++i) { const int kk = 2 * i + (lane >> 5); const float s = jb.vec ? jb.c0 + jb.c1 * jb.vec[k0 + kk] : 1.f;
        scr[kk * 33 + (lane & 31)] = jb.src[(size_t)(k0 + kk) * jb.ldsrc + n0 + (lane & 31)] * s; }
    asm volatile("s_waitcnt lgkmcnt(0)" ::: "memory");
    const int c = lane & 7;
#pragma unroll
    for (int j = 0; j < 4; ++j) { const int n = (lane >> 3) + 8 * j; const LAS float* s = scr + (8 * c) * 33 + n;
        u32x4 o; o.x = pk2(s[0 * 33], s[1 * 33]); o.y = pk2(s[2 * 33], s[3 * 33]); o.z = pk2(s[4 * 33], s[5 * 33]); o.w = pk2(s[6 * 33], s[7 * 33]);
        *(u32x4*)(jb.dst + (size_t)(n0 + n) * jb.lddst + k0 + 8 * c) = o; }
    asm volatile("s_waitcnt lgkmcnt(0)" ::: "memory");
}
__device__ __forceinline__ void prep_phase(unsigned char* ws, unsigned char* ob, LAS unsigned char* lds) {
    const int tid = opaque_tid(), lane = tid & 63, wave = tid >> 6;
    LAS float* scr = (LAS float*)(lds + wave * 16384);
    const int gw = blockIdx.x * 8 + wave, NGW = gridDim.x * 8;
    int base = 0;
    for (int j = 0; j < 24; ++j) { Job jb; get_job(ws, ob, lds, j, jb); const int cnt = (jb.K / 64) * (jb.N / 32);
        int first = (gw - base % NGW + NGW) % NGW;
        for (int it = first; it < cnt; it += NGW) tr_item(jb, scr, it, lane);
        base += cnt; }
    const size_t gt = (size_t)blockIdx.x * 512 + tid, NT = (size_t)gridDim.x * 512;
    {
        u16* WE = (u16*)(ws + OFF_WEFF); const float* wo = IN(7);
        for (size_t i = gt; i < 512ull * 1024; i += NT) { const int d = (int)(i & 1023), gc = (int)(i >> 10), g = gc >> 7, c = gc & 127;
            float sr = 0.f, si = 0.f;
            for (int c2 = 0; c2 < 128; ++c2) { const float fr = (float)((c * c2) & 127) * (1.f / 128.f); const float w = wo[(size_t)(512 + 128 * g + c2) * 1024 + d];
                sr += __builtin_amdgcn_cosf(fr) * w; si += __builtin_amdgcn_sinf(fr) * w; }
            WE[(size_t)d * 1536 + 512 + gc] = f2bf(sr * 0.08838834764f); WE[(size_t)d * 1536 + 1024 + gc] = f2bf(si * 0.08838834764f); }
    }
    {
        u16* DA = (u16*)(ws + OFF_DFTA);
        for (size_t i = gt; i < 512ull * 512; i += NT) { const int kk = (int)(i & 511), m = (int)(i >> 9); const int rio = m >> 8, k1 = m & 255, rii = kk >> 8, t1 = kk & 255;
            const float fr = (float)((k1 * t1) & 255) * (1.f / 256.f); const float c = __builtin_amdgcn_cosf(fr), s = __builtin_amdgcn_sinf(fr);
            DA[i] = f2bf(rio == rii ? c : (rio == 0 ? s : -s)); }
    }
    {
        u16* W2 = (u16*)(ws + OFF_WUP2);
        for (size_t i = gt; i < 4096ull * 256; i += NT) { const int k = (int)(i & 255), n = (int)(i >> 8), gi = n >> 10, c = n & 1023; float v = 0.f;
            if ((k >> 6) == gi) { const int z = gi & 1; const float* src = (gi < 2 ? IN(16) : IN(19)) + (size_t)z * 64 * 1024; v = src[(size_t)(k & 63) * 1024 + c]; }
            W2[i] = f2bf(v); }
        u16* WG = (u16*)(ws + OFF_WG2);
        for (size_t i = gt; i < 1024ull * 256; i += NT) { const int k = (int)(i & 255), n = (int)(i >> 8); WG[i] = f2bf(k < 128 ? IN(21)[(size_t)k * 1024 + n] : 0.f); }
    }
}

__device__ __forceinline__ void load_row_bf(const u16* row, int lane, float* v) { unpk8(*(const u32x4*)(row + 8 * lane), v); unpk8(*(const u32x4*)(row + 512 + 8 * lane), v + 8); }
__device__ __forceinline__ float rstd_of(const float* v) { float s = 0.f;
#pragma unroll
    for (int j = 0; j < 16; ++j) s += v[j] * v[j];
    return 1.f / sqrtf(wave_sum(s) * (1.f / 1024.f) + 1e-6f); }
__device__ __forceinline__ void norm0_phase(unsigned char* ws, unsigned char* ob, LAS unsigned char* lds) {
    const int tix = opaque_tid(); const int lane = tix & 63, gw = blockIdx.x * 8 + (tix >> 6), NGW = gridDim.x * 8;
    u16* H = (u16*)(ws + OFF_H); const float* g = IN(2);
    f32x4 gv[4];
#pragma unroll
    for (int j = 0; j < 4; ++j) gv[j] = *(const f32x4*)(g + 4 * lane + 256 * j);
    for (int t = gw; t < 65536; t += NGW) { const float* xr = t < HT ? IN(0) + (size_t)t * 1024 : IN(1) + (size_t)(t - HT) * 1024;
        f32x4 v[4]; float s = 0.f;
#pragma unroll
        for (int j = 0; j < 4; ++j) { v[j] = *(const f32x4*)(xr + 4 * lane + 256 * j); s += v[j].x * v[j].x + v[j].y * v[j].y + v[j].z * v[j].z + v[j].w * v[j].w; }
        const float r = 1.f / sqrtf(wave_sum(s) * (1.f / 1024.f) + 1e-6f);
#pragma unroll
        for (int j = 0; j < 4; ++j) { const f32x4 o = v[j] * r * gv[j]; u32x2 w; w.x = pk2(o.x, o.y); w.y = pk2(o.z, o.w); *(u32x2*)(H + (size_t)t * 1024 + 4 * lane + 256 * j) = w; } }
}
__device__ __forceinline__ void normx_phase(unsigned char* ws, unsigned char* ob, const float* g, int mode) {
    const int tix = opaque_tid(); const int lane = tix & 63, gw = blockIdx.x * 8 + (tix >> 6), NGW = gridDim.x * 8;
    const u16* X = (const u16*)(ws + OFF_X); u16* H = (u16*)(ws + OFF_H);
    float gv[16];
#pragma unroll
    for (int j = 0; j < 2; ++j)
#pragma unroll
        for (int e = 0; e < 8; ++e) gv[8 * j + e] = g[8 * lane + 512 * j + e];
    for (int t = gw; t < 65536; t += NGW) { float v[16]; load_row_bf(X + (size_t)t * 1024, lane, v); const float r = rstd_of(v);
#pragma unroll
        for (int j = 0; j < 16; ++j) v[j] = v[j] * r * gv[j];
        if (mode == 0) { *(u32x4*)(H + (size_t)t * 1024 + 8 * lane) = pk8(v); *(u32x4*)(H + (size_t)t * 1024 + 512 + 8 * lane) = pk8(v + 8); }
        else { float* o = ((float*)ob) + (size_t)t * 1024;
#pragma unroll
            for (int j = 0; j < 2; ++j) { *(f32x4*)(o + 8 * lane + 512 * j) = (f32x4){v[8 * j], v[8 * j + 1], v[8 * j + 2], v[8 * j + 3]}; *(f32x4*)(o + 8 * lane + 512 * j + 4) = (f32x4){v[8 * j + 4], v[8 * j + 5], v[8 * j + 6], v[8 * j + 7]}; } } }
}
__device__ __forceinline__ void norm1_phase(unsigned char* ws, unsigned char* ob, LAS unsigned char* lds, int hf) {
    const int tix = opaque_tid(); const int lane = tix & 63, gw = blockIdx.x * 8 + (tix >> 6), NGW = gridDim.x * 8;
    const u16* X = (const u16*)(ws + OFF_X) + (size_t)hf * HT * 1024; u16* XO = (u16*)(ws + OFF_HH); const float* g = IN(2) + 1024; const float* mu = IN(8);
    const int T = hf ? 8192 : 4096;
    float gv[16], m1[3][16], m2[3][16];
#pragma unroll
    for (int j = 0; j < 2; ++j)
#pragma unroll
        for (int e = 0; e < 8; ++e) { gv[8 * j + e] = g[8 * lane + 512 * j + e];
#pragma unroll
            for (int q = 0; q < 3; ++q) { const float mm = mu[q * 1024 + 8 * lane + 512 * j + e]; m1[q][8 * j + e] = 1.f - mm; m2[q][8 * j + e] = 0.5f * mm; } }
    for (int r0 = gw * 8; r0 < HT; r0 += NGW * 8) {
        const int pos0 = r0 & (T - 1);
        float pv[16], cv[16], nv[16];
        if (pos0 > 0) { load_row_bf(X + (size_t)(r0 - 1) * 1024, lane, pv); const float r = rstd_of(pv);
#pragma unroll
            for (int j = 0; j < 16; ++j) pv[j] = pv[j] * r * gv[j]; }
        else {
#pragma unroll
            for (int j = 0; j < 16; ++j) pv[j] = 0.f; }
        { load_row_bf(X + (size_t)r0 * 1024, lane, cv); const float r = rstd_of(cv);
#pragma unroll
            for (int j = 0; j < 16; ++j) cv[j] = cv[j] * r * gv[j]; }
        u32x4 nq0 = *(const u32x4*)(X + (size_t)(r0 + 1) * 1024 + 8 * lane), nq1 = *(const u32x4*)(X + (size_t)(r0 + 1) * 1024 + 512 + 8 * lane);
#pragma unroll 2
        for (int i = 0; i < 8; ++i) { const int t = r0 + i; const bool hn = (pos0 + i) < T - 1;
            if (hn) { unpk8(nq0, nv); unpk8(nq1, nv + 8); const float r = rstd_of(nv);
#pragma unroll
                for (int j = 0; j < 16; ++j) nv[j] = nv[j] * r * gv[j]; }
            else {
#pragma unroll
                for (int j = 0; j < 16; ++j) nv[j] = 0.f; }
            if (i < 7 && (pos0 + i + 1) < T - 1) { nq0 = *(const u32x4*)(X + (size_t)(t + 2) * 1024 + 8 * lane); nq1 = *(const u32x4*)(X + (size_t)(t + 2) * 1024 + 512 + 8 * lane); }
            u16* o = XO + (size_t)t * 1024;
#pragma unroll
            for (int q = 0; q < 3; ++q) { float m[16];
#pragma unroll
                for (int j = 0; j < 16; ++j) m[j] = cv[j] * m1[q][j] + m2[q][j] * (pv[j] + nv[j]);
                *(u32x4*)(o + (size_t)q * HT * 1024 + 8 * lane) = pk8(m); *(u32x4*)(o + (size_t)q * HT * 1024 + 512 + 8 * lane) = pk8(m + 8); }
            *(u32x4*)(o + 3ull * HT * 1024 + 8 * lane) = pk8(cv); *(u32x4*)(o + 3ull * HT * 1024 + 512 + 8 * lane) = pk8(cv + 8);
#pragma unroll
            for (int j = 0; j < 16; ++j) { pv[j] = cv[j]; cv[j] = nv[j]; } } }
}

__device__ __forceinline__ void yconv_phase(unsigned char* ws, unsigned char* ob, LAS unsigned char* lds) {
    const int tix = opaque_tid(); const int lane = tix & 63, gw = blockIdx.x * 8 + (tix >> 6), NGW = gridDim.x * 8;
    const u16* PR = (const u16*)(ob + OUT_PROJ); u16* CAT = (u16*)(ws + OFF_CAT); const float* cw = IN(6);
    float w[3][8];
#pragma unroll
    for (int j = 0; j < 3; ++j)
#pragma unroll
        for (int e = 0; e < 8; ++e) w[j][e] = cw[j * 512 + 8 * lane + e];
    for (int t = gw; t < 65536; t += NGW) { const int T = seqT(t), pos = t & (T - 1);
        float acc[8], gb[8];
#pragma unroll
        for (int e = 0; e < 8; ++e) acc[e] = 0.f;
#pragma unroll
        for (int j = 0; j < 3; ++j) { const int pp = pos + j - 1; if (pp < 0 || pp >= T) continue;
            const u16* r = PR + (size_t)(t + j - 1) * 1536 + 8 * lane; float a[8], b[8]; unpk8(*(const u32x4*)(r + 512), a); unpk8(*(const u32x4*)(r + 1024), b);
#pragma unroll
            for (int e = 0; e < 8; ++e) acc[e] += w[j][e] * a[e] * b[e]; }
        unpk8(*(const u32x4*)(PR + (size_t)t * 1536 + 8 * lane), gb);
#pragma unroll
        for (int e = 0; e < 8; ++e) acc[e] *= gb[e];
        *(u32x4*)(CAT + (size_t)t * 1536 + 8 * lane) = pk8(acc); }
}
template <int T2>
__device__ __forceinline__ void stageA_item(const u16* FT, u16* YP, int tokbase, size_t nbase, int ch, int t1) {
    constexpr float C32[32] = {1.000000000f, 0.980785280f, 0.923879533f, 0.831469612f, 0.707106781f, 0.555570233f, 0.382683432f, 0.195090322f, 0.000000000f, -0.195090322f, -0.382683432f, -0.555570233f, -0.707106781f, -0.831469612f, -0.923879533f, -0.980785280f, -1.000000000f, -0.980785280f, -0.923879533f, -0.831469612f, -0.707106781f, -0.555570233f, -0.382683432f, -0.195090322f, -0.000000000f, 0.195090322f, 0.382683432f, 0.555570233f, 0.707106781f, 0.831469612f, 0.923879533f, 0.980785280f};
    constexpr float S32[32] = {0.000000000f, 0.195090322f, 0.382683432f, 0.555570233f, 0.707106781f, 0.831469612f, 0.923879533f, 0.980785280f, 1.000000000f, 0.980785280f, 0.923879533f, 0.831469612f, 0.707106781f, 0.555570233f, 0.382683432f, 0.195090322f, 0.000000000f, -0.195090322f, -0.382683432f, -0.555570233f, -0.707106781f, -0.831469612f, -0.923879533f, -0.980785280f, -1.000000000f, -0.980785280f, -0.923879533f, -0.831469612f, -0.707106781f, -0.555570233f, -0.382683432f, -0.195090322f};
    float xv[T2];
#pragma unroll
    for (int t2 = 0; t2 < T2; ++t2) xv[t2] = bf2f(FT[(size_t)ch * 65536 + tokbase + t1 + 256 * t2]);
    const float invs = 1.f / sqrtf((float)(256 * T2));
#pragma unroll
    for (int k2 = 0; k2 <= T2 / 2; ++k2) { float yr = 0.f, yi = 0.f;
#pragma unroll
        for (int t2 = 0; t2 < T2; ++t2) { const int j = ((k2 * t2) & (T2 - 1)) * (32 / T2); yr += xv[t2] * C32[j]; yi -= xv[t2] * S32[j]; }
#pragma unroll
        for (int mir = 0; mir < 2; ++mir) { const int kk = mir ? T2 - k2 : k2; if (mir && (k2 == 0 || k2 == T2 / 2)) continue; const float yim = mir ? -yi : yi;
            const float fr = (float)(kk * t1) * (1.f / (256.f * T2)); const float c = __builtin_amdgcn_cosf(fr), sn = __builtin_amdgcn_sinf(fr);
            u16* o = YP + (nbase + (size_t)kk * 512 + ch) * 512 + t1;
            o[0] = f2bf((yr * c + yim * sn) * invs); o[256] = f2bf((yim * c - yr * sn) * invs); } }
}
__device__ __forceinline__ void stageA_phase(unsigned char* ws, unsigned char* ob, LAS unsigned char* lds) {
    const int tid = opaque_tid();
    const u16* FT = (const u16*)(ob + OUT_FT); u16* YP = (u16*)(ws + OFF_YP);
    for (int it = blockIdx.x; it < 12 * 256; it += gridDim.x) { const int sq = it >> 8, ch = 2 * (it & 255) + (tid >> 8), t1 = tid & 255;
        if (sq < 8) stageA_item<16>(FT, YP, sq * 4096, (size_t)sq * 16 * 512, ch, t1);
        else stageA_item<32>(FT, YP, HT + (sq - 8) * 8192, 65536 + (size_t)(sq - 8) * 32 * 512, ch, t1); }
}

__device__ __forceinline__ void act_phase(unsigned char* ws, unsigned char* ob, LAS unsigned char* lds, int l, int chunk) {
    const u16* U = (const u16*)(ws + OFF_U); u16* ACT = (u16*)(ob + OUT_ACT);
    const float* cw = IN(28) + (size_t)l * 3 * 5632; const float* cb = IN(29) + (size_t)l * 5632;
    const size_t gt = (size_t)blockIdx.x * 512 + opaque_tid(), NT = (size_t)gridDim.x * 512;
    for (size_t i = gt; i < 1024ull * 352; i += NT) {
        const int rbk = (int)(i / 352), c = 8 * (int)(i % 352), row0 = rbk * 16; const int tg0 = chunk * 16384 + row0, T = seqT(tg0), pos0 = tg0 & (T - 1);
        float wg[3][8], wv[3][8], bg[8], bv[8];
#pragma unroll
        for (int j = 0; j < 3; ++j) { const f32x4 a0 = *(const f32x4*)(cw + j * 5632 + c), a1 = *(const f32x4*)(cw + j * 5632 + c + 4), b0 = *(const f32x4*)(cw + j * 5632 + 2816 + c), b1 = *(const f32x4*)(cw + j * 5632 + 2816 + c + 4);
            wg[j][0] = a0.x; wg[j][1] = a0.y; wg[j][2] = a0.z; wg[j][3] = a0.w; wg[j][4] = a1.x; wg[j][5] = a1.y; wg[j][6] = a1.z; wg[j][7] = a1.w;
            wv[j][0] = b0.x; wv[j][1] = b0.y; wv[j][2] = b0.z; wv[j][3] = b0.w; wv[j][4] = b1.x; wv[j][5] = b1.y; wv[j][6] = b1.z; wv[j][7] = b1.w; }
        { const f32x4 a0 = *(const f32x4*)(cb + c), a1 = *(const f32x4*)(cb + c + 4), b0 = *(const f32x4*)(cb + 2816 + c), b1 = *(const f32x4*)(cb + 2816 + c + 4);
            bg[0] = a0.x; bg[1] = a0.y; bg[2] = a0.z; bg[3] = a0.w; bg[4] = a1.x; bg[5] = a1.y; bg[6] = a1.z; bg[7] = a1.w;
            bv[0] = b0.x; bv[1] = b0.y; bv[2] = b0.z; bv[3] = b0.w; bv[4] = b1.x; bv[5] = b1.y; bv[6] = b1.z; bv[7] = b1.w; }
        float pg[8], pv[8], cg_[8], cv[8];
        const u16* r = U + (size_t)row0 * 5632 + c;
        u32x4 bufg[3][4], bufv[3][4];
        const bool tail_ok = pos0 + 16 < T;
#define ACT_LOAD(g_, b_) do { _Pragma("unroll") for (int k = 0; k < 4; ++k) { const int rn = 4 * (g_) + k + 1; \
            if (rn < 16 || tail_ok) { bufg[b_][k] = *(const u32x4*)(r + (size_t)rn * 5632); bufv[b_][k] = *(const u32x4*)(r + (size_t)rn * 5632 + 2816); } \
            else { bufg[b_][k] = (u32x4){0u, 0u, 0u, 0u}; bufv[b_][k] = (u32x4){0u, 0u, 0u, 0u}; } } } while (0)
        ACT_LOAD(0, 0); ACT_LOAD(1, 1);
        if (pos0 > 0) { unpk8(*(const u32x4*)(r - 5632), pg); unpk8(*(const u32x4*)(r - 5632 + 2816), pv); }
        else {
#pragma unroll
            for (int e = 0; e < 8; ++e) { pg[e] = 0.f; pv[e] = 0.f; } }
        unpk8(*(const u32x4*)r, cg_); unpk8(*(const u32x4*)(r + 2816), cv);
#pragma unroll
        for (int g = 0; g < 4; ++g) {
            if (g < 2) ACT_LOAD(g + 2, (g + 2) % 3);
#pragma unroll
            for (int k = 0; k < 4; ++k) { float ng[8], nv[8], o[8]; unpk8(bufg[g % 3][k], ng); unpk8(bufv[g % 3][k], nv);
#pragma unroll
                for (int e = 0; e < 8; ++e) { const float gg = bg[e] + wg[0][e] * pg[e] + wg[1][e] * cg_[e] + wg[2][e] * ng[e]; const float v = bv[e] + wv[0][e] * pv[e] + wv[1][e] * cv[e] + wv[2][e] * nv[e];
                    o[e] = gg * sigmoidf_(gg) * v; pg[e] = cg_[e]; pv[e] = cv[e]; cg_[e] = ng[e]; cv[e] = nv[e]; }
                *(u32x4*)(ACT + (size_t)(row0 + 4 * g + k) * 2816 + c) = pk8(o); } }
#undef ACT_LOAD
    }
}

__device__ __forceinline__ void lprep_phase(unsigned char* ws, unsigned char* ob, int hf) {
    const int tix = opaque_tid(); const int lane = tix & 63, gw = blockIdx.x * 8 + (tix >> 6), NGW = gridDim.x * 8;
    const u16* PB = (const u16*)(ob + OUT_P); u16* L = (u16*)(ws + OFF_L); u16* LG = (u16*)(ws + OFF_LG);
    const int T = hf ? 8192 : 4096;
    for (int t = gw; t < HT; t += NGW) { const int pos = t & (T - 1); const u16* r = PB + (size_t)t * 768; float a[8], b[8];
        if (lane < 32) { const int i = lane >> 3, r0 = (lane & 7) * 8, sh = (i & 1) ? 1 : -1; const bool ok = (i & 1) ? (pos < T - 1) : (pos > 0);
            unpk8(*(const u32x4*)(r + i * 128 + r0), a);
            if (ok) { unpk8(*(const u32x4*)(r + sh * 768 + i * 128 + 64 + r0), b);
#pragma unroll
                for (int e = 0; e < 8; ++e) a[e] += b[e]; }
            if (i < 2) {
#pragma unroll
                for (int e = 0; e < 8; ++e) a[e] = 1.f - 2.f * __builtin_amdgcn_rcpf(1.f + __expf(2.f * a[e])); }
            *(u32x4*)(L + (size_t)t * 256 + 8 * lane) = pk8(a); }
        else if (lane < 48) { const int r0 = (lane - 32) * 8; unpk8(*(const u32x4*)(r + 512 + r0), a);
            if (pos > 0) { unpk8(*(const u32x4*)(r - 768 + 640 + r0), b);
#pragma unroll
                for (int e = 0; e < 8; ++e) a[e] += b[e]; }
            if (pos < T - 1) { unpk8(*(const u32x4*)(r + 768 + 640 + r0), b);
#pragma unroll
                for (int e = 0; e < 8; ++e) a[e] += b[e]; }
#pragma unroll
            for (int e = 0; e < 8; ++e) a[e] = sigmoidf_(a[e]);
            *(u32x4*)(LG + (size_t)t * 256 + r0) = pk8(a); }
        else { unsigned zz = 0u; asm volatile("" : "+v"(zz)); *(u32x4*)(LG + (size_t)t * 256 + 128 + (lane - 48) * 8) = (u32x4){zz, zz, zz, zz}; } }
}
__device__ __forceinline__ void rwprep_phase(unsigned char* ws, unsigned char* ob, LAS unsigned char* lds) {
    const int tix = opaque_tid(); const int lane = tix & 63, gw = blockIdx.x * 8 + (tix >> 6), NGW = gridDim.x * 8;
    const u16* R = (const u16*)(ob + OUT_RKV); const u16* Kp = R + (size_t)HT * 1024;
    const u16* A0 = (const u16*)(ws + OFF_D4) + 2ull * HT * 1024; const u16* A1 = A0 + (size_t)HT * 1024;
    float* INV = (float*)(ws + OFF_INV); float* BON = (float*)(ws + OFF_BON);
    const float* kkp = IN(22) + 16 * lane; const float* kap = IN(23) + 16 * lane; const float* rkp = IN(24) + 16 * lane;
    float kk[16], ka[16], rk[16];
#pragma unroll
    for (int e = 0; e < 16; ++e) { kk[e] = kkp[e]; ka[e] = kap[e]; rk[e] = rkp[e]; }
    for (int t0 = gw; t0 < HT; t0 += 2 * NGW) {
        u32x4 q[2][8];
#pragma unroll
        for (int u2 = 0; u2 < 2; ++u2) { const int t = t0 + u2 * NGW; if (t < HT) { const size_t o = (size_t)t * 1024 + 16 * lane;
            q[u2][0] = *(const u32x4*)(Kp + o); q[u2][1] = *(const u32x4*)(Kp + o + 8); q[u2][2] = *(const u32x4*)(R + o); q[u2][3] = *(const u32x4*)(R + o + 8);
            q[u2][4] = *(const u32x4*)(A0 + o); q[u2][5] = *(const u32x4*)(A0 + o + 8); q[u2][6] = *(const u32x4*)(A1 + o); q[u2][7] = *(const u32x4*)(A1 + o + 8); } }
#pragma unroll
        for (int u2 = 0; u2 < 2; ++u2) { const int t = t0 + u2 * NGW; if (t < HT) { float k[16], r[16], a0[16], a1[16];
            unpk8(q[u2][0], k); unpk8(q[u2][1], k + 8); unpk8(q[u2][2], r); unpk8(q[u2][3], r + 8); unpk8(q[u2][4], a0); unpk8(q[u2][5], a0 + 8); unpk8(q[u2][6], a1); unpk8(q[u2][7], a1 + 8);
            float ss = 0.f, bn = 0.f;
#pragma unroll
            for (int e = 0; e < 16; ++e) { const float qq = k[e] * kk[e]; ss += qq * qq; bn += r[e] * k[e] * rk[e] * (2.f + (a0[e] + a1[e] - 2.f) * ka[e]); }
            ss = allreduce4(ss); bn = allreduce4(bn);
            if ((lane & 3) == 0) { INV[(size_t)t * 16 + (lane >> 2)] = 1.f / fmaxf(sqrtf(ss), 1e-12f); BON[(size_t)t * 16 + (lane >> 2)] = bn; } } } }
}
__device__ __forceinline__ void gn_phase(unsigned char* ws, unsigned char* ob, LAS unsigned char* lds) {
    const int tix = opaque_tid(); const int lane = tix & 63, gw = blockIdx.x * 8 + (tix >> 6), NGW = gridDim.x * 8;
    const u16* Y = (const u16*)(ob + OUT_Y); const u16* V = (const u16*)(ob + OUT_RKV) + 2ull * HT * 1024;
    const u16* G = (const u16*)(ws + OFF_G); u16* YG = (u16*)(ws + OFF_YG); const float* BON = (const float*)(ws + OFF_BON); const u16* YB = (const u16*)(ws + OFF_D4) + 3ull * HT * 1024;
    float gw_[16], gb_[16];
#pragma unroll
    for (int e = 0; e < 16; ++e) { gw_[e] = IN(25)[16 * lane + e]; gb_[e] = IN(26)[16 * lane + e]; }
    for (int t0 = gw; t0 < HT; t0 += 2 * NGW) {
        u32x4 q[2][8]; float bnv[2] = {0.f, 0.f};
#pragma unroll
        for (int u2 = 0; u2 < 2; ++u2) { const int t = t0 + u2 * NGW; if (t < HT) { const size_t o = (size_t)t * 1024 + 16 * lane;
            q[u2][0] = *(const u32x4*)(Y + o); q[u2][1] = *(const u32x4*)(Y + o + 8); q[u2][2] = *(const u32x4*)(YB + o); q[u2][3] = *(const u32x4*)(YB + o + 8);
            q[u2][4] = *(const u32x4*)(V + o); q[u2][5] = *(const u32x4*)(V + o + 8); q[u2][6] = *(const u32x4*)(G + o); q[u2][7] = *(const u32x4*)(G + o + 8); bnv[u2] = BON[(size_t)t * 16 + (lane >> 2)]; } }
#pragma unroll
        for (int u2 = 0; u2 < 2; ++u2) { const int t = t0 + u2 * NGW; if (t < HT) { const size_t o = (size_t)t * 1024 + 16 * lane; float y[16], yb[16], v[16], g[16];
            unpk8(q[u2][0], y); unpk8(q[u2][1], y + 8); unpk8(q[u2][2], yb); unpk8(q[u2][3], yb + 8); unpk8(q[u2][4], v); unpk8(q[u2][5], v + 8); unpk8(q[u2][6], g); unpk8(q[u2][7], g + 8);
            float s = 0.f;
#pragma unroll
            for (int e = 0; e < 16; ++e) { y[e] += yb[e]; s += y[e]; }
            const float mean = allreduce4(s) * (1.f / 64.f); float qv = 0.f;
#pragma unroll
            for (int e = 0; e < 16; ++e) { y[e] -= mean; qv += y[e] * y[e]; }
            const float rstd = 1.f / sqrtf(allreduce4(qv) * (1.f / 64.f) + 64e-5f); const float bn = bnv[u2];
#pragma unroll
            for (int e = 0; e < 16; ++e) y[e] = (y[e] * rstd * gw_[e] + gb_[e] + bn * v[e]) * g[e];
            *(u32x4*)(YG + o) = pk8(y); *(u32x4*)(YG + o + 8) = pk8(y + 8); } } }
}

typedef float f32x16 __attribute__((ext_vector_type(16)));
#define MFMA32(a, b, c) __builtin_amdgcn_mfma_f32_32x32x16_bf16((a), (b), (c), 0, 0, 0)
__device__ __forceinline__ unsigned pkc(float lo, float hi) { typedef __bf16 bf2 __attribute__((ext_vector_type(2))); typedef float f2 __attribute__((ext_vector_type(2))); const f2 v = {lo, hi}; const bf2 b = __builtin_convertvector(v, bf2); return __builtin_bit_cast(unsigned, b); }
__device__ __forceinline__ u16 bfc(float v) { return (u16)(pkc(v, 0.f) & 0xffffu); }
__device__ __forceinline__ bf16x8 pack_lo(const f32x16& x) { u32x4 p; p.x = pkc(x[0], x[1]); p.y = pkc(x[2], x[3]); p.z = pkc(x[4], x[5]); p.w = pkc(x[6], x[7]); return __builtin_bit_cast(bf16x8, p); }
__device__ __forceinline__ bf16x8 pack_hi(const f32x16& x) { u32x4 p; p.x = pkc(x[8], x[9]); p.y = pkc(x[10], x[11]); p.z = pkc(x[12], x[13]); p.w = pkc(x[14], x[15]); return __builtin_bit_cast(bf16x8, p); }
constexpr int SL_QS = 1056;
constexpr int SL_AR = 0, SL_BK = 4 * SL_QS, SL_BT = 8 * SL_QS, SL_KT = SL_BT + 2048, SL_VT = SL_KT + 2048, SL_MK = SL_VT + 2048, SL_T2 = SL_MK + 1024, SL_WL = SL_T2 + 1024, SL_SIZE = SL_WL + 256;
static_assert(SL_VT >= 10240 && 8 * SL_SIZE <= LDS_TAB, "scan slot layout");
__device__ __forceinline__ void scan_phase(unsigned char* ws, unsigned char* ob, LAS unsigned char* lds, int hf) {
    const int T = hf ? 8192 : 4096, nunits = (hf ? 4 : 8) * 16 * 2, nblk = T / 16, nbatch = nblk / 8;
    const int tid = opaque_tid(), lane = tid & 63, wave = __builtin_amdgcn_readfirstlane(tid >> 6), r = lane & 31, h = lane >> 5;
    const u16* R = (const u16*)(ob + OUT_RKV); const u16* Kp = R + (size_t)HT * 1024; const u16* V = Kp + (size_t)HT * 1024;
    const u16* D4 = (const u16*)(ws + OFF_D4); const float* INV = (const float*)(ws + OFF_INV);
    const int ci = wave;
    const int jb = lane >> 5, jl = lane & 31, js = jl >> 4, jh = (jl >> 2) & 1, je = ((jl >> 3) & 1) * 4 + (jl & 3);
    const unsigned posj = (unsigned)((jb * 2 + js) * SL_QS + jh * 16 + je * 2);
    LAS unsigned char* sb = lds + wave * SL_SIZE;
#define SC_BAR() do { asm volatile("s_waitcnt lgkmcnt(0)" ::: "memory"); __builtin_amdgcn_s_barrier(); asm volatile("" ::: "memory"); } while (0)
    const int nroles = (hf && gridDim.x >= 256) ? 2 : 1;
    const int bx = blockIdx.x, role = nroles == 2 ? ((bx >> 3) & 1) : 0, u0 = nroles == 2 ? (((bx >> 4) << 3) | (bx & 7)) : bx;
    unsigned* hflag = (unsigned*)(ws + OFF_BAR + 16384); float* hslot = (float*)(ws + OFF_HSLOT);
    for (int u = u0; u < nunits; u += (nroles == 2 ? 1 << 30 : (int)gridDim.x)) {
        if (nroles == 2 && bx >= 256) break;
        const int z = u & 1, hd = (u >> 1) & 15, b = u >> 5; const size_t seqbase = (size_t)b * T;
        u16* Y = z ? (u16*)(ws + OFF_D4) + 3ull * HT * 1024 : (u16*)(ob + OUT_Y);
        const float kkc = IN(22)[hd * 64 + lane], kac = IN(23)[hd * 64 + lane];
        f32x16 X0, X1;
#pragma unroll
        for (int g = 0; g < 16; ++g) { X0[g] = 0.f; X1[g] = 0.f; }
        const unsigned lanepart = (unsigned)((hd * 64 + 8 * (lane & 7)) * 2); const u16* Dz = D4 + (size_t)z * HT * 1024; const u16* Az = D4 + (size_t)(2 + z) * HT * 1024;
        u32x4 graw[5][2]; float inv = 0.f;
#define SC_LOAD(bt_) do { int nb_ = (bt_); asm volatile("" : "+s"(nb_)); const int n_ = nb_ * 8 + ci;     \
            _Pragma("unroll") for (int i2 = 0; i2 < 2; ++i2) { const int t_ = (lane >> 3) + 8 * i2; const int tl_ = z ? (T - 1 - (16 * n_ + t_)) : (16 * n_ + t_); \
                const unsigned off_ = (unsigned)(((int)seqbase + tl_) * 2048) + lanepart;            \
                graw[0][i2] = *(const u32x4*)((const char*)R + off_); graw[1][i2] = *(const u32x4*)((const char*)Kp + off_); graw[2][i2] = *(const u32x4*)((const char*)V + off_); \
                graw[3][i2] = *(const u32x4*)((const char*)Dz + off_); graw[4][i2] = *(const u32x4*)((const char*)Az + off_); } \
            { const int t_ = lane & 15; const int tl_ = z ? (T - 1 - (16 * n_ + t_)) : (16 * n_ + t_); inv = *(const float*)((const char*)INV + (unsigned)((((int)seqbase + tl_) * 16 + hd) * 4)); } } while (0)
        SC_LOAD(role);
        __syncthreads();
        for (int bt = role; bt < nbatch; bt += nroles) {
            {
#pragma unroll
                for (int a5 = 0; a5 < 5; ++a5) { *(LAS u32x4*)(sb + a5 * 2048 + lane * 16) = graw[a5][0]; *(LAS u32x4*)(sb + a5 * 2048 + 1024 + lane * 16) = graw[a5][1]; }
                asm volatile("s_waitcnt lgkmcnt(0)" ::: "memory");
                unsigned rr[16], kr[16], lr[16], ar[16], vr[16];
#pragma unroll
                for (int t = 0; t < 16; ++t) { rr[t] = *(const LAS u16*)(sb + 0 * 2048 + t * 128 + 2 * lane); kr[t] = *(const LAS u16*)(sb + 1 * 2048 + t * 128 + 2 * lane); vr[t] = *(const LAS u16*)(sb + 2 * 2048 + t * 128 + 2 * lane);
                    lr[t] = *(const LAS u16*)(sb + 3 * 2048 + t * 128 + 2 * lane); ar[t] = *(const LAS u16*)(sb + 4 * 2048 + t * 128 + 2 * lane); }
                asm volatile("s_waitcnt lgkmcnt(0)" ::: "memory");
#define PK16(a_, t0_) ((a_)[t0_] | ((a_)[(t0_) + 1] << 16))
                *(LAS u32x4*)(sb + SL_VT + lane * 32) = (u32x4){PK16(vr, 0), PK16(vr, 2), PK16(vr, 8), PK16(vr, 10)}; *(LAS u32x4*)(sb + SL_VT + lane * 32 + 16) = (u32x4){PK16(vr, 4), PK16(vr, 6), PK16(vr, 12), PK16(vr, 14)};
                float L = 0.f, Eprev = 1.f; unsigned b16[8], k16[8];
#pragma unroll
                for (int t = 0; t < 16; ++t) { const float invt = __int_as_float(__builtin_amdgcn_readlane(__float_as_int(inv), t));
                    const float kf = __uint_as_float(kr[t] << 16), rf = __uint_as_float(rr[t] << 16), lw = __uint_as_float(lr[t] << 16), af = __uint_as_float(ar[t] << 16);
                    const float kk_ = kf * kkc * invt; L += lw; const float E = __expf(L), Einv = __builtin_amdgcn_rcpf(E);
                    const u16 At = bfc(-kk_ * Eprev), Rt = bfc(rf * E), Bt = bfc(kk_ * af * Einv), Kt = bfc(kf * (1.f + (af - 1.f) * kac) * Einv); Eprev = E;
                    constexpr int dummy = 0; (void)dummy;
                    const int ht = (t >> 2) & 1, et = ((t >> 3) & 1) * 4 + (t & 3);
                    *(LAS u16*)(sb + SL_AR + posj + 32 * t) = At; *(LAS u16*)(sb + SL_AR + posj + 32 * (16 + t)) = Rt;
                    *(LAS u16*)(sb + SL_BK + posj + 32 * t) = Bt; *(LAS u16*)(sb + SL_BK + posj + 32 * (16 + t)) = Kt;
                    if (t & 1) { b16[t >> 1] |= (unsigned)Bt << 16; k16[t >> 1] |= (unsigned)Kt << 16; } else { b16[t >> 1] = Bt; k16[t >> 1] = Kt; } (void)ht; (void)et; }
                *(LAS u32x4*)(sb + SL_BT + lane * 32) = (u32x4){b16[0], b16[1], b16[4], b16[5]}; *(LAS u32x4*)(sb + SL_BT + lane * 32 + 16) = (u32x4){b16[2], b16[3], b16[6], b16[7]};
                *(LAS u32x4*)(sb + SL_KT + lane * 32) = (u32x4){k16[0], k16[1], k16[4], k16[5]}; *(LAS u32x4*)(sb + SL_KT + lane * 32 + 16) = (u32x4){k16[2], k16[3], k16[6], k16[7]};
#undef PK16
                *(LAS float*)(sb + SL_WL + 4 * lane) = Eprev; }
            if (bt + nroles < nbatch) SC_LOAD(bt + nroles);
            asm volatile("s_waitcnt lgkmcnt(0)" ::: "memory");
            {   f32x16 M;
#pragma unroll
                for (int g = 0; g < 16; ++g) M[g] = 0.f;
#pragma unroll
                for (int q = 0; q < 4; ++q) { const bf16x8 a = *(const LAS bf16x8*)(sb + SL_AR + q * SL_QS + r * 32 + h * 16), bq = *(const LAS bf16x8*)(sb + SL_BK + q * SL_QS + r * 32 + h * 16); M = MFMA32(a, bq, M); }
                LAS float* Mf = (LAS float*)(sb + SL_BK);
                int rl = r, hl = h; asm volatile("" : "+v"(rl), "+v"(hl));
#pragma unroll
                for (int g = 0; g < 16; ++g) { const int tp = (g & 3) + 8 * (g >> 2) + 4 * hl, tt = tp & 15, ss = rl & 15; const bool keep = (tp < 16) ? (ss < tt) : (ss <= tt); Mf[tp * 32 + rl] = keep ? M[g] : 0.f; }
                asm volatile("s_waitcnt lgkmcnt(0)" ::: "memory");
                const int c = lane & 15, hc = (c >> 2) & 1, ec = ((c >> 3) & 1) * 4 + (c & 3); float x[16];
#pragma unroll
                for (int gq = 0; gq < 4; ++gq) { f32x4 mr[4][4];
#pragma unroll
                    for (int i = 0; i < 4; ++i)
#pragma unroll
                        for (int q4 = 0; q4 <= gq; ++q4) mr[i][q4] = *(const LAS f32x4*)(Mf + (4 * gq + i) * 32 + 4 * q4);
#pragma unroll
                    for (int i = 0; i < 4; ++i) { const int t = 4 * gq + i; float acc = (t == c) ? 1.f : 0.f;
#pragma unroll
                        for (int q4 = 0; q4 <= gq; ++q4)
#pragma unroll
                            for (int e = 0; e < 4; ++e) if (4 * q4 + e < t) acc += mr[i][q4][e] * x[4 * q4 + e];
                        x[t] = acc; if (lane < 16) *(LAS u16*)(sb + SL_T2 + (t * 2 + hc) * 16 + 2 * ec) = bfc(acc); } }
#pragma unroll
                for (int gq = 0; gq < 4; ++gq) { f32x4 mr[4][4];
#pragma unroll
                    for (int i = 0; i < 4; ++i)
#pragma unroll
                        for (int q4 = 0; q4 <= gq; ++q4) mr[i][q4] = *(const LAS f32x4*)(Mf + (16 + 4 * gq + i) * 32 + 4 * q4);
#pragma unroll
                    for (int i = 0; i < 4; ++i) { const int t = 4 * gq + i; float acc = 0.f;
#pragma unroll
                        for (int q4 = 0; q4 <= gq; ++q4)
#pragma unroll
                            for (int e = 0; e < 4; ++e) if (4 * q4 + e <= t) acc += mr[i][q4][e] * x[4 * q4 + e];
                        if (lane < 16) *(LAS u16*)(sb + SL_T2 + ((16 + t) * 2 + hc) * 16 + 2 * ec) = bfc(acc); } }
                {   const f32x4 m0 = *(const LAS f32x4*)(Mf + r * 32 + 16 + 4 * h), m1 = *(const LAS f32x4*)(Mf + r * 32 + 24 + 4 * h);
                    u32x4 w; w.x = pkc(m0.x, m0.y); w.y = pkc(m0.z, m0.w); w.z = pkc(m1.x, m1.y); w.w = pkc(m1.z, m1.w);
                    *(LAS u32x4*)(sb + SL_MK + (r * 2 + h) * 16) = w; }
            }
            SC_BAR();
            if (wave < 2) { const int ib = wave;
                if (nroles == 2 && bt > 0) {
                    unsigned* fl = hflag + (u * 2 + ib) * 16;
                    while (__hip_atomic_load(fl, __ATOMIC_RELAXED, __HIP_MEMORY_SCOPE_AGENT) < (unsigned)bt) __builtin_amdgcn_s_sleep(1);
                    const unsigned* sl = (const unsigned*)(hslot + (size_t)((u * 2 + ib) * 2 + (role ^ 1)) * 2048);
#pragma unroll
                    for (int g = 0; g < 16; ++g) { X0[g] = __uint_as_float(__hip_atomic_load(sl + g * 64 + lane, __ATOMIC_RELAXED, __HIP_MEMORY_SCOPE_AGENT)); X1[g] = __uint_as_float(__hip_atomic_load(sl + 1024 + g * 64 + lane, __ATOMIC_RELAXED, __HIP_MEMORY_SCOPE_AGENT)); } }
                for (int c2 = 0; c2 < 8; ++c2) { LAS unsigned char* s2 = lds + c2 * SL_SIZE;
                    const bf16x8 vfrag = *(const LAS bf16x8*)(s2 + SL_VT + (ib * 32 + r) * 32 + h * 16), mk = *(const LAS bf16x8*)(s2 + SL_MK + (r * 2 + h) * 16);
                    f32x16 out;
#pragma unroll
                    for (int g = 0; g < 16; ++g) out[g] = 0.f;
                    out = MFMA32(mk, vfrag, out);
                    out = MFMA32(*(const LAS bf16x8*)(s2 + SL_AR + 0 * SL_QS + r * 32 + h * 16), pack_lo(X0), out);
                    out = MFMA32(*(const LAS bf16x8*)(s2 + SL_AR + 1 * SL_QS + r * 32 + h * 16), pack_hi(X0), out);
                    out = MFMA32(*(const LAS bf16x8*)(s2 + SL_AR + 2 * SL_QS + r * 32 + h * 16), pack_lo(X1), out);
                    out = MFMA32(*(const LAS bf16x8*)(s2 + SL_AR + 3 * SL_QS + r * 32 + h * 16), pack_hi(X1), out);
                    f32x16 sat;
#pragma unroll
                    for (int g = 0; g < 16; ++g) sat[g] = 0.f;
                    sat = MFMA32(*(const LAS bf16x8*)(s2 + SL_T2 + (r * 2 + h) * 16), pack_lo(out), sat);
                    LAS float* yb = (LAS float*)(s2 + SL_BK);
#pragma unroll
                    for (int e = 0; e < 8; ++e) { const int tm = 8 * (e >> 2) + 4 * h + (e & 3); yb[tm * 64 + ib * 32 + r] = out[8 + e] + sat[8 + e]; }
                    const bf16x8 sfrag = pack_lo(sat);
                    X0 = MFMA32(*(const LAS bf16x8*)(s2 + SL_KT + r * 32 + h * 16), vfrag, X0);
                    X1 = MFMA32(*(const LAS bf16x8*)(s2 + SL_KT + (32 + r) * 32 + h * 16), vfrag, X1);
                    X0 = MFMA32(*(const LAS bf16x8*)(s2 + SL_BT + r * 32 + h * 16), sfrag, X0);
                    X1 = MFMA32(*(const LAS bf16x8*)(s2 + SL_BT + (32 + r) * 32 + h * 16), sfrag, X1);
#pragma unroll
                    for (int q4 = 0; q4 < 4; ++q4) { const f32x4 w0 = *(const LAS f32x4*)(s2 + SL_WL + (8 * q4 + 4 * h) * 4), w1 = *(const LAS f32x4*)(s2 + SL_WL + (32 + 8 * q4 + 4 * h) * 4);
#pragma unroll
                        for (int e = 0; e < 4; ++e) { X0[4 * q4 + e] *= w0[e]; X1[4 * q4 + e] *= w1[e]; } } }
                if (nroles == 2 && bt + 1 < nbatch) {
                    unsigned* sl = (unsigned*)(hslot + (size_t)((u * 2 + ib) * 2 + role) * 2048);
#pragma unroll
                    for (int g = 0; g < 16; ++g) { __hip_atomic_store(sl + g * 64 + lane, __float_as_uint(X0[g]), __ATOMIC_RELAXED, __HIP_MEMORY_SCOPE_AGENT); __hip_atomic_store(sl + 1024 + g * 64 + lane, __float_as_uint(X1[g]), __ATOMIC_RELAXED, __HIP_MEMORY_SCOPE_AGENT); }
                    asm volatile("s_waitcnt vmcnt(0)" ::: "memory");
                    if (lane == 0) __hip_atomic_store(hflag + (u * 2 + ib) * 16, (unsigned)(bt + 1), __ATOMIC_RELAXED, __HIP_MEMORY_SCOPE_AGENT); } }
            SC_BAR();
            int tf = tid; asm volatile("" : "+v"(tf));
#pragma unroll
            for (int k8 = 0; k8 < 8; ++k8) { const int idx = tf + 512 * k8, slot = idx >> 9, tm = (idx >> 5) & 15, cp = idx & 31; const int n = bt * 8 + slot;
                const int tl = z ? (T - 1 - (16 * n + tm)) : (16 * n + tm); unsigned* addr = (unsigned*)((char*)Y + (unsigned)((((int)seqbase + tl) * 1024 + hd * 64 + 2 * cp) * 2));
                const LAS float* yb = (const LAS float*)(lds + slot * SL_SIZE + SL_BK); *addr = pk2(yb[tm * 64 + 2 * cp], yb[tm * 64 + 2 * cp + 1]); }
            SC_BAR();
        }
#undef SC_LOAD
#undef SC_BAR
    }
}

enum { PH_PREP = 0, PH_L0_NORM, PH_L0_GEMM_IN, PH_L0_CONV_FFTA, PH_L0_GEMM_DFT, PH_L0_GEMM_OUT, PH_F0_NORM, PH_F0 = 7  , PH_L1 = 19  , PH_F1_NORM = 37, PH_F1 = 38  , PH_FINAL = 50, PH_COUNT = 51 };

__device__ __forceinline__ void ffn_phase(unsigned char* ws, unsigned char* ob, LAS unsigned char* lds, int l, int sub) {
    const int chunk = sub / 3, op = sub % 3;
    if (op == 0) { EpiPlain E{(u16*)(ws + OFF_U), 5632}; gemm_phase(lds, (const u16*)(ws + OFF_H) + (size_t)chunk * 16384 * 1024, 1024, (const u16*)(ws + OFF_WUP) + (size_t)l * 5632 * 1024, 1024, 64, 22, 1024, E); }
    else if (op == 1) act_phase(ws, ob, lds, l, chunk);
    else { EpiResid E{(u16*)(ws + OFF_X) + (size_t)chunk * 16384 * 1024}; gemm_phase(lds, (const u16*)(ob + OUT_ACT), 2816, (const u16*)(ws + OFF_WDN) + (size_t)l * 1024 * 2816, 2816, 64, 4, 2816, E); }
}

__global__ void __launch_bounds__(512, 2) mk_fwd(P p) {
    extern __shared__ __attribute__((aligned(16))) unsigned char smem[];
    LAS unsigned char* lds = (LAS unsigned char*)smem;
    if (threadIdx.x < 31) ((LAS unsigned long long*)(lds + LDS_TAB))[threadIdx.x] = (unsigned long long)p.in[threadIdx.x];
    if (threadIdx.x == 0) { volatile LAS unsigned* xst = (volatile LAS unsigned*)(lds + LDS_TAB + 256); xst[0] = 0u; xst[1] = 0u; xst[2] = 0u;
        (void)xb_add(&((unsigned*)(p.ws + OFF_BAR))[XB_XCNT(xb_xcc_id())], 1u); }
    __syncthreads();
    for (int ph = p.ph_lo; ph < p.ph_hi; ++ph) {
        size_t oz = 0; asm volatile("" : "+s"(oz));
        unsigned char* ws = p.ws + oz; unsigned char* ob = (unsigned char*)p.out + oz;
        if (TM(0) && ph == PH_PREP) { prep_phase(ws, ob, lds); __syncthreads(); norm0_phase(ws, ob, lds); }
        else if (ph == PH_L0_NORM) continue;
        else if (TM(2) && ph == PH_L0_GEMM_IN) {
            { EpiPlain E{(u16*)(ob + OUT_PROJ), 1536}; gemm_phase(lds, (const u16*)(ws + OFF_H), 1024, (const u16*)(ws + OFF_WC), 1024, 256, 6, 1024, E); }
            __syncthreads();
            { EpiPlain E{(u16*)(ob + OUT_FT), 65536}; gemm_phase(lds, (const u16*)(ws + OFF_WF), 1024, (const u16*)(ws + OFF_H), 1024, 2, 256, 1024, E); }
        }
        else if (TM(3) && ph == PH_L0_CONV_FFTA) { yconv_phase(ws, ob, lds); __syncthreads(); stageA_phase(ws, ob, lds); }
        else if (TM(4) && ph == PH_L0_GEMM_DFT) { EpiDft E{(u16*)(ws + OFF_CAT)}; gemm_phase(lds, (const u16*)(ws + OFF_DFTA), 512, (const u16*)(ws + OFF_YP), 512, 2, 512, 512, E); }
        else if (TM(5) && ph == PH_L0_GEMM_OUT) { EpiOut0 E{IN(0), IN(1), (u16*)(ws + OFF_X)}; gemm_phase(lds, (const u16*)(ws + OFF_CAT), 1536, (const u16*)(ws + OFF_WEFF), 1536, 256, 4, 1536, E); }
        else if (TM(6) && ph == PH_F0_NORM) normx_phase(ws, ob, IN(3), 0);
        else if (TM(7) && ph >= PH_F0 && ph < PH_F0 + 12) ffn_phase(ws, ob, lds, 0, ph - PH_F0);
        else if (TM(8) && ph >= PH_L1 && ph < PH_L1 + 18) { const int hf = (ph - PH_L1) / 9, op = (ph - PH_L1) % 9;
            if (TM(10) && op == 0) norm1_phase(ws, ob, lds, hf);
            else if (TM(11) && op == 1) {
                { EpiRkvP E{(u16*)(ob + OUT_RKV), (size_t)HT * 1024, (u16*)(ob + OUT_P)};
                    gemm_phase(lds, (const u16*)(ws + OFF_HH), 1024, (const u16*)(ws + OFF_WRKV), 1024, 128, 15, 1024, E, 2, (size_t)HT * 1024 * 2); }
            }
            else if (TM(12) && op == 2) lprep_phase(ws, ob, hf);
            else if (TM(13) && op == 3) { EpiUp2 E{(u16*)(ws + OFF_D4), IN(14), IN(17)}; gemm_phase(lds, (const u16*)(ws + OFF_L), 256, (const u16*)(ws + OFF_WUP2), 256, 128, 16, 256, E); }
            else if (TM(14) && op == 4) rwprep_phase(ws, ob, lds);
            else if (TM(15) && op == 5) scan_phase(ws, ob, lds, hf);
            else if (TM(16) && op == 6) { EpiPlain E{(u16*)(ws + OFF_G), 1024}; gemm_phase(lds, (const u16*)(ws + OFF_LG), 256, (const u16*)(ws + OFF_WG2), 256, 128, 4, 256, E); }
            else if (TM(17) && op == 7) gn_phase(ws, ob, lds);
            else if (TM(18)) { EpiResid E{(u16*)(ws + OFF_X) + (size_t)hf * HT * 1024}; gemm_phase(lds, (const u16*)(ws + OFF_YG), 1024, (const u16*)(ws + OFF_WO), 1024, 128, 4, 1024, E); }
        }
        else if (TM(6) && ph == PH_F1_NORM) normx_phase(ws, ob, IN(3) + 1024, 0);
        else if (TM(7) && ph >= PH_F1 && ph < PH_F1 + 12) ffn_phase(ws, ob, lds, 1, ph - PH_F1);
        else if (TM(9) && ph == PH_FINAL) normx_phase(ws, ob, IN(4), 1);
        if (ph + 1 < p.ph_hi) {
            if (p.ph_hi < 0) cg::this_grid().sync();
            grid_bar((unsigned*)(p.ws + OFF_BAR), (volatile LAS unsigned*)(lds + LDS_TAB + 256));
        }
    }
}

extern "C" void kernel_launch(void* const* d_in, const int* in_sizes, int n_in, void* d_out, int out_size, void* d_ws, size_t ws_size, hipStream_t stream) {
    static int grid = 0;
    if (grid == 0) {
        if (n_in != 31 || ws_size < WS_NEED || out_size != 65536 * 1024) { fprintf(stderr, "kernel_launch: unexpected shapes (n_in %d, ws %zu, out %d)\n", n_in, ws_size, out_size); grid = -1; return; }
        int dev = 0, cus = 0, per_cu = 0;
        hipGetDevice(&dev); hipDeviceGetAttribute(&cus, hipDeviceAttributeMultiprocessorCount, dev);
        if (hipFuncSetAttribute((const void*)mk_fwd, hipFuncAttributeMaxDynamicSharedMemorySize, LDS_BYTES) != hipSuccess) { fprintf(stderr, "kernel_launch: hipFuncSetAttribute failed\n"); grid = -1; return; }
        if (hipOccupancyMaxActiveBlocksPerMultiprocessor(&per_cu, (const void*)mk_fwd, 512, LDS_BYTES) != hipSuccess || per_cu < 1) { fprintf(stderr, "kernel_launch: occupancy query says %d\n", per_cu); per_cu = 1; }
        (void)hipGetLastError();
        grid = cus * per_cu;
    }
    if (grid < 0) return;
    if (hipMemsetAsync((unsigned char*)d_ws + OFF_BAR, 0, 16384 + 128 * 2 * 64, stream) != hipSuccess) { fprintf(stderr, "kernel_launch: memset failed\n"); return; }
    P p{};
    for (int i = 0; i < 31; ++i) p.in[i] = (const float*)d_in[i];
    p.out = (float*)d_out; p.ws = (unsigned char*)d_ws;
#if MK_PER_PHASE
    for (int ph = 0; ph < PH_COUNT; ++ph) { p.ph_lo = ph; p.ph_hi = ph + 1; hipLaunchKernelGGL(mk_fwd, dim3(grid), dim3(512), LDS_BYTES, stream, p); }
#else
    p.ph_lo = 0; p.ph_hi = PH_COUNT;
    void* args[] = {&p};
    hipError_t e = hipLaunchCooperativeKernel((const void*)mk_fwd, dim3(grid), dim3(512), args, LDS_BYTES, stream);
    if (e != hipSuccess) fprintf(stderr, "kernel_launch: cooperative launch failed: %s (grid %d)\n", hipGetErrorString(e), grid);
#endif
}
```

```cpp
#include <hip/hip_runtime.h>
#include <hip/hip_cooperative_groups.h>
#include <cstdio>
namespace cg = cooperative_groups;

#ifndef PROBE_DUP
#define PROBE_DUP 0
#define PROBE_LO 0
#define PROBE_HI 0
#endif
#ifndef MK_PER_PHASE
#define MK_PER_PHASE 0
#endif

#ifndef TESTMASK
#define TESTMASK 0xFFFFFFF
#endif
#define TM(k) ((TESTMASK >> (k)) & 1)
#define LAS __attribute__((address_space(3)))
typedef unsigned short u16;
typedef short bf16x8 __attribute__((ext_vector_type(8)));
typedef float f32x4 __attribute__((ext_vector_type(4)));
typedef unsigned u32x4 __attribute__((ext_vector_type(4)));
typedef unsigned u32x2 __attribute__((ext_vector_type(2)));

__device__ __forceinline__ int opaque_tid() { int t = threadIdx.x; asm volatile("" : "+v"(t)); return t; }
constexpr int LDS_BYTES = 160 * 1024;
constexpr int LDS_TAB = LDS_BYTES - 512;
__device__ __forceinline__ const float* in_ptr(LAS unsigned char* lds, int i) {
    const LAS unsigned* t = (const LAS unsigned*)(lds + LDS_TAB) + 2 * i; const unsigned lo = __builtin_amdgcn_readfirstlane(t[0]), hi = __builtin_amdgcn_readfirstlane(t[1]);
    return (const float*)(((unsigned long long)hi << 32) | lo); }
#define IN(i) in_ptr(lds, (i))
constexpr size_t MiB = 1ull << 20;
constexpr int HT = 32768;
constexpr size_t OFF_WC = 0;
constexpr size_t OFF_WF = OFF_WC + 1536ull * 1024 * 2;
constexpr size_t OFF_WEFF = OFF_WF + 512ull * 1024 * 2;
constexpr size_t OFF_DFTA = OFF_WEFF + 1024ull * 1536 * 2;
constexpr size_t OFF_WUP = OFF_DFTA + 512ull * 512 * 2;
constexpr size_t OFF_WDN = OFF_WUP + 2ull * 5632 * 1024 * 2;
constexpr size_t OFF_WRKV = OFF_WDN + 2ull * 1024 * 2816 * 2;
constexpr size_t OFF_WLORA = OFF_WRKV + 3072ull * 1024 * 2;
constexpr size_t OFF_WRKV_END = OFF_WRKV + 3072ull * 2048 * 2;
constexpr size_t OFF_WUP2 = OFF_WRKV_END + 768ull * 1024 * 2;
constexpr size_t OFF_WG2 = OFF_WUP2 + 4096ull * 256 * 2;
constexpr size_t OFF_WO = OFF_WG2 + 1024ull * 256 * 2;
constexpr size_t OFF_WEND = OFF_WO + 1024ull * 1024 * 2;
static_assert(OFF_WEND <= 60 * MiB, "weights region");
constexpr size_t OFF_X = 64 * MiB;
constexpr size_t OFF_R0 = 192 * MiB;
constexpr size_t WS_NEED = 512 * MiB;
constexpr size_t OFF_H = OFF_R0;
constexpr size_t OFF_YP = OFF_R0;
constexpr size_t OFF_CAT = OFF_R0 + 128 * MiB;
constexpr size_t OUT_PROJ = 0;
constexpr size_t OUT_FT = 192 * MiB;
constexpr size_t OFF_U = OFF_R0 + 128 * MiB;
constexpr size_t OUT_ACT = 0;
constexpr size_t OFF_HH = OFF_R0;
constexpr size_t OUT_RKV = 0;
constexpr size_t OUT_P = 192 * MiB;
constexpr size_t OUT_Y = 192 * MiB;
constexpr size_t OFF_D4 = OFF_R0;
constexpr size_t OFF_L = OFF_R0 + 256 * MiB;
constexpr size_t OFF_LG = OFF_R0 + 272 * MiB;
constexpr size_t OFF_INV = OFF_R0 + 288 * MiB;
constexpr size_t OFF_BON = OFF_R0 + 290 * MiB;
constexpr size_t OFF_G = OFF_R0;
constexpr size_t OFF_YG = OFF_R0 + 64 * MiB;

constexpr size_t OFF_HSLOT = 60 * MiB;
constexpr size_t OFF_BAR = 59 * MiB;
struct P { const float* in[31]; float* out; unsigned char* ws; int ph_lo, ph_hi; };

__device__ __forceinline__ float bflo(unsigned w) { return __uint_as_float(w << 16); }
__device__ __forceinline__ float bfhi(unsigned w) { return __uint_as_float(w & 0xffff0000u); }
__device__ __forceinline__ float bf2f(u16 v) { return __uint_as_float((unsigned)v << 16); }
__device__ __forceinline__ unsigned pk2(float lo, float hi) { unsigned r; asm("v_cvt_pk_bf16_f32 %0, %1, %2" : "=v"(r) : "v"(lo), "v"(hi)); return r; }
__device__ __forceinline__ u16 f2bf(float v) { return (u16)(pk2(v, 0.f) & 0xffffu); }
__device__ __forceinline__ u32x4 pk8(const float* v) { u32x4 o; o.x = pk2(v[0], v[1]); o.y = pk2(v[2], v[3]); o.z = pk2(v[4], v[5]); o.w = pk2(v[6], v[7]); return o; }
__device__ __forceinline__ void unpk8(u32x4 w, float* v) { v[0] = bflo(w.x); v[1] = bfhi(w.x); v[2] = bflo(w.y); v[3] = bfhi(w.y); v[4] = bflo(w.z); v[5] = bfhi(w.z); v[6] = bflo(w.w); v[7] = bfhi(w.w); }
#define DPP_ADD(v, ctrl) v += __int_as_float(__builtin_amdgcn_update_dpp(0, __float_as_int(v), ctrl, 0xF, 0xF, true))
__device__ __forceinline__ float allreduce16(float v) { DPP_ADD(v, 0xB1); DPP_ADD(v, 0x4E); DPP_ADD(v, 0x141); DPP_ADD(v, 0x140); return v; }
__device__ __forceinline__ float wave_sum(float v) {
    v = allreduce16(v);
    const float a = __int_as_float(__builtin_amdgcn_readlane(__float_as_int(v), 0)), b = __int_as_float(__builtin_amdgcn_readlane(__float_as_int(v), 16)),
                c = __int_as_float(__builtin_amdgcn_readlane(__float_as_int(v), 32)), d = __int_as_float(__builtin_amdgcn_readlane(__float_as_int(v), 48));
    return (a + b) + (c + d); }
__device__ __forceinline__ float allreduce4(float v) { DPP_ADD(v, 0xB1); DPP_ADD(v, 0x4E); return v; }
__device__ __forceinline__ float sigmoidf_(float x) { return __builtin_amdgcn_rcpf(1.f + __expf(-x)); }
__device__ __forceinline__ int seqT(int t) { return t < HT ? 4096 : 8192; }

#define XB_XCNT(j)  (256  + 64 * (j))
#define XB_XSUB(j)  (1280 + 64 * (j))
#define XB_XGEN(j)  (2304 + 64 * (j))
#define XB_TOP      3328
#define XB_TOPGEN   3392
#define XCD_BAR_WORDS 3456
__device__ __forceinline__ unsigned xb_ld(unsigned* p)              { return __hip_atomic_load(p, __ATOMIC_RELAXED, __HIP_MEMORY_SCOPE_AGENT); }
__device__ __forceinline__ unsigned xb_add(unsigned* p, unsigned v) { return __hip_atomic_fetch_add(p, v, __ATOMIC_RELAXED, __HIP_MEMORY_SCOPE_AGENT); }
__device__ __forceinline__ unsigned xb_xcc_id() { return (unsigned)__builtin_amdgcn_s_getreg((3 << 11) | 20) & 0xFu; }
__device__ __forceinline__ void grid_bar(unsigned* bar, volatile LAS unsigned* st) {
    asm volatile("s_waitcnt vmcnt(0)" ::: "memory");
    __syncthreads();
    if (threadIdx.x == 0) {
        __builtin_amdgcn_s_waitcnt(0);
        const unsigned x = xb_xcc_id();
        unsigned nloc = st[0], nx = st[1]; const unsigned gen = st[2]; st[2] = gen + 1u;
        if (nloc == 0u) {
            for (;;) { unsigned sum = 0u, cnt = 0u, mine = 0u;
#pragma unroll 1
                for (unsigned j = 0; j < 16; ++j) { const unsigned c = xb_ld(&bar[XB_XCNT(j)]); sum += c; cnt += (c > 0u) ? 1u : 0u; mine = (j == x) ? c : mine; }
                if (sum == gridDim.x) { nloc = mine; nx = cnt; break; }
                __builtin_amdgcn_s_sleep(1); }
            st[0] = nloc; st[1] = nx; }
        const unsigned old = xb_add(&bar[XB_XSUB(x)], 1u);
        if (old + 1u == (gen + 1u) * nloc) {
            __builtin_amdgcn_fence(__ATOMIC_RELEASE, "agent");
            asm volatile("s_waitcnt vmcnt(0)" ::: "memory");
            const unsigned og = xb_add(&bar[XB_TOP], 1u);
            if (og + 1u == (gen + 1u) * nx) xb_add(&bar[XB_TOPGEN], 1u);
            else while (xb_ld(&bar[XB_TOPGEN]) == gen) __builtin_amdgcn_s_sleep(1);
            __builtin_amdgcn_fence(__ATOMIC_ACQUIRE, "agent");
            xb_add(&bar[XB_XGEN(x)], 1u);
            asm volatile("s_waitcnt vmcnt(0)" ::: "memory");
        } else {
            while (xb_ld(&bar[XB_XGEN(x)]) == gen) __builtin_amdgcn_s_sleep(1);
            __builtin_amdgcn_fence(__ATOMIC_ACQUIRE, "agent");
            asm volatile("s_waitcnt vmcnt(0)" ::: "memory");
        }
    }
    __syncthreads();
}
constexpr int HTB = 128 * 64 * 2;
__device__ __forceinline__ int lds_byte(int r, int c) { const int st = (r >> 4) * 2 + (c >> 5), rr = r & 15, cc = c & 31, ob = rr * 64 + cc * 2; return st * 1024 + (ob ^ (((ob >> 9) & 1) << 5)); }
__device__ __forceinline__ void stage_rc(int b, int& R, int& C) { const int st = b / 1024, sb = b % 1024, swz = sb ^ (((sb >> 9) & 1) << 5); R = (st >> 1) * 16 + swz / 64; C = (st & 1) * 32 + (swz % 64) / 2; }
__device__ __forceinline__ int perm32(int rho) { const int n = rho >> 4, i = rho & 15; return 8 * (i >> 2) + 4 * n + (i & 3); }
struct Unit { int pm, pn; };
__device__ __forceinline__ bool next_unit(int i, int nM, int nN, Unit& u) {
    const int nwg = nM * nN; const long L = (long)i * (long)gridDim.x + blockIdx.x; if (L >= nwg) return false;
    int wgid = (int)L; { const int q = nwg / 8, r = nwg % 8, xcd = wgid % 8, off = wgid / 8; wgid = (xcd < r ? xcd * (q + 1) : r * (q + 1) + (xcd - r) * q) + off; }
    const int nig = 8 * nN, gid = wgid / nig, fm = gid * 8, gsz = (nM - fm) < 8 ? (nM - fm) : 8;
    u.pm = fm + ((wgid % nig) % gsz); u.pn = (wgid % nig) / gsz; return true;
}

template <class Epi>
__device__ __forceinline__ void gemm_phase(LAS unsigned char* lds, const u16* A, int lda, const u16* Bt, int ldb, int nM, int nN, int K, const Epi& E, int ashift = 31, size_t astride = 0) {
    int tid = opaque_tid();
    const int wid = __builtin_amdgcn_readfirstlane(tid >> 6), lane = tid & 63, wr = wid >> 2, wc = wid & 3, fr = lane & 15, fq = lane >> 4;
    const int nt = K / 64;
    unsigned voffA[2], voffB[2];
#pragma unroll
    for (int i = 0; i < 2; ++i) { int R, C; stage_rc(tid * 16 + i * 8192, R, C); const int Rb = (R & ~31) + perm32(R & 31);
        voffA[i] = (unsigned)(R * lda + C) * 2u; voffB[i] = (unsigned)(Rb * ldb + C) * 2u; }
    const size_t kstep = 128;
    const size_t hstepA = (size_t)128 * lda * 2, hstepB = (size_t)128 * ldb * 2, tstepA = 2 * hstepA, tstepB = 2 * hstepB;
    const unsigned ldsw = (unsigned)wid * 1024u;
    const int aoff = lds_byte(wr * 64 + fr, fq * 8), boff = lds_byte(wc * 32 + fr, fq * 8);
#define G_SA(b, h) (((b) * 2 + (h)) * HTB)
#define G_SB(b, h) ((4 + (b) * 2 + (h)) * HTB)
#define G_STAGE(bufoff, gbase, voff) do { _Pragma("unroll") for (int _i = 0; _i < 2; ++_i) \
        __builtin_amdgcn_global_load_lds((const unsigned*)((const char*)(gbase) + (voff)[_i]), (LAS unsigned*)(lds + (bufoff) + ldsw + _i * 8192), 16, 0, 0); } while (0)
#define G_LDA(dst, b, h) do { _Pragma("unroll") for (int m = 0; m < 4; ++m) _Pragma("unroll") for (int k = 0; k < 2; ++k) dst[m][k] = *(const LAS bf16x8*)(lds + G_SA(b, h) + aoff + m * 2048 + k * 1024); } while (0)
#define G_LDB(dst, b, h) do { _Pragma("unroll") for (int n = 0; n < 2; ++n) _Pragma("unroll") for (int k = 0; k < 2; ++k) dst[n][k] = *(const LAS bf16x8*)(lds + G_SB(b, h) + boff + n * 2048 + k * 1024); } while (0)
#define G_MMA(ai, bj, At, Bt_) do { __builtin_amdgcn_s_setprio(1); _Pragma("unroll") for (int m = 0; m < 4; ++m) _Pragma("unroll") for (int n = 0; n < 2; ++n) _Pragma("unroll") for (int k = 0; k < 2; ++k) \
        acc[ai][bj][m][n] = __builtin_amdgcn_mfma_f32_16x16x32_bf16(Bt_[n][k], At[m][k], acc[ai][bj][m][n], 0, 0, 0); __builtin_amdgcn_s_setprio(0); } while (0)
#define G_WAIT_V(n) asm volatile("s_waitcnt vmcnt(" #n ")" ::: "memory")
#define G_WAIT_L(n) asm volatile("s_waitcnt lgkmcnt(" #n ")" ::: "memory")
#define G_BAR __builtin_amdgcn_s_barrier()
#define G_SCHED __builtin_amdgcn_sched_barrier(0)
    Unit cur, nxt; int ui = 0;
    if (!next_unit(0, nM, nN, cur)) return;
    f32x4 acc[2][2][4][2];
#pragma unroll
    for (int a = 0; a < 2; ++a)
#pragma unroll
        for (int b = 0; b < 2; ++b)
#pragma unroll
            for (int m = 0; m < 4; ++m)
#pragma unroll
                for (int n = 0; n < 2; ++n) acc[a][b][m][n] = (f32x4){0.f, 0.f, 0.f, 0.f};
    bf16x8 At[4][2], B0[2][2], B1[2][2];
    const char* cA = (const char*)A + (size_t)(cur.pn >> ashift) * astride + (size_t)cur.pm * tstepA; const char* cB = (const char*)Bt + (size_t)cur.pn * tstepB;
    G_STAGE(G_SB(0, 0), cB, voffB); G_STAGE(G_SA(0, 0), cA, voffA); G_STAGE(G_SB(0, 1), cB + hstepB, voffB); G_STAGE(G_SA(0, 1), cA + hstepA, voffA);
    if (wr == 1) G_BAR;
    G_WAIT_V(4); G_BAR;
    G_STAGE(G_SB(1, 0), cB + kstep, voffB); G_STAGE(G_SA(1, 0), cA + kstep, voffA); G_STAGE(G_SB(1, 1), cB + hstepB + kstep, voffB);
    G_WAIT_V(6); G_BAR;
    for (;;) {
        const bool has_next = next_unit(ui + 1, nM, nN, nxt);
        const char* nA = has_next ? (const char*)A + (size_t)(nxt.pn >> ashift) * astride + (size_t)nxt.pm * tstepA : cA; const char* nB = has_next ? (const char*)Bt + (size_t)nxt.pn * tstepB : cB;
        for (int t = 0; t < nt; t += 2) {
            const bool last = (t == nt - 2);
            const char* a1 = cA + (size_t)(t + 1) * kstep;
            const char* a2 = last ? nA : cA + (size_t)(t + 2) * kstep; const char* b2 = last ? nB : cB + (size_t)(t + 2) * kstep;
            const char* a3 = a2 + kstep; const char* b3 = b2 + kstep;
            G_LDB(B0, 0, 0); G_SCHED; G_LDA(At, 0, 0); G_STAGE(G_SA(1, 1), a1 + hstepA, voffA);
            G_WAIT_L(8); G_BAR; G_WAIT_L(0); G_MMA(0, 0, At, B0); G_BAR; G_SCHED;
            G_LDB(B1, 0, 1); G_STAGE(G_SB(0, 0), b2, voffB);
            G_BAR; G_WAIT_L(0); G_MMA(0, 1, At, B1); G_BAR;
            G_LDA(At, 0, 1); G_STAGE(G_SA(0, 0), a2, voffA);
            G_BAR; G_WAIT_L(0); G_MMA(1, 0, At, B0); G_BAR; G_SCHED;
            G_STAGE(G_SB(0, 1), b2 + hstepB, voffB);
            G_WAIT_V(6); G_BAR; G_MMA(1, 1, At, B1); G_BAR;
            G_LDB(B0, 1, 0); G_SCHED; G_LDA(At, 1, 0); G_STAGE(G_SA(0, 1), a2 + hstepA, voffA);
            G_WAIT_L(8); G_BAR; G_WAIT_L(0); G_MMA(0, 0, At, B0); G_BAR; G_SCHED;
            G_LDB(B1, 1, 1); G_STAGE(G_SB(1, 0), b3, voffB);
            G_BAR; G_WAIT_L(0); G_MMA(0, 1, At, B1); G_BAR;
            G_LDA(At, 1, 1); G_STAGE(G_SA(1, 0), a3, voffA);
            G_BAR; G_WAIT_L(0); G_MMA(1, 0, At, B0); G_BAR; G_SCHED;
            G_STAGE(G_SB(1, 1), b3 + hstepB, voffB);
            G_WAIT_V(6); G_BAR; G_MMA(1, 1, At, B1); G_BAR;
        }
        {
            const int row0 = cur.pm * 256 + wr * 64 + fr, col0 = cur.pn * 256 + wc * 32 + 8 * fq;
            if constexpr (Epi::PRE == 1) {
#pragma unroll
                for (int ai = 0; ai < 2; ++ai) { u32x4 pre[8];
#pragma unroll
                    for (int m = 0; m < 4; ++m)
#pragma unroll
                        for (int bj = 0; bj < 2; ++bj) pre[m * 2 + bj] = E.pre(row0 + ai * 128 + m * 16, col0 + bj * 128);
#pragma unroll
                    for (int m = 0; m < 4; ++m)
#pragma unroll
                        for (int bj = 0; bj < 2; ++bj) E.store(row0 + ai * 128 + m * 16, col0 + bj * 128, acc[ai][bj][m][0], acc[ai][bj][m][1], pre[m * 2 + bj]); } }
            else if constexpr (Epi::PRE == 2) {
#pragma unroll
                for (int bj = 0; bj < 2; ++bj) { f32x4 cb0, cb1; E.cpre(col0 + bj * 128, cb0, cb1);
#pragma unroll
                    for (int ai = 0; ai < 2; ++ai)
#pragma unroll
                        for (int m = 0; m < 4; ++m) E.store(row0 + ai * 128 + m * 16, col0 + bj * 128, acc[ai][bj][m][0], acc[ai][bj][m][1], cb0, cb1); } }
            else if constexpr (Epi::PRE == 3) {
#pragma unroll
                for (int ai = 0; ai < 2; ++ai)
#pragma unroll
                    for (int mp = 0; mp < 2; ++mp) { f32x4 pa[4], pb[4];
#pragma unroll
                        for (int mm = 0; mm < 2; ++mm)
#pragma unroll
                            for (int bj = 0; bj < 2; ++bj) E.pre2(row0 + ai * 128 + (2 * mp + mm) * 16, col0 + bj * 128, pa[mm * 2 + bj], pb[mm * 2 + bj]);
#pragma unroll
                        for (int mm = 0; mm < 2; ++mm)
#pragma unroll
                            for (int bj = 0; bj < 2; ++bj) E.store(row0 + ai * 128 + (2 * mp + mm) * 16, col0 + bj * 128, acc[ai][bj][2 * mp + mm][0], acc[ai][bj][2 * mp + mm][1], pa[mm * 2 + bj], pb[mm * 2 + bj]); } }
            else {
#pragma unroll
                for (int ai = 0; ai < 2; ++ai)
#pragma unroll
                    for (int m = 0; m < 4; ++m)
#pragma unroll
                        for (int bj = 0; bj < 2; ++bj) E.store(row0 + ai * 128 + m * 16, col0 + bj * 128, acc[ai][bj][m][0], acc[ai][bj][m][1]); }
        }
        if (!has_next) break;
#pragma unroll
        for (int a = 0; a < 2; ++a)
#pragma unroll
            for (int b = 0; b < 2; ++b)
#pragma unroll
                for (int m = 0; m < 4; ++m)
#pragma unroll
                    for (int n = 0; n < 2; ++n) acc[a][b][m][n] = (f32x4){0.f, 0.f, 0.f, 0.f};
        cur = nxt; cA = nA; cB = nB; ++ui;
    }
    G_WAIT_V(0);
    if (wr == 0) G_BAR;
    G_BAR;
#undef G_SA
#undef G_SB
#undef G_STAGE
#undef G_LDA
#undef G_LDB
#undef G_MMA
#undef G_WAIT_V
#undef G_WAIT_L
#undef G_BAR
#undef G_SCHED
}

__device__ __forceinline__ u32x4 pkv(f32x4 v0, f32x4 v1) { u32x4 w; w.x = pk2(v0.x, v0.y); w.y = pk2(v0.z, v0.w); w.z = pk2(v1.x, v1.y); w.w = pk2(v1.z, v1.w); return w; }
struct EpiPlain { static constexpr int PRE = 0; u16* O; size_t ld;
    __device__ __forceinline__ void store(int row, int col, f32x4 v0, f32x4 v1) const { *(u32x4*)(O + (size_t)row * ld + col) = pkv(v0, v1); } };
struct EpiSplit { static constexpr int PRE = 0; u16* O; size_t stride;
    __device__ __forceinline__ void store(int row, int col, f32x4 v0, f32x4 v1) const { const int t = col >> 10; *(u32x4*)(O + (size_t)t * stride + (size_t)row * 1024 + (col & 1023)) = pkv(v0, v1); } };
struct EpiRkvP { static constexpr int PRE = 0; u16* O; size_t stride; u16* Pb;
    __device__ __forceinline__ void store(int row, int col, f32x4 v0, f32x4 v1) const { const int t = col >> 10;
        u16* dst = (t < 3) ? O + (size_t)t * stride + (size_t)row * 1024 + (col & 1023) : Pb + (size_t)row * 768 + (col - 3072);
        *(u32x4*)dst = pkv(v0, v1); } };
struct EpiDft { static constexpr int PRE = 0; u16* CAT;
    __device__ __forceinline__ void store(int row, int col, f32x4 v0, f32x4 v1) const {
        const int ri = row >> 8, k1 = row & 255; int tok;
        if (col < 65536) { const int b = col >> 13, k2 = (col >> 9) & 15; tok = b * 4096 + k1 * 16 + k2; }
        else { const int n2 = col - 65536; const int b = n2 >> 14, k2 = (n2 >> 9) & 31; tok = HT + b * 8192 + k1 * 32 + k2; }
        const int ch = col & 511;
        *(u32x4*)(CAT + (size_t)tok * 1536 + 512 + ri * 512 + ch) = pkv(v0, v1); } };
struct EpiOut0 { static constexpr int PRE = 3; const float* xp; const float* xs; u16* X;
    __device__ __forceinline__ void pre2(int row, int col, f32x4& a, f32x4& b) const {
        const float* src = (row < HT ? xp + (size_t)row * 1024 : xs + (size_t)(row - HT) * 1024) + col; a = *(const f32x4*)src; b = *(const f32x4*)(src + 4); }
    __device__ __forceinline__ void store(int row, int col, f32x4 v0, f32x4 v1, f32x4 a, f32x4 b) const { *(u32x4*)(X + (size_t)row * 1024 + col) = pkv(a + v0, b + v1); } };
struct EpiResid { static constexpr int PRE = 1; u16* X;
    __device__ __forceinline__ u32x4 pre(int row, int col) const { return *(const u32x4*)(X + (size_t)row * 1024 + col); }
    __device__ __forceinline__ void store(int row, int col, f32x4 v0, f32x4 v1, u32x4 w) const {
        f32x4 a = {bflo(w.x), bfhi(w.x), bflo(w.y), bfhi(w.y)}, b = {bflo(w.z), bfhi(w.z), bflo(w.w), bfhi(w.w)};
        *(u32x4*)(X + (size_t)row * 1024 + col) = pkv(a + v0, b + v1); } };
struct EpiUp2 { static constexpr int PRE = 2; u16* D4; const float* w0; const float* a0;
    __device__ __forceinline__ void cpre(int col, f32x4& b0, f32x4& b1) const { const int gi = col >> 10, c = col & 1023; const float* bias = (gi < 2 ? w0 + gi * 1024 : a0 + (gi - 2) * 1024) + c; b0 = *(const f32x4*)bias; b1 = *(const f32x4*)(bias + 4); }
    __device__ __forceinline__ void store(int row, int col, f32x4 v0, f32x4 v1, f32x4 b0, f32x4 b1) const {
        const int gi = col >> 10, c = col & 1023; const float sc = gi < 2 ? -0.60653066f * 1.44269504f : 1.f;     f32x4 x0 = v0 + b0, x1 = v1 + b1;
#pragma unroll
        for (int j = 0; j < 4; ++j) { x0[j] = sc * __builtin_amdgcn_rcpf(1.f + __expf(-x0[j])); x1[j] = sc * __builtin_amdgcn_rcpf(1.f + __expf(-x1[j])); }
        *(u32x4*)(D4 + (size_t)gi * ((size_t)HT * 1024) + (size_t)row * 1024 + c) = pkv(x0, x1); } };
struct Job { const float* src; const float* vec; u16* dst; int ldsrc, lddst, K, N; float c0, c1; };
__device__ __forceinline__ bool get_job(unsigned char* ws, unsigned char* ob, LAS unsigned char* lds, int j, Job& jb) {
    jb.vec = nullptr; jb.c0 = 1.f; jb.c1 = 0.f;
    if (j == 0) { jb.src = IN(5); jb.ldsrc = 2048; jb.dst = (u16*)(ws + OFF_WC); jb.lddst = 1024; jb.K = 1024; jb.N = 1536; return true; }
    if (j == 1) { jb.src = IN(5) + 1536; jb.ldsrc = 2048; jb.dst = (u16*)(ws + OFF_WF); jb.lddst = 1024; jb.K = 1024; jb.N = 512; return true; }
    if (j == 2) { jb.src = IN(7); jb.ldsrc = 1024; jb.dst = (u16*)(ws + OFF_WEFF); jb.lddst = 1536; jb.K = 512; jb.N = 1024; return true; }
    if (j < 5) { const int l = j - 3; jb.src = IN(27) + (size_t)l * 1024 * 5632; jb.ldsrc = 5632; jb.dst = (u16*)(ws + OFF_WUP) + (size_t)l * 5632 * 1024; jb.lddst = 1024; jb.K = 1024; jb.N = 5632; return true; }
    if (j < 7) { const int l = j - 5; jb.src = IN(30) + (size_t)l * 2816 * 1024; jb.ldsrc = 1024; jb.dst = (u16*)(ws + OFF_WDN) + (size_t)l * 1024 * 2816; jb.lddst = 2816; jb.K = 2816; jb.N = 1024; return true; }
    if (j < 10) { const int q = j - 7; jb.src = IN(10 + q); jb.ldsrc = 1024; jb.dst = (u16*)(ws + OFF_WRKV) + (size_t)q * 1024 * 1024; jb.lddst = 1024; jb.K = 1024; jb.N = 1024; return true; }
    if (j < 13) { jb.src = IN(10); jb.ldsrc = 1024; jb.dst = (u16*)(ws + OFF_WRKV); jb.lddst = 1024; jb.K = 0; jb.N = 32; return true; }
    if (j < 21) { const int i = (j - 13) >> 1, part = (j - 13) & 1, z = i & 1, which = i >> 1; jb.src = IN(which ? 18 : 15) + (size_t)z * 1024 * 64; jb.ldsrc = 64; jb.vec = IN(9) + (z * 2 + which) * 1024;
        jb.c0 = part ? 0.f : 1.f; jb.c1 = part ? 1.f : -1.f; jb.dst = (u16*)(ws + OFF_WLORA) + (size_t)(i * 128 + part * 64) * 1024; jb.lddst = 1024; jb.K = 1024; jb.N = 64; return true; }
    if (j < 23) { const int part = j - 21; jb.src = IN(20); jb.ldsrc = 128; jb.vec = IN(8) + 3 * 1024; jb.c0 = part ? 0.f : 1.f; jb.c1 = part ? 0.5f : -1.f;
        jb.dst = (u16*)(ws + OFF_WLORA) + (size_t)(512 + part * 128) * 1024; jb.lddst = 1024; jb.K = 1024; jb.N = 128; return true; }
    if (j == 23) { jb.src = IN(13); jb.ldsrc = 1024; jb.dst = (u16*)(ws + OFF_WO); jb.lddst = 1024; jb.K = 1024; jb.N = 1024; return true; }
    return false;
}
__device__ __forceinline__ void tr_item(const Job& jb, LAS float* scr, int item, int lane) {
    const int nblk = jb.N / 32, kb = item / nblk, nb = item % nblk, k0 = 64 * kb, n0 = 32 * nb;
#pragma unroll 8
    for (int i = 0; i < 32; ++i) { const int kk = 2 * i + (lane >> 5); const float s = jb.vec ? jb.c0 + jb.c1 * jb.vec[k0 + kk] : 1.f;
        scr[kk * 33 + (lane & 31)] = jb.src[(size_t)(k0 + kk) * jb.ldsrc + n0 + (lane & 31)] * s; }
    asm volatile("s_waitcnt lgkmcnt(0)" ::: "memory");
    const int c = lane & 7;
#pragma unroll
    for (int j = 0; j < 4; ++j) { const int n = (lane >> 3) + 8 * j; const LAS float* s = scr + (8 * c) * 33 + n;
        u32x4 o; o.x = pk2(s[0 * 33], s[1 * 33]); o.y = pk2(s[2 * 33], s[3 * 33]); o.z = pk2(s[4 * 33], s[5 * 33]); o.w = pk2(s[6 * 33], s[7 * 33]);
        *(u32x4*)(jb.dst + (size_t)(n0 + n) * jb.lddst + k0 + 8 * c) = o; }
    asm volatile("s_waitcnt lgkmcnt(0)" ::: "memory");
}
__device__ __forceinline__ void prep_phase(unsigned char* ws, unsigned char* ob, LAS unsigned char* lds) {
    const int tid = opaque_tid(), lane = tid & 63, wave = tid >> 6;
    LAS float* scr = (LAS float*)(lds + wave * 16384);
    const int gw = blockIdx.x * 8 + wave, NGW = gridDim.x * 8;
    int base = 0;
    for (int j = 0; j < 24; ++j) { Job jb; get_job(ws, ob, lds, j, jb); const int cnt = (jb.K / 64) * (jb.N / 32);
        int first = (gw - base % NGW + NGW) % NGW;
        for (int it = first; it < cnt; it += NGW) tr_item(jb, scr, it, lane);
        base += cnt; }
    const size_t gt = (size_t)blockIdx.x * 512 + tid, NT = (size_t)gridDim.x * 512;
    {
        u16* WE = (u16*)(ws + OFF_WEFF); const float* wo = IN(7);
        for (size_t i = gt; i < 512ull * 1024; i += NT) { const int d = (int)(i & 1023), gc = (int)(i >> 10), g = gc >> 7, c = gc & 127;
            float sr = 0.f, si = 0.f;
            for (int c2 = 0; c2 < 128; ++c2) { const float fr = (float)((c * c2) & 127) * (1.f / 128.f); const float w = wo[(size_t)(512 + 128 * g + c2) * 1024 + d];
                sr += __builtin_amdgcn_cosf(fr) * w; si += __builtin_amdgcn_sinf(fr) * w; }
            WE[(size_t)d * 1536 + 512 + gc] = f2bf(sr * 0.08838834764f); WE[(size_t)d * 1536 + 1024 + gc] = f2bf(si * 0.08838834764f); }
    }
    {
        u16* DA = (u16*)(ws + OFF_DFTA);
        for (size_t i = gt; i < 512ull * 512; i += NT) { const int kk = (int)(i & 511), m = (int)(i >> 9); const int rio = m >> 8, k1 = m & 255, rii = kk >> 8, t1 = kk & 255;
            const float fr = (float)((k1 * t1) & 255) * (1.f / 256.f); const float c = __builtin_amdgcn_cosf(fr), s = __builtin_amdgcn_sinf(fr);
            DA[i] = f2bf(rio == rii ? c : (rio == 0 ? s : -s)); }
    }
    {
        u16* W2 = (u16*)(ws + OFF_WUP2);
        for (size_t i = gt; i < 4096ull * 256; i += NT) { const int k = (int)(i & 255), n = (int)(i >> 8), gi = n >> 10, c = n & 1023; float v = 0.f;
            if ((k >> 6) == gi) { const int z = gi & 1; const float* src = (gi < 2 ? IN(16) : IN(19)) + (size_t)z * 64 * 1024; v = src[(size_t)(k & 63) * 1024 + c]; }
            W2[i] = f2bf(v); }
        u16* WG = (u16*)(ws + OFF_WG2);
        for (size_t i = gt; i < 1024ull * 256; i += NT) { const int k = (int)(i & 255), n = (int)(i >> 8); WG[i] = f2bf(k < 128 ? IN(21)[(size_t)k * 1024 + n] : 0.f); }
    }
}

__device__ __forceinline__ void load_row_bf(const u16* row, int lane, float* v) { unpk8(*(const u32x4*)(row + 8 * lane), v); unpk8(*(const u32x4*)(row + 512 + 8 * lane), v + 8); }
__device__ __forceinline__ float rstd_of(const float* v) { float s = 0.f;
#pragma unroll
    for (int j = 0; j < 16; ++j) s += v[j] * v[j];
    return 1.f / sqrtf(wave_sum(s) * (1.f / 1024.f) + 1e-6f); }
__device__ __forceinline__ void norm0_phase(unsigned char* ws, unsigned char* ob, LAS unsigned char* lds) {
    const int tix = opaque_tid(); const int lane = tix & 63, gw = blockIdx.x * 8 + (tix >> 6), NGW = gridDim.x * 8;
    u16* H = (u16*)(ws + OFF_H); const float* g = IN(2);
    f32x4 gv[4];
#pragma unroll
    for (int j = 0; j < 4; ++j) gv[j] = *(const f32x4*)(g + 4 * lane + 256 * j);
    for (int t = gw; t < 65536; t += NGW) { const float* xr = t < HT ? IN(0) + (size_t)t * 1024 : IN(1) + (size_t)(t - HT) * 1024;
        f32x4 v[4]; float s = 0.f;
#pragma unroll
        for (int j = 0; j < 4; ++j) { v[j] = *(const f32x4*)(xr + 4 * lane + 256 * j); s += v[j].x * v[j].x + v[j].y * v[j].y + v[j].z * v[j].z + v[j].w * v[j].w; }
        const float r = 1.f / sqrtf(wave_sum(s) * (1.f / 1024.f) + 1e-6f);
#pragma unroll
        for (int j = 0; j < 4; ++j) { const f32x4 o = v[j] * r * gv[j]; u32x2 w; w.x = pk2(o.x, o.y); w.y = pk2(o.z, o.w); *(u32x2*)(H + (size_t)t * 1024 + 4 * lane + 256 * j) = w; } }
}
__device__ __forceinline__ void normx_phase(unsigned char* ws, unsigned char* ob, const float* g, int mode) {
    const int tix = opaque_tid(); const int lane = tix & 63, gw = blockIdx.x * 8 + (tix >> 6), NGW = gridDim.x * 8;
    const u16* X = (const u16*)(ws + OFF_X); u16* H = (u16*)(ws + OFF_H);
    float gv[16];
#pragma unroll
    for (int j = 0; j < 2; ++j)
#pragma unroll
        for (int e = 0; e < 8; ++e) gv[8 * j + e] = g[8 * lane + 512 * j + e];
    for (int t = gw; t < 65536; t += NGW) { float v[16]; load_row_bf(X + (size_t)t * 1024, lane, v); const float r = rstd_of(v);
#pragma unroll
        for (int j = 0; j < 16; ++j) v[j] = v[j] * r * gv[j];
        if (mode == 0) { *(u32x4*)(H + (size_t)t * 1024 + 8 * lane) = pk8(v); *(u32x4*)(H + (size_t)t * 1024 + 512 + 8 * lane) = pk8(v + 8); }
        else { float* o = ((float*)ob) + (size_t)t * 1024;
#pragma unroll
            for (int j = 0; j < 2; ++j) { *(f32x4*)(o + 8 * lane + 512 * j) = (f32x4){v[8 * j], v[8 * j + 1], v[8 * j + 2], v[8 * j + 3]}; *(f32x4*)(o + 8 * lane + 512 * j + 4) = (f32x4){v[8 * j + 4], v[8 * j + 5], v[8 * j + 6], v[8 * j + 7]}; } } }
}
__device__ __forceinline__ void norm1_phase(unsigned char* ws, unsigned char* ob, LAS unsigned char* lds, int hf) {
    const int tix = opaque_tid(); const int lane = tix & 63, gw = blockIdx.x * 8 + (tix >> 6), NGW = gridDim.x * 8;
    const u16* X = (const u16*)(ws + OFF_X) + (size_t)hf * HT * 1024; u16* XO = (u16*)(ws + OFF_HH); const float* g = IN(2) + 1024; const float* mu = IN(8);
    const int T = hf ? 8192 : 4096;
    float gv[16], m1[3][16], m2[3][16];
#pragma unroll
    for (int j = 0; j < 2; ++j)
#pragma unroll
        for (int e = 0; e < 8; ++e) { gv[8 * j + e] = g[8 * lane + 512 * j + e];
#pragma unroll
            for (int q = 0; q < 3; ++q) { const float mm = mu[q * 1024 + 8 * lane + 512 * j + e]; m1[q][8 * j + e] = 1.f - mm; m2[q][8 * j + e] = 0.5f * mm; } }
    for (int r0 = gw * 8; r0 < HT; r0 += NGW * 8) {
        const int pos0 = r0 & (T - 1);
        float pv[16], cv[16], nv[16];
        if (pos0 > 0) { load_row_bf(X + (size_t)(r0 - 1) * 1024, lane, pv); const float r = rstd_of(pv);
#pragma unroll
            for (int j = 0; j < 16; ++j) pv[j] = pv[j] * r * gv[j]; }
        else {
#pragma unroll
            for (int j = 0; j < 16; ++j) pv[j] = 0.f; }
        { load_row_bf(X + (size_t)r0 * 1024, lane, cv); const float r = rstd_of(cv);
#pragma unroll
            for (int j = 0; j < 16; ++j) cv[j] = cv[j] * r * gv[j]; }
        u32x4 nq0 = *(const u32x4*)(X + (size_t)(r0 + 1) * 1024 + 8 * lane), nq1 = *(const u32x4*)(X + (size_t)(r0 + 1) * 1024 + 512 + 8 * lane);
#pragma unroll 2
        for (int i = 0; i < 8; ++i) { const int t = r0 + i; const bool hn = (pos0 + i) < T - 1;
            if (hn) { unpk8(nq0, nv); unpk8(nq1, nv + 8); const float r = rstd_of(nv);
#pragma unroll
                for (int j = 0; j < 16; ++j) nv[j] = nv[j] * r * gv[j]; }
            else {
#pragma unroll
                for (int j = 0; j < 16; ++j) nv[j] = 0.f; }
            if (i < 7 && (pos0 + i + 1) < T - 1) { nq0 = *(const u32x4*)(X + (size_t)(t + 2) * 1024 + 8 * lane); nq1 = *(const u32x4*)(X + (size_t)(t + 2) * 1024 + 512 + 8 * lane); }
            u16* o = XO + (size_t)t * 1024;
#pragma unroll
            for (int q = 0; q < 3; ++q) { float m[16];
#pragma unroll
                for (int j = 0; j < 16; ++j) m[j] = cv[j] * m1[q][j] + m2[q][j] * (pv[j] + nv[j]);
                *(u32x4*)(o + (size_t)q * HT * 1024 + 8 * lane) = pk8(m); *(u32x4*)(o + (size_t)q * HT * 1024 + 512 + 8 * lane) = pk8(m + 8); }
            *(u32x4*)(o + 3ull * HT * 1024 + 8 * lane) = pk8(cv); *(u32x4*)(o + 3ull * HT * 1024 + 512 + 8 * lane) = pk8(cv + 8);
#pragma unroll
            for (int j = 0; j < 16; ++j) { pv[j] = cv[j]; cv[j] = nv[j]; } } }
}

__device__ __forceinline__ void yconv_phase(unsigned char* ws, unsigned char* ob, LAS unsigned char* lds) {
    const int tix = opaque_tid(); const int lane = tix & 63, gw = blockIdx.x * 8 + (tix >> 6), NGW = gridDim.x * 8;
    const u16* PR = (const u16*)(ob + OUT_PROJ); u16* CAT = (u16*)(ws + OFF_CAT); const float* cw = IN(6);
    float w[3][8];
#pragma unroll
    for (int j = 0; j < 3; ++j)
#pragma unroll
        for (int e = 0; e < 8; ++e) w[j][e] = cw[j * 512 + 8 * lane + e];
    for (int t = gw; t < 65536; t += NGW) { const int T = seqT(t), pos = t & (T - 1);
        float acc[8], gb[8];
#pragma unroll
        for (int e = 0; e < 8; ++e) acc[e] = 0.f;
#pragma unroll
        for (int j = 0; j < 3; ++j) { const int pp = pos + j - 1; if (pp < 0 || pp >= T) continue;
            const u16* r = PR + (size_t)(t + j - 1) * 1536 + 8 * lane; float a[8], b[8]; unpk8(*(const u32x4*)(r + 512), a); unpk8(*(const u32x4*)(r + 1024), b);
#pragma unroll
            for (int e = 0; e < 8; ++e) acc[e] += w[j][e] * a[e] * b[e]; }
        unpk8(*(const u32x4*)(PR + (size_t)t * 1536 + 8 * lane), gb);
#pragma unroll
        for (int e = 0; e < 8; ++e) acc[e] *= gb[e];
        *(u32x4*)(CAT + (size_t)t * 1536 + 8 * lane) = pk8(acc); }
}
template <int T2>
__device__ __forceinline__ void stageA_item(const u16* FT, u16* YP, int tokbase, size_t nbase, int ch, int t1) {
    constexpr float C32[32] = {1.000000000f, 0.980785280f, 0.923879533f, 0.831469612f, 0.707106781f, 0.555570233f, 0.382683432f, 0.195090322f, 0.000000000f, -0.195090322f, -0.382683432f, -0.555570233f, -0.707106781f, -0.831469612f, -0.923879533f, -0.980785280f, -1.000000000f, -0.980785280f, -0.923879533f, -0.831469612f, -0.707106781f, -0.555570233f, -0.382683432f, -0.195090322f, -0.000000000f, 0.195090322f, 0.382683432f, 0.555570233f, 0.707106781f, 0.831469612f, 0.923879533f, 0.980785280f};
    constexpr float S32[32] = {0.000000000f, 0.195090322f, 0.382683432f, 0.555570233f, 0.707106781f, 0.831469612f, 0.923879533f, 0.980785280f, 1.000000000f, 0.980785280f, 0.923879533f, 0.831469612f, 0.707106781f, 0.555570233f, 0.382683432f, 0.195090322f, 0.000000000f, -0.195090322f, -0.382683432f, -0.555570233f, -0.707106781f, -0.831469612f, -0.923879533f, -0.980785280f, -1.000000000f, -0.980785280f, -0.923879533f, -0.831469612f, -0.707106781f, -0.555570233f, -0.382683432f, -0.195090322f};
    float xv[T2];
#pragma unroll
    for (int t2 = 0; t2 < T2; ++t2) xv[t2] = bf2f(FT[(size_t)ch * 65536 + tokbase + t1 + 256 * t2]);
    const float invs = 1.f / sqrtf((float)(256 * T2));
#pragma unroll
    for (int k2 = 0; k2 <= T2 / 2; ++k2) { float yr = 0.f, yi = 0.f;
#pragma unroll
        for (int t2 = 0; t2 < T2; ++t2) { const int j = ((k2 * t2) & (T2 - 1)) * (32 / T2); yr += xv[t2] * C32[j]; yi -= xv[t2] * S32[j]; }
#pragma unroll
        for (int mir = 0; mir < 2; ++mir) { const int kk = mir ? T2 - k2 : k2; if (mir && (k2 == 0 || k2 == T2 / 2)) continue; const float yim = mir ? -yi : yi;
            const float fr = (float)(kk * t1) * (1.f / (256.f * T2)); const float c = __builtin_amdgcn_cosf(fr), sn = __builtin_amdgcn_sinf(fr);
            u16* o = YP + (nbase + (size_t)kk * 512 + ch) * 512 + t1;
            o[0] = f2bf((yr * c + yim * sn) * invs); o[256] = f2bf((yim * c - yr * sn) * invs); } }
}
__device__ __forceinline__ void stageA_phase(unsigned char* ws, unsigned char* ob, LAS unsigned char* lds) {
    const int tid = opaque_tid();
    const u16* FT = (const u16*)(ob + OUT_FT); u16* YP = (u16*)(ws + OFF_YP);
    for (int it = blockIdx.x; it < 12 * 256; it += gridDim.x) { const int sq = it >> 8, ch = 2 * (it & 255) + (tid >> 8), t1 = tid & 255;
        if (sq < 8) stageA_item<16>(FT, YP, sq * 4096, (size_t)sq * 16 * 512, ch, t1);
        else stageA_item<32>(FT, YP, HT + (sq - 8) * 8192, 65536 + (size_t)(sq - 8) * 32 * 512, ch, t1); }
}

__device__ __forceinline__ void act_phase(unsigned char* ws, unsigned char* ob, LAS unsigned char* lds, int l, int chunk) {
    const u16* U = (const u16*)(ws + OFF_U); u16* ACT = (u16*)(ob + OUT_ACT);
    const float* cw = IN(28) + (size_t)l * 3 * 5632; const float* cb = IN(29) + (size_t)l * 5632;
    const size_t gt = (size_t)blockIdx.x * 512 + opaque_tid(), NT = (size_t)gridDim.x * 512;
    for (size_t i = gt; i < 1024ull * 352; i += NT) {
        const int rbk = (int)(i / 352), c = 8 * (int)(i % 352), row0 = rbk * 16; const int tg0 = chunk * 16384 + row0, T = seqT(tg0), pos0 = tg0 & (T - 1);
        float wg[3][8], wv[3][8], bg[8], bv[8];
#pragma unroll
        for (int j = 0; j < 3; ++j) { const f32x4 a0 = *(const f32x4*)(cw + j * 5632 + c), a1 = *(const f32x4*)(cw + j * 5632 + c + 4), b0 = *(const f32x4*)(cw + j * 5632 + 2816 + c), b1 = *(const f32x4*)(cw + j * 5632 + 2816 + c + 4);
            wg[j][0] = a0.x; wg[j][1] = a0.y; wg[j][2] = a0.z; wg[j][3] = a0.w; wg[j][4] = a1.x; wg[j][5] = a1.y; wg[j][6] = a1.z; wg[j][7] = a1.w;
            wv[j][0] = b0.x; wv[j][1] = b0.y; wv[j][2] = b0.z; wv[j][3] = b0.w; wv[j][4] = b1.x; wv[j][5] = b1.y; wv[j][6] = b1.z; wv[j][7] = b1.w; }
        { const f32x4 a0 = *(const f32x4*)(cb + c), a1 = *(const f32x4*)(cb + c + 4), b0 = *(const f32x4*)(cb + 2816 + c), b1 = *(const f32x4*)(cb + 2816 + c + 4);
            bg[0] = a0.x; bg[1] = a0.y; bg[2] = a0.z; bg[3] = a0.w; bg[4] = a1.x; bg[5] = a1.y; bg[6] = a1.z; bg[7] = a1.w;
            bv[0] = b0.x; bv[1] = b0.y; bv[2] = b0.z; bv[3] = b0.w; bv[4] = b1.x; bv[5] = b1.y; bv[6] = b1.z; bv[7] = b1.w; }
        float pg[8], pv[8], cg_[8], cv[8];
        const u16* r = U + (size_t)row0 * 5632 + c;
        u32x4 bufg[2][4], bufv[2][4];
        const bool tail_ok = pos0 + 16 < T;
#define ACT_LOAD(g_, b_) do { _Pragma("unroll") for (int k = 0; k < 4; ++k) { const int rn = 4 * (g_) + k + 1; \
            if (rn < 16 || tail_ok) { bufg[b_][k] = *(const u32x4*)(r + (size_t)rn * 5632); bufv[b_][k] = *(const u32x4*)(r + (size_t)rn * 5632 + 2816); } \
            else { bufg[b_][k] = (u32x4){0u, 0u, 0u, 0u}; bufv[b_][k] = (u32x4){0u, 0u, 0u, 0u}; } } } while (0)
        ACT_LOAD(0, 0);
        if (pos0 > 0) { unpk8(*(const u32x4*)(r - 5632), pg); unpk8(*(const u32x4*)(r - 5632 + 2816), pv); }
        else {
#pragma unroll
            for (int e = 0; e < 8; ++e) { pg[e] = 0.f; pv[e] = 0.f; } }
        unpk8(*(const u32x4*)r, cg_); unpk8(*(const u32x4*)(r + 2816), cv);
#pragma unroll
        for (int g = 0; g < 4; ++g) {
            if (g < 3) ACT_LOAD(g + 1, (g + 1) & 1);
#pragma unroll
            for (int k = 0; k < 4; ++k) { float ng[8], nv[8], o[8]; unpk8(bufg[g & 1][k], ng); unpk8(bufv[g & 1][k], nv);
#pragma unroll
                for (int e = 0; e < 8; ++e) { const float gg = bg[e] + wg[0][e] * pg[e] + wg[1][e] * cg_[e] + wg[2][e] * ng[e]; const float v = bv[e] + wv[0][e] * pv[e] + wv[1][e] * cv[e] + wv[2][e] * nv[e];
                    o[e] = gg * sigmoidf_(gg) * v; pg[e] = cg_[e]; pv[e] = cv[e]; cg_[e] = ng[e]; cv[e] = nv[e]; }
                *(u32x4*)(ACT + (size_t)(row0 + 4 * g + k) * 2816 + c) = pk8(o); } }
#undef ACT_LOAD
    }
}

__device__ __forceinline__ void lprep_phase(unsigned char* ws, unsigned char* ob, int hf) {
    const int tix = opaque_tid(); const int lane = tix & 63, gw = blockIdx.x * 8 + (tix >> 6), NGW = gridDim.x * 8;
    const u16* PB = (const u16*)(ob + OUT_P); u16* L = (u16*)(ws + OFF_L); u16* LG = (u16*)(ws + OFF_LG);
    const int T = hf ? 8192 : 4096;
    for (int t = gw; t < HT; t += NGW) { const int pos = t & (T - 1); const u16* r = PB + (size_t)t * 768; float a[8], b[8];
        if (lane < 32) { const int i = lane >> 3, r0 = (lane & 7) * 8, sh = (i & 1) ? 1 : -1; const bool ok = (i & 1) ? (pos < T - 1) : (pos > 0);
            unpk8(*(const u32x4*)(r + i * 128 + r0), a);
            if (ok) { unpk8(*(const u32x4*)(r + sh * 768 + i * 128 + 64 + r0), b);
#pragma unroll
                for (int e = 0; e < 8; ++e) a[e] += b[e]; }
            if (i < 2) {
#pragma unroll
                for (int e = 0; e < 8; ++e) a[e] = 1.f - 2.f * __builtin_amdgcn_rcpf(1.f + __expf(2.f * a[e])); }
            *(u32x4*)(L + (size_t)t * 256 + 8 * lane) = pk8(a); }
        else if (lane < 48) { const int r0 = (lane - 32) * 8; unpk8(*(const u32x4*)(r + 512 + r0), a);
            if (pos > 0) { unpk8(*(const u32x4*)(r - 768 + 640 + r0), b);
#pragma unroll
                for (int e = 0; e < 8; ++e) a[e] += b[e]; }
            if (pos < T - 1) { unpk8(*(const u32x4*)(r + 768 + 640 + r0), b);
#pragma unroll
                for (int e = 0; e < 8; ++e) a[e] += b[e]; }
#pragma unroll
            for (int e = 0; e < 8; ++e) a[e] = sigmoidf_(a[e]);
            *(u32x4*)(LG + (size_t)t * 256 + r0) = pk8(a); }
        else { unsigned zz = 0u; asm volatile("" : "+v"(zz)); *(u32x4*)(LG + (size_t)t * 256 + 128 + (lane - 48) * 8) = (u32x4){zz, zz, zz, zz}; } }
}
__device__ __forceinline__ void rwprep_phase(unsigned char* ws, unsigned char* ob, LAS unsigned char* lds) {
    const int tix = opaque_tid(); const int lane = tix & 63, gw = blockIdx.x * 8 + (tix >> 6), NGW = gridDim.x * 8;
    const u16* R = (const u16*)(ob + OUT_RKV); const u16* Kp = R + (size_t)HT * 1024;
    const u16* A0 = (const u16*)(ws + OFF_D4) + 2ull * HT * 1024; const u16* A1 = A0 + (size_t)HT * 1024;
    float* INV = (float*)(ws + OFF_INV); float* BON = (float*)(ws + OFF_BON);
    const float* kkp = IN(22) + 16 * lane; const float* kap = IN(23) + 16 * lane; const float* rkp = IN(24) + 16 * lane;
    float kk[16], ka[16], rk[16];
#pragma unroll
    for (int e = 0; e < 16; ++e) { kk[e] = kkp[e]; ka[e] = kap[e]; rk[e] = rkp[e]; }
    for (int t0 = gw; t0 < HT; t0 += 2 * NGW) {
        u32x4 q[2][8];
#pragma unroll
        for (int u2 = 0; u2 < 2; ++u2) { const int t = t0 + u2 * NGW; if (t < HT) { const size_t o = (size_t)t * 1024 + 16 * lane;
            q[u2][0] = *(const u32x4*)(Kp + o); q[u2][1] = *(const u32x4*)(Kp + o + 8); q[u2][2] = *(const u32x4*)(R + o); q[u2][3] = *(const u32x4*)(R + o + 8);
            q[u2][4] = *(const u32x4*)(A0 + o); q[u2][5] = *(const u32x4*)(A0 + o + 8); q[u2][6] = *(const u32x4*)(A1 + o); q[u2][7] = *(const u32x4*)(A1 + o + 8); } }
#pragma unroll
        for (int u2 = 0; u2 < 2; ++u2) { const int t = t0 + u2 * NGW; if (t < HT) { float k[16], r[16], a0[16], a1[16];
            unpk8(q[u2][0], k); unpk8(q[u2][1], k + 8); unpk8(q[u2][2], r); unpk8(q[u2][3], r + 8); unpk8(q[u2][4], a0); unpk8(q[u2][5], a0 + 8); unpk8(q[u2][6], a1); unpk8(q[u2][7], a1 + 8);
            float ss = 0.f, bn = 0.f;
#pragma unroll
            for (int e = 0; e < 16; ++e) { const float qq = k[e] * kk[e]; ss += qq * qq; bn += r[e] * k[e] * rk[e] * (2.f + (a0[e] + a1[e] - 2.f) * ka[e]); }
            ss = allreduce4(ss); bn = allreduce4(bn);
            if ((lane & 3) == 0) { INV[(size_t)t * 16 + (lane >> 2)] = 1.f / fmaxf(sqrtf(ss), 1e-12f); BON[(size_t)t * 16 + (lane >> 2)] = bn; } } } }
}
__device__ __forceinline__ void gn_phase(unsigned char* ws, unsigned char* ob, LAS unsigned char* lds) {
    const int tix = opaque_tid(); const int lane = tix & 63, gw = blockIdx.x * 8 + (tix >> 6), NGW = gridDim.x * 8;
    const u16* Y = (const u16*)(ob + OUT_Y); const u16* V = (const u16*)(ob + OUT_RKV) + 2ull * HT * 1024;
    const u16* G = (const u16*)(ws + OFF_G); u16* YG = (u16*)(ws + OFF_YG); const float* BON = (const float*)(ws + OFF_BON); const u16* YB = (const u16*)(ws + OFF_D4) + 3ull * HT * 1024;
    float gw_[16], gb_[16];
#pragma unroll
    for (int e = 0; e < 16; ++e) { gw_[e] = IN(25)[16 * lane + e]; gb_[e] = IN(26)[16 * lane + e]; }
    for (int t0 = gw; t0 < HT; t0 += 2 * NGW) {
        u32x4 q[2][8]; float bnv[2] = {0.f, 0.f};
#pragma unroll
        for (int u2 = 0; u2 < 2; ++u2) { const int t = t0 + u2 * NGW; if (t < HT) { const size_t o = (size_t)t * 1024 + 16 * lane;
            q[u2][0] = *(const u32x4*)(Y + o); q[u2][1] = *(const u32x4*)(Y + o + 8); q[u2][2] = *(const u32x4*)(YB + o); q[u2][3] = *(const u32x4*)(YB + o + 8);
            q[u2][4] = *(const u32x4*)(V + o); q[u2][5] = *(const u32x4*)(V + o + 8); q[u2][6] = *(const u32x4*)(G + o); q[u2][7] = *(const u32x4*)(G + o + 8); bnv[u2] = BON[(size_t)t * 16 + (lane >> 2)]; } }
#pragma unroll
        for (int u2 = 0; u2 < 2; ++u2) { const int t = t0 + u2 * NGW; if (t < HT) { const size_t o = (size_t)t * 1024 + 16 * lane; float y[16], yb[16], v[16], g[16];
            unpk8(q[u2][0], y); unpk8(q[u2][1], y + 8); unpk8(q[u2][2], yb); unpk8(q[u2][3], yb + 8); unpk8(q[u2][4], v); unpk8(q[u2][5], v + 8); unpk8(q[u2][6], g); unpk8(q[u2][7], g + 8);
            float s = 0.f;
#pragma unroll
            for (int e = 0; e < 16; ++e) { y[e] += yb[e]; s += y[e]; }
            const float mean = allreduce4(s) * (1.f / 64.f); float qv = 0.f;
#pragma unroll
            for (int e = 0; e < 16; ++e) { y[e] -= mean; qv += y[e] * y[e]; }
            const float rstd = 1.f / sqrtf(allreduce4(qv) * (1.f / 64.f) + 64e-5f); const float bn = bnv[u2];
#pragma unroll
            for (int e = 0; e < 16; ++e) y[e] = (y[e] * rstd * gw_[e] + gb_[e] + bn * v[e]) * g[e];
            *(u32x4*)(YG + o) = pk8(y); *(u32x4*)(YG + o + 8) = pk8(y + 8); } } }
}

typedef float f32x16 __attribute__((ext_vector_type(16)));
#define MFMA32(a, b, c) __builtin_amdgcn_mfma_f32_32x32x16_bf16((a), (b), (c), 0, 0, 0)
__device__ __forceinline__ unsigned pkc(float lo, float hi) { typedef __bf16 bf2 __attribute__((ext_vector_type(2))); typedef float f2 __attribute__((ext_vector_type(2))); const f2 v = {lo, hi}; const bf2 b = __builtin_convertvector(v, bf2); return __builtin_bit_cast(unsigned, b); }
__device__ __forceinline__ u16 bfc(float v) { return (u16)(pkc(v, 0.f) & 0xffffu); }
__device__ __forceinline__ bf16x8 pack_lo(const f32x16& x) { u32x4 p; p.x = pkc(x[0], x[1]); p.y = pkc(x[2], x[3]); p.z = pkc(x[4], x[5]); p.w = pkc(x[6], x[7]); return __builtin_bit_cast(bf16x8, p); }
__device__ __forceinline__ bf16x8 pack_hi(const f32x16& x) { u32x4 p; p.x = pkc(x[8], x[9]); p.y = pkc(x[10], x[11]); p.z = pkc(x[12], x[13]); p.w = pkc(x[14], x[15]); return __builtin_bit_cast(bf16x8, p); }
constexpr int SL_QS = 1056;
constexpr int SL_AR = 0, SL_BK = 4 * SL_QS, SL_BT = 8 * SL_QS, SL_KT = SL_BT + 2048, SL_VT = SL_KT + 2048, SL_MK = SL_VT + 2048, SL_T2 = SL_MK + 1024, SL_WL = SL_T2 + 1024, SL_SIZE = SL_WL + 256;
static_assert(SL_VT >= 10240 && 8 * SL_SIZE <= LDS_TAB, "scan slot layout");
__device__ __forceinline__ void scan_phase(unsigned char* ws, unsigned char* ob, LAS unsigned char* lds, int hf) {
    const int T = hf ? 8192 : 4096, nunits = (hf ? 4 : 8) * 16 * 2, nblk = T / 16, nbatch = nblk / 8;
    const int tid = opaque_tid(), lane = tid & 63, wave = __builtin_amdgcn_readfirstlane(tid >> 6), r = lane & 31, h = lane >> 5;
    const u16* R = (const u16*)(ob + OUT_RKV); const u16* Kp = R + (size_t)HT * 1024; const u16* V = Kp + (size_t)HT * 1024;
    const u16* D4 = (const u16*)(ws + OFF_D4); const float* INV = (const float*)(ws + OFF_INV);
    const int ci = wave;
    const int jb = lane >> 5, jl = lane & 31, js = jl >> 4, jh = (jl >> 2) & 1, je = ((jl >> 3) & 1) * 4 + (jl & 3);
    const unsigned posj = (unsigned)((jb * 2 + js) * SL_QS + jh * 16 + je * 2);
    LAS unsigned char* sb = lds + wave * SL_SIZE;
#define SC_BAR() do { asm volatile("s_waitcnt lgkmcnt(0)" ::: "memory"); __builtin_amdgcn_s_barrier(); asm volatile("" ::: "memory"); } while (0)
    const int nroles = (hf && gridDim.x >= 256) ? 2 : 1;
    const int bx = blockIdx.x, role = nroles == 2 ? ((bx >> 3) & 1) : 0, u0 = nroles == 2 ? (((bx >> 4) << 3) | (bx & 7)) : bx;
    unsigned* hflag = (unsigned*)(ws + OFF_BAR + 16384); float* hslot = (float*)(ws + OFF_HSLOT);
    for (int u = u0; u < nunits; u += (nroles == 2 ? 1 << 30 : (int)gridDim.x)) {
        if (nroles == 2 && bx >= 256) break;
        const int z = u & 1, hd = (u >> 1) & 15, b = u >> 5; const size_t seqbase = (size_t)b * T;
        u16* Y = z ? (u16*)(ws + OFF_D4) + 3ull * HT * 1024 : (u16*)(ob + OUT_Y);
        const float kkc = IN(22)[hd * 64 + lane], kac = IN(23)[hd * 64 + lane];
        f32x16 X0, X1;
#pragma unroll
        for (int g = 0; g < 16; ++g) { X0[g] = 0.f; X1[g] = 0.f; }
        const unsigned lanepart = (unsigned)((hd * 64 + 8 * (lane & 7)) * 2); const u16* Dz = D4 + (size_t)z * HT * 1024; const u16* Az = D4 + (size_t)(2 + z) * HT * 1024;
        u32x4 graw[5][2]; float inv = 0.f;
#define SC_LOAD(bt_) do { int nb_ = (bt_); asm volatile("" : "+s"(nb_)); const int n_ = nb_ * 8 + ci;     \
            _Pragma("unroll") for (int i2 = 0; i2 < 2; ++i2) { const int t_ = (lane >> 3) + 8 * i2; const int tl_ = z ? (T - 1 - (16 * n_ + t_)) : (16 * n_ + t_); \
                const unsigned off_ = (unsigned)(((int)seqbase + tl_) * 2048) + lanepart;            \
                graw[0][i2] = *(const u32x4*)((const char*)R + off_); graw[1][i2] = *(const u32x4*)((const char*)Kp + off_); graw[2][i2] = *(const u32x4*)((const char*)V + off_); \
                graw[3][i2] = *(const u32x4*)((const char*)Dz + off_); graw[4][i2] = *(const u32x4*)((const char*)Az + off_); } \
            { const int t_ = lane & 15; const int tl_ = z ? (T - 1 - (16 * n_ + t_)) : (16 * n_ + t_); inv = *(const float*)((const char*)INV + (unsigned)((((int)seqbase + tl_) * 16 + hd) * 4)); } } while (0)
        SC_LOAD(role);
        __syncthreads();
        for (int bt = role; bt < nbatch; bt += nroles) {
            {
#pragma unroll
                for (int a5 = 0; a5 < 5; ++a5) { *(LAS u32x4*)(sb + a5 * 2048 + lane * 16) = graw[a5][0]; *(LAS u32x4*)(sb + a5 * 2048 + 1024 + lane * 16) = graw[a5][1]; }
                asm volatile("s_waitcnt lgkmcnt(0)" ::: "memory");
                unsigned rr[16], kr[16], lr[16], ar[16], vr[16];
#pragma unroll
                for (int t = 0; t < 16; ++t) { rr[t] = *(const LAS u16*)(sb + 0 * 2048 + t * 128 + 2 * lane); kr[t] = *(const LAS u16*)(sb + 1 * 2048 + t * 128 + 2 * lane); vr[t] = *(const LAS u16*)(sb + 2 * 2048 + t * 128 + 2 * lane);
                    lr[t] = *(const LAS u16*)(sb + 3 * 2048 + t * 128 + 2 * lane); ar[t] = *(const LAS u16*)(sb + 4 * 2048 + t * 128 + 2 * lane); }
                asm volatile("s_waitcnt lgkmcnt(0)" ::: "memory");
#define PK16(a_, t0_) ((a_)[t0_] | ((a_)[(t0_) + 1] << 16))
                *(LAS u32x4*)(sb + SL_VT + lane * 32) = (u32x4){PK16(vr, 0), PK16(vr, 2), PK16(vr, 8), PK16(vr, 10)}; *(LAS u32x4*)(sb + SL_VT + lane * 32 + 16) = (u32x4){PK16(vr, 4), PK16(vr, 6), PK16(vr, 12), PK16(vr, 14)};
                float L = 0.f, Eprev = 1.f; unsigned b16[8], k16[8];
#pragma unroll
                for (int t = 0; t < 16; ++t) { const float invt = __int_as_float(__builtin_amdgcn_readlane(__float_as_int(inv), t));
                    const float kf = __uint_as_float(kr[t] << 16), rf = __uint_as_float(rr[t] << 16), lw = __uint_as_float(lr[t] << 16), af = __uint_as_float(ar[t] << 16);
                    const float kk_ = kf * kkc * invt; L += lw; const float E = __builtin_amdgcn_exp2f(L), Einv = __builtin_amdgcn_rcpf(E);
                    const u16 At = bfc(-kk_ * Eprev), Rt = bfc(rf * E), Bt = bfc(kk_ * af * Einv), Kt = bfc(kf * (1.f + (af - 1.f) * kac) * Einv); Eprev = E;
                    constexpr int dummy = 0; (void)dummy;
                    const int ht = (t >> 2) & 1, et = ((t >> 3) & 1) * 4 + (t & 3);
                    *(LAS u16*)(sb + SL_AR + posj + 32 * t) = At; *(LAS u16*)(sb + SL_AR + posj + 32 * (16 + t)) = Rt;
                    *(LAS u16*)(sb + SL_BK + posj + 32 * t) = Bt; *(LAS u16*)(sb + SL_BK + posj + 32 * (16 + t)) = Kt;
                    if (t & 1) { b16[t >> 1] |= (unsigned)Bt << 16; k16[t >> 1] |= (unsigned)Kt << 16; } else { b16[t >> 1] = Bt; k16[t >> 1] = Kt; } (void)ht; (void)et; }
                *(LAS u32x4*)(sb + SL_BT + lane * 32) = (u32x4){b16[0], b16[1], b16[4], b16[5]}; *(LAS u32x4*)(sb + SL_BT + lane * 32 + 16) = (u32x4){b16[2], b16[3], b16[6], b16[7]};
                *(LAS u32x4*)(sb + SL_KT + lane * 32) = (u32x4){k16[0], k16[1], k16[4], k16[5]}; *(LAS u32x4*)(sb + SL_KT + lane * 32 + 16) = (u32x4){k16[2], k16[3], k16[6], k16[7]};
#undef PK16
                *(LAS float*)(sb + SL_WL + 4 * lane) = Eprev; }
            if (bt + nroles < nbatch) SC_LOAD(bt + nroles);
            asm volatile("s_waitcnt lgkmcnt(0)" ::: "memory");
            {   f32x16 M;
#pragma unroll
                for (int g = 0; g < 16; ++g) M[g] = 0.f;
#pragma unroll
                for (int q = 0; q < 4; ++q) { const bf16x8 a = *(const LAS bf16x8*)(sb + SL_AR + q * SL_QS + r * 32 + h * 16), bq = *(const LAS bf16x8*)(sb + SL_BK + q * SL_QS + r * 32 + h * 16); M = MFMA32(a, bq, M); }
                LAS float* Mf = (LAS float*)(sb + SL_BK);
                int rl = r, hl = h; asm volatile("" : "+v"(rl), "+v"(hl));
#pragma unroll
                for (int g = 0; g < 16; ++g) { const int tp = (g & 3) + 8 * (g >> 2) + 4 * hl, tt = tp & 15, ss = rl & 15; const bool keep = (tp < 16) ? (ss < tt) : (ss <= tt); Mf[tp * 32 + rl] = keep ? M[g] : 0.f; }
                asm volatile("s_waitcnt lgkmcnt(0)" ::: "memory");
                const int c = lane & 15, hc = (c >> 2) & 1, ec = ((c >> 3) & 1) * 4 + (c & 3); float x[16];
#pragma unroll
                for (int gq = 0; gq < 4; ++gq) { f32x4 mr[4][4];
#pragma unroll
                    for (int i = 0; i < 4; ++i)
#pragma unroll
                        for (int q4 = 0; q4 <= gq; ++q4) mr[i][q4] = *(const LAS f32x4*)(Mf + (4 * gq + i) * 32 + 4 * q4);
#pragma unroll
                    for (int i = 0; i < 4; ++i) { const int t = 4 * gq + i; float acc = (t == c) ? 1.f : 0.f;
#pragma unroll
                        for (int q4 = 0; q4 <= gq; ++q4)
#pragma unroll
                            for (int e = 0; e < 4; ++e) if (4 * q4 + e < t) acc += mr[i][q4][e] * x[4 * q4 + e];
                        x[t] = acc; if (lane < 16) *(LAS u16*)(sb + SL_T2 + (t * 2 + hc) * 16 + 2 * ec) = bfc(acc); } }
#pragma unroll
                for (int gq = 0; gq < 4; ++gq) { f32x4 mr[4][4];
#pragma unroll
                    for (int i = 0; i < 4; ++i)
#pragma unroll
                        for (int q4 = 0; q4 <= gq; ++q4) mr[i][q4] = *(const LAS f32x4*)(Mf + (16 + 4 * gq + i) * 32 + 4 * q4);
#pragma unroll
                    for (int i = 0; i < 4; ++i) { const int t = 4 * gq + i; float acc = 0.f;
#pragma unroll
                        for (int q4 = 0; q4 <= gq; ++q4)
#pragma unroll
                            for (int e = 0; e < 4; ++e) if (4 * q4 + e <= t) acc += mr[i][q4][e] * x[4 * q4 + e];
                        if (lane < 16) *(LAS u16*)(sb + SL_T2 + ((16 + t) * 2 + hc) * 16 + 2 * ec) = bfc(acc); } }
                {   const f32x4 m0 = *(const LAS f32x4*)(Mf + r * 32 + 16 + 4 * h), m1 = *(const LAS f32x4*)(Mf + r * 32 + 24 + 4 * h);
                    u32x4 w; w.x = pkc(m0.x, m0.y); w.y = pkc(m0.z, m0.w); w.z = pkc(m1.x, m1.y); w.w = pkc(m1.z, m1.w);
                    *(LAS u32x4*)(sb + SL_MK + (r * 2 + h) * 16) = w; }
            }
            SC_BAR();
            if (wave < 2) { const int ib = wave;
                if (nroles == 2 && bt > 0) {
                    unsigned* fl = hflag + (u * 2 + ib) * 16;
                    while (__hip_atomic_load(fl, __ATOMIC_RELAXED, __HIP_MEMORY_SCOPE_AGENT) < (unsigned)bt) __builtin_amdgcn_s_sleep(1);
                    const unsigned* sl = (const unsigned*)(hslot + (size_t)((u * 2 + ib) * 2 + (role ^ 1)) * 2048);
#pragma unroll
                    for (int g = 0; g < 16; ++g) { X0[g] = __uint_as_float(__hip_atomic_load(sl + g * 64 + lane, __ATOMIC_RELAXED, __HIP_MEMORY_SCOPE_AGENT)); X1[g] = __uint_as_float(__hip_atomic_load(sl + 1024 + g * 64 + lane, __ATOMIC_RELAXED, __HIP_MEMORY_SCOPE_AGENT)); } }
                for (int c2 = 0; c2 < 8; ++c2) { LAS unsigned char* s2 = lds + c2 * SL_SIZE;
                    const bf16x8 vfrag = *(const LAS bf16x8*)(s2 + SL_VT + (ib * 32 + r) * 32 + h * 16), mk = *(const LAS bf16x8*)(s2 + SL_MK + (r * 2 + h) * 16);
                    f32x16 out;
#pragma unroll
                    for (int g = 0; g < 16; ++g) out[g] = 0.f;
                    out = MFMA32(mk, vfrag, out);
                    out = MFMA32(*(const LAS bf16x8*)(s2 + SL_AR + 0 * SL_QS + r * 32 + h * 16), pack_lo(X0), out);
                    out = MFMA32(*(const LAS bf16x8*)(s2 + SL_AR + 1 * SL_QS + r * 32 + h * 16), pack_hi(X0), out);
                    out = MFMA32(*(const LAS bf16x8*)(s2 + SL_AR + 2 * SL_QS + r * 32 + h * 16), pack_lo(X1), out);
                    out = MFMA32(*(const LAS bf16x8*)(s2 + SL_AR + 3 * SL_QS + r * 32 + h * 16), pack_hi(X1), out);
                    f32x16 sat;
#pragma unroll
                    for (int g = 0; g < 16; ++g) sat[g] = 0.f;
                    sat = MFMA32(*(const LAS bf16x8*)(s2 + SL_T2 + (r * 2 + h) * 16), pack_lo(out), sat);
                    LAS float* yb = (LAS float*)(s2 + SL_BK);
#pragma unroll
                    for (int e = 0; e < 8; ++e) { const int tm = 8 * (e >> 2) + 4 * h + (e & 3); yb[tm * 64 + ib * 32 + r] = out[8 + e] + sat[8 + e]; }
                    const bf16x8 sfrag = pack_lo(sat);
                    X0 = MFMA32(*(const LAS bf16x8*)(s2 + SL_KT + r * 32 + h * 16), vfrag, X0);
                    X1 = MFMA32(*(const LAS bf16x8*)(s2 + SL_KT + (32 + r) * 32 + h * 16), vfrag, X1);
                    X0 = MFMA32(*(const LAS bf16x8*)(s2 + SL_BT + r * 32 + h * 16), sfrag, X0);
                    X1 = MFMA32(*(const LAS bf16x8*)(s2 + SL_BT + (32 + r) * 32 + h * 16), sfrag, X1);
#pragma unroll
                    for (int q4 = 0; q4 < 4; ++q4) { const f32x4 w0 = *(const LAS f32x4*)(s2 + SL_WL + (8 * q4 + 4 * h) * 4), w1 = *(const LAS f32x4*)(s2 + SL_WL + (32 + 8 * q4 + 4 * h) * 4);
#pragma unroll
                        for (int e = 0; e < 4; ++e) { X0[4 * q4 + e] *= w0[e]; X1[4 * q4 + e] *= w1[e]; } } }
                if (nroles == 2 && bt + 1 < nbatch) {
                    unsigned* sl = (unsigned*)(hslot + (size_t)((u * 2 + ib) * 2 + role) * 2048);
#pragma unroll
                    for (int g = 0; g < 16; ++g) { __hip_atomic_store(sl + g * 64 + lane, __float_as_uint(X0[g]), __ATOMIC_RELAXED, __HIP_MEMORY_SCOPE_AGENT); __hip_atomic_store(sl + 1024 + g * 64 + lane, __float_as_uint(X1[g]), __ATOMIC_RELAXED, __HIP_MEMORY_SCOPE_AGENT); }
                    asm volatile("s_waitcnt vmcnt(0)" ::: "memory");
                    if (lane == 0) __hip_atomic_store(hflag + (u * 2 + ib) * 16, (unsigned)(bt + 1), __ATOMIC_RELAXED, __HIP_MEMORY_SCOPE_AGENT); } }
            SC_BAR();
            int tf = tid; asm volatile("" : "+v"(tf));
#pragma unroll
            for (int k8 = 0; k8 < 8; ++k8) { const int idx = tf + 512 * k8, slot = idx >> 9, tm = (idx >> 5) & 15, cp = idx & 31; const int n = bt * 8 + slot;
                const int tl = z ? (T - 1 - (16 * n + tm)) : (16 * n + tm); unsigned* addr = (unsigned*)((char*)Y + (unsigned)((((int)seqbase + tl) * 1024 + hd * 64 + 2 * cp) * 2));
                const LAS float* yb = (const LAS float*)(lds + slot * SL_SIZE + SL_BK); *addr = pk2(yb[tm * 64 + 2 * cp], yb[tm * 64 + 2 * cp + 1]); }
            SC_BAR();
        }
#undef SC_LOAD
#undef SC_BAR
    }
}

enum { PH_PREP = 0, PH_L0_NORM, PH_L0_GEMM_IN, PH_L0_CONV_FFTA, PH_L0_GEMM_DFT, PH_L0_GEMM_OUT, PH_F0_NORM, PH_F0 = 7  , PH_L1 = 19  , PH_F1_NORM = 37, PH_F1 = 38  , PH_FINAL = 50, PH_COUNT = 51 };

__device__ __forceinline__ void ffn_phase(unsigned char* ws, unsigned char* ob, LAS unsigned char* lds, int l, int sub) {
    const int chunk = sub / 3, op = sub % 3;
    if (op == 0) { EpiPlain E{(u16*)(ws + OFF_U), 5632}; gemm_phase(lds, (const u16*)(ws + OFF_H) + (size_t)chunk * 16384 * 1024, 1024, (const u16*)(ws + OFF_WUP) + (size_t)l * 5632 * 1024, 1024, 64, 22, 1024, E); }
    else if (op == 1) act_phase(ws, ob, lds, l, chunk);
    else { EpiResid E{(u16*)(ws + OFF_X) + (size_t)chunk * 16384 * 1024}; gemm_phase(lds, (const u16*)(ob + OUT_ACT), 2816, (const u16*)(ws + OFF_WDN) + (size_t)l * 1024 * 2816, 2816, 64, 4, 2816, E); }
}

__global__ void __launch_bounds__(512, 2) mk_fwd(P p) {
    extern __shared__ __attribute__((aligned(16))) unsigned char smem[];
    LAS unsigned char* lds = (LAS unsigned char*)smem;
    if (threadIdx.x < 31) ((LAS unsigned long long*)(lds + LDS_TAB))[threadIdx.x] = (unsigned long long)p.in[threadIdx.x];
    if (threadIdx.x == 0) { volatile LAS unsigned* xst = (volatile LAS unsigned*)(lds + LDS_TAB + 256); xst[0] = 0u; xst[1] = 0u; xst[2] = 0u;
        (void)xb_add(&((unsigned*)(p.ws + OFF_BAR))[XB_XCNT(xb_xcc_id())], 1u); }
    __syncthreads();
    for (int ph = p.ph_lo; ph < p.ph_hi; ++ph) {
        size_t oz = 0; asm volatile("" : "+s"(oz));
        unsigned char* ws = p.ws + oz; unsigned char* ob = (unsigned char*)p.out + oz;
        if (TM(0) && ph == PH_PREP) { prep_phase(ws, ob, lds); __syncthreads(); norm0_phase(ws, ob, lds); }
        else if (ph == PH_L0_NORM) continue;
        else if (TM(2) && ph == PH_L0_GEMM_IN) {
            { EpiPlain E{(u16*)(ob + OUT_PROJ), 1536}; gemm_phase(lds, (const u16*)(ws + OFF_H), 1024, (const u16*)(ws + OFF_WC), 1024, 256, 6, 1024, E); }
            __syncthreads();
            { EpiPlain E{(u16*)(ob + OUT_FT), 65536}; gemm_phase(lds, (const u16*)(ws + OFF_WF), 1024, (const u16*)(ws + OFF_H), 1024, 2, 256, 1024, E); }
        }
        else if (TM(3) && ph == PH_L0_CONV_FFTA) { yconv_phase(ws, ob, lds); __syncthreads(); stageA_phase(ws, ob, lds); }
        else if (TM(4) && ph == PH_L0_GEMM_DFT) { EpiDft E{(u16*)(ws + OFF_CAT)}; gemm_phase(lds, (const u16*)(ws + OFF_DFTA), 512, (const u16*)(ws + OFF_YP), 512, 2, 512, 512, E); }
        else if (TM(5) && ph == PH_L0_GEMM_OUT) { EpiOut0 E{IN(0), IN(1), (u16*)(ws + OFF_X)}; gemm_phase(lds, (const u16*)(ws + OFF_CAT), 1536, (const u16*)(ws + OFF_WEFF), 1536, 256, 4, 1536, E); }
        else if (TM(6) && ph == PH_F0_NORM) normx_phase(ws, ob, IN(3), 0);
        else if (TM(7) && ph >= PH_F0 && ph < PH_F0 + 12) ffn_phase(ws, ob, lds, 0, ph - PH_F0);
        else if (TM(8) && ph >= PH_L1 && ph < PH_L1 + 18) { const int hf = (ph - PH_L1) / 9, op = (ph - PH_L1) % 9;
            if (TM(10) && op == 0) norm1_phase(ws, ob, lds, hf);
            else if (TM(11) && op == 1) {
                { EpiRkvP E{(u16*)(ob + OUT_RKV), (size_t)HT * 1024, (u16*)(ob + OUT_P)};
                    gemm_phase(lds, (const u16*)(ws + OFF_HH), 1024, (const u16*)(ws + OFF_WRKV), 1024, 128, 15, 1024, E, 2, (size_t)HT * 1024 * 2); }
            }
            else if (TM(12) && op == 2) lprep_phase(ws, ob, hf);
            else if (TM(13) && op == 3) { EpiUp2 E{(u16*)(ws + OFF_D4), IN(14), IN(17)}; gemm_phase(lds, (const u16*)(ws + OFF_L), 256, (const u16*)(ws + OFF_WUP2), 256, 128, 16, 256, E); }
            else if (TM(14) && op == 4) rwprep_phase(ws, ob, lds);
            else if (TM(15) && op == 5) scan_phase(ws, ob, lds, hf);
            else if (TM(16) && op == 6) { EpiPlain E{(u16*)(ws + OFF_G), 1024}; gemm_phase(lds, (const u16*)(ws + OFF_LG), 256, (const u16*)(ws + OFF_WG2), 256, 128, 4, 256, E); }
            else if (TM(17) && op == 7) gn_phase(ws, ob, lds);
            else if (TM(18)) { EpiResid E{(u16*)(ws + OFF_X) + (size_t)hf * HT * 1024}; gemm_phase(lds, (const u16*)(ws + OFF_YG), 1024, (const u16*)(ws + OFF_WO), 1024, 128, 4, 1024, E); }
        }
        else if (TM(6) && ph == PH_F1_NORM) normx_phase(ws, ob, IN(3) + 1024, 0);
        else if (TM(7) && ph >= PH_F1 && ph < PH_F1 + 12) ffn_phase(ws, ob, lds, 1, ph - PH_F1);
        else if (TM(9) && ph == PH_FINAL) normx_phase(ws, ob, IN(4), 1);
        if (ph + 1 < p.ph_hi) {
            if (p.ph_hi < 0) cg::this_grid().sync();
            grid_bar((unsigned*)(p.ws + OFF_BAR), (volatile LAS unsigned*)(lds + LDS_TAB + 256));
        }
    }
}

extern "C" void kernel_launch(void* const* d_in, const int* in_sizes, int n_in, void* d_out, int out_size, void* d_ws, size_t ws_size, hipStream_t stream) {
    static int grid = 0;
    if (grid == 0) {
        if (n_in != 31 || ws_size < WS_NEED || out_size != 65536 * 1024) { fprintf(stderr, "kernel_launch: unexpected shapes (n_in %d, ws %zu, out %d)\n", n_in, ws_size, out_size); grid = -1; return; }
        int dev = 0, cus = 0, per_cu = 0;
        hipGetDevice(&dev); hipDeviceGetAttribute(&cus, hipDeviceAttributeMultiprocessorCount, dev);
        if (hipFuncSetAttribute((const void*)mk_fwd, hipFuncAttributeMaxDynamicSharedMemorySize, LDS_BYTES) != hipSuccess) { fprintf(stderr, "kernel_launch: hipFuncSetAttribute failed\n"); grid = -1; return; }
        if (hipOccupancyMaxActiveBlocksPerMultiprocessor(&per_cu, (const void*)mk_fwd, 512, LDS_BYTES) != hipSuccess || per_cu < 1) { fprintf(stderr, "kernel_launch: occupancy query says %d\n", per_cu); per_cu = 1; }
        (void)hipGetLastError();
        grid = cus * per_cu;
    }
    if (grid < 0) return;
    if (hipMemsetAsync((unsigned char*)d_ws + OFF_BAR, 0, 16384 + 128 * 2 * 64, stream) != hipSuccess) { fprintf(stderr, "kernel_launch: memset failed\n"); return; }
    P p{};
    for (int i = 0; i < 31; ++i) p.in[i] = (const float*)d_in[i];
    p.out = (float*)d_out; p.ws = (unsigned char*)d_ws;
#if MK_PER_PHASE
    for (int ph = 0; ph < PH_COUNT; ++ph) { p.ph_lo = ph; p.ph_hi = ph + 1; hipLaunchKernelGGL(mk_fwd, dim3(grid), dim3(512), LDS_BYTES, stream, p); }
#else
    p.ph_lo = 0; p.ph_hi = PH_COUNT;
    void* args[] = {&p};
    hipError_t e = hipLaunchCooperativeKernel((const void*)mk_fwd, dim3(grid), dim3(512), args, LDS_BYTES, stream);
    if (e != hipSuccess) fprintf(stderr, "kernel_launch: cooperative launch failed: %s (grid %d)\n", hipGetErrorString(e), grid);
#endif
}
```

```cpp
#include <hip/hip_runtime.h>
#include <hip/hip_cooperative_groups.h>
#include <cstdio>
namespace cg = cooperative_groups;

#ifndef PROBE_DUP
#define PROBE_DUP 0
#define PROBE_LO 0
#define PROBE_HI 0
#endif
#ifndef MK_PER_PHASE
#define MK_PER_PHASE 0
#endif

#ifndef TESTMASK
#define TESTMASK 0xFFFFFFF
#endif
#define TM(k) ((TESTMASK >> (k)) & 1)
#define LAS __attribute__((address_space(3)))
typedef unsigned short u16;
typedef short bf16x8 __attribute__((ext_vector_type(8)));
typedef float f32x4 __attribute__((ext_vector_type(4)));
typedef unsigned u32x4 __attribute__((ext_vector_type(4)));
typedef unsigned u32x2 __attribute__((ext_vector_type(2)));

__device__ __forceinline__ int opaque_tid() { int t = threadIdx.x; asm volatile("" : "+v"(t)); return t; }
constexpr int LDS_BYTES = 160 * 1024;
constexpr int LDS_TAB = LDS_BYTES - 512;
__device__ __forceinline__ const float* in_ptr(LAS unsigned char* lds, int i) {
    const LAS unsigned* t = (const LAS unsigned*)(lds + LDS_TAB) + 2 * i; const unsigned lo = __builtin_amdgcn_readfirstlane(t[0]), hi = __builtin_amdgcn_readfirstlane(t[1]);
    return (const float*)(((unsigned long long)hi << 32) | lo); }
__device__ __forceinline__ const float* in_ptr_g(LAS unsigned char* lds, int i, const unsigned char* gbase) {
    const unsigned long long a = (unsigned long long)in_ptr(lds, i); return (const float*)(gbase + (long long)(a - (unsigned long long)gbase)); }
#define IN(i) in_ptr(lds, (i))
#define IN_G(i) in_ptr_g(lds, (i), ws)
constexpr size_t MiB = 1ull << 20;
constexpr int HT = 32768;
constexpr size_t OFF_WC = 0;
constexpr size_t OFF_WF = OFF_WC + 1536ull * 1024 * 2;
constexpr size_t OFF_WEFF = OFF_WF + 512ull * 1024 * 2;
constexpr size_t OFF_DFTA = OFF_WEFF + 1024ull * 1536 * 2;
constexpr size_t OFF_WUP = OFF_DFTA + 512ull * 512 * 2;
constexpr size_t OFF_WDN = OFF_WUP + 2ull * 5632 * 1024 * 2;
constexpr size_t OFF_WRKV = OFF_WDN + 2ull * 1024 * 2816 * 2;
constexpr size_t OFF_WLORA = OFF_WRKV + 3072ull * 1024 * 2;
constexpr size_t OFF_WRKV_END = OFF_WRKV + 3072ull * 2048 * 2;
constexpr size_t OFF_WUP2 = OFF_WRKV_END + 768ull * 1024 * 2;
constexpr size_t OFF_WG2 = OFF_WUP2 + 4096ull * 256 * 2;
constexpr size_t OFF_WO = OFF_WG2 + 1024ull * 256 * 2;
constexpr size_t OFF_WEND = OFF_WO + 1024ull * 1024 * 2;
static_assert(OFF_WEND <= 60 * MiB, "weights region");
constexpr size_t OFF_X = 64 * MiB;
constexpr size_t OFF_R0 = 192 * MiB;
constexpr size_t WS_NEED = 512 * MiB;
constexpr size_t OFF_H = OFF_R0;
constexpr size_t OFF_YP = OFF_R0;
constexpr size_t OFF_CAT = OFF_R0 + 128 * MiB;
constexpr size_t OUT_PROJ = 0;
constexpr size_t OUT_FT = 192 * MiB;
constexpr size_t OFF_U = OFF_R0 + 128 * MiB;
constexpr size_t OUT_ACT = 0;
constexpr size_t OFF_HH = OFF_R0;
constexpr size_t OUT_RKV = 0;
constexpr size_t OUT_P = 192 * MiB;
constexpr size_t OUT_Y = 192 * MiB;
constexpr size_t OFF_D4 = OFF_R0;
constexpr size_t OFF_L = OFF_R0 + 256 * MiB;
constexpr size_t OFF_LG = OFF_R0 + 272 * MiB;
constexpr size_t OFF_INV = OFF_R0 + 288 * MiB;
constexpr size_t OFF_BON = OFF_R0 + 290 * MiB;
constexpr size_t OFF_G = OFF_R0;
constexpr size_t OFF_YG = OFF_R0 + 64 * MiB;

constexpr size_t OFF_HSLOT = 60 * MiB;
constexpr size_t OFF_BAR = 59 * MiB;
struct P { const float* in[31]; float* out; unsigned char* ws; int ph_lo, ph_hi; };

__device__ __forceinline__ float bflo(unsigned w) { return __uint_as_float(w << 16); }
__device__ __forceinline__ float bfhi(unsigned w) { return __uint_as_float(w & 0xffff0000u); }
__device__ __forceinline__ float bf2f(u16 v) { return __uint_as_float((unsigned)v << 16); }
__device__ __forceinline__ unsigned pk2(float lo, float hi) { unsigned r; asm("v_cvt_pk_bf16_f32 %0, %1, %2" : "=v"(r) : "v"(lo), "v"(hi)); return r; }
__device__ __forceinline__ u16 f2bf(float v) { return (u16)(pk2(v, 0.f) & 0xffffu); }
__device__ __forceinline__ u32x4 pk8(const float* v) { u32x4 o; o.x = pk2(v[0], v[1]); o.y = pk2(v[2], v[3]); o.z = pk2(v[4], v[5]); o.w = pk2(v[6], v[7]); return o; }
__device__ __forceinline__ void unpk8(u32x4 w, float* v) { v[0] = bflo(w.x); v[1] = bfhi(w.x); v[2] = bflo(w.y); v[3] = bfhi(w.y); v[4] = bflo(w.z); v[5] = bfhi(w.z); v[6] = bflo(w.w); v[7] = bfhi(w.w); }
#define DPP_ADD(v, ctrl) v += __int_as_float(__builtin_amdgcn_update_dpp(0, __float_as_int(v), ctrl, 0xF, 0xF, true))
__device__ __forceinline__ float allreduce16(float v) { DPP_ADD(v, 0xB1); DPP_ADD(v, 0x4E); DPP_ADD(v, 0x141); DPP_ADD(v, 0x140); return v; }
__device__ __forceinline__ float wave_sum(float v) {
    v = allreduce16(v);
    const float a = __int_as_float(__builtin_amdgcn_readlane(__float_as_int(v), 0)), b = __int_as_float(__builtin_amdgcn_readlane(__float_as_int(v), 16)),
                c = __int_as_float(__builtin_amdgcn_readlane(__float_as_int(v), 32)), d = __int_as_float(__builtin_amdgcn_readlane(__float_as_int(v), 48));
    return (a + b) + (c + d); }
__device__ __forceinline__ float allreduce4(float v) { DPP_ADD(v, 0xB1); DPP_ADD(v, 0x4E); return v; }
__device__ __forceinline__ float sigmoidf_(float x) { return __builtin_amdgcn_rcpf(1.f + __expf(-x)); }
__device__ __forceinline__ int seqT(int t) { return t < HT ? 4096 : 8192; }

#define XB_XCNT(j)  (256  + 64 * (j))
#define XB_XSUB(j)  (1280 + 64 * (j))
#define XB_XGEN(j)  (2304 + 64 * (j))
#define XB_TOP      3328
#define XB_TOPGEN   3392
#define XCD_BAR_WORDS 3456
__device__ __forceinline__ unsigned xb_ld(unsigned* p)              { return __hip_atomic_load(p, __ATOMIC_RELAXED, __HIP_MEMORY_SCOPE_AGENT); }
__device__ __forceinline__ unsigned xb_add(unsigned* p, unsigned v) { return __hip_atomic_fetch_add(p, v, __ATOMIC_RELAXED, __HIP_MEMORY_SCOPE_AGENT); }
__device__ __forceinline__ unsigned xb_xcc_id() { return (unsigned)__builtin_amdgcn_s_getreg((3 << 11) | 20) & 0xFu; }
__device__ __forceinline__ void grid_bar(unsigned* bar, volatile LAS unsigned* st) {
    asm volatile("s_waitcnt vmcnt(0)" ::: "memory");
    __syncthreads();
    if (threadIdx.x == 0) {
        __builtin_amdgcn_s_waitcnt(0);
        const unsigned x = xb_xcc_id();
        unsigned nloc = st[0], nx = st[1]; const unsigned gen = st[2]; st[2] = gen + 1u;
        if (nloc == 0u) {
            for (;;) { unsigned sum = 0u, cnt = 0u, mine = 0u;
#pragma unroll 1
                for (unsigned j = 0; j < 16; ++j) { const unsigned c = xb_ld(&bar[XB_XCNT(j)]); sum += c; cnt += (c > 0u) ? 1u : 0u; mine = (j == x) ? c : mine; }
                if (sum == gridDim.x) { nloc = mine; nx = cnt; break; }
                __builtin_amdgcn_s_sleep(1); }
            st[0] = nloc; st[1] = nx; }
        const unsigned old = xb_add(&bar[XB_XSUB(x)], 1u);
        if (old + 1u == (gen + 1u) * nloc) {
            __builtin_amdgcn_fence(__ATOMIC_RELEASE, "agent");
            asm volatile("s_waitcnt vmcnt(0)" ::: "memory");
            const unsigned og = xb_add(&bar[XB_TOP], 1u);
            if (og + 1u == (gen + 1u) * nx) xb_add(&bar[XB_TOPGEN], 1u);
            else while (xb_ld(&bar[XB_TOPGEN]) == gen) __builtin_amdgcn_s_sleep(1);
            __builtin_amdgcn_fence(__ATOMIC_ACQUIRE, "agent");
            xb_add(&bar[XB_XGEN(x)], 1u);
            asm volatile("s_waitcnt vmcnt(0)" ::: "memory");
        } else {
            while (xb_ld(&bar[XB_XGEN(x)]) == gen) __builtin_amdgcn_s_sleep(1);
            __builtin_amdgcn_fence(__ATOMIC_ACQUIRE, "agent");
            asm volatile("s_waitcnt vmcnt(0)" ::: "memory");
        }
    }
    __syncthreads();
}
constexpr int HTB = 128 * 64 * 2;
__device__ __forceinline__ int lds_byte(int r, int c) { const int st = (r >> 4) * 2 + (c >> 5), rr = r & 15, cc = c & 31, ob = rr * 64 + cc * 2; return st * 1024 + (ob ^ (((ob >> 9) & 1) << 5)); }
__device__ __forceinline__ void stage_rc(int b, int& R, int& C) { const int st = b / 1024, sb = b % 1024, swz = sb ^ (((sb >> 9) & 1) << 5); R = (st >> 1) * 16 + swz / 64; C = (st & 1) * 32 + (swz % 64) / 2; }
__device__ __forceinline__ int perm32(int rho) { const int n = rho >> 4, i = rho & 15; return 8 * (i >> 2) + 4 * n + (i & 3); }
struct Unit { int pm, pn; };
__device__ __forceinline__ bool next_unit(int i, int nM, int nN, Unit& u) {
    const int nwg = nM * nN; const long L = (long)i * (long)gridDim.x + blockIdx.x; if (L >= nwg) return false;
    int wgid = (int)L; { const int q = nwg / 8, r = nwg % 8, xcd = wgid % 8, off = wgid / 8; wgid = (xcd < r ? xcd * (q + 1) : r * (q + 1) + (xcd - r) * q) + off; }
    const int nig = 8 * nN, gid = wgid / nig, fm = gid * 8, gsz = (nM - fm) < 8 ? (nM - fm) : 8;
    u.pm = fm + ((wgid % nig) % gsz); u.pn = (wgid % nig) / gsz; return true;
}

template <class Epi>
__device__ __forceinline__ void gemm_phase(LAS unsigned char* lds, const u16* A, int lda, const u16* Bt, int ldb, int nM, int nN, int K, const Epi& E, int ashift = 31, size_t astride = 0) {
    int tid = opaque_tid();
    const int wid = __builtin_amdgcn_readfirstlane(tid >> 6), lane = tid & 63, wr = wid >> 2, wc = wid & 3, fr = lane & 15, fq = lane >> 4;
    const int nt = K / 64;
    unsigned voffA[2], voffB[2];
#pragma unroll
    for (int i = 0; i < 2; ++i) { int R, C; stage_rc(tid * 16 + i * 8192, R, C); const int Rb = (R & ~31) + perm32(R & 31);
        voffA[i] = (unsigned)(R * lda + C) * 2u; voffB[i] = (unsigned)(Rb * ldb + C) * 2u; }
    const size_t kstep = 128;
    const size_t hstepA = (size_t)128 * lda * 2, hstepB = (size_t)128 * ldb * 2, tstepA = 2 * hstepA, tstepB = 2 * hstepB;
    const unsigned ldsw = (unsigned)wid * 1024u;
    const int aoff = lds_byte(wr * 64 + fr, fq * 8), boff = lds_byte(wc * 32 + fr, fq * 8);
#define G_SA(b, h) (((b) * 2 + (h)) * HTB)
#define G_SB(b, h) ((4 + (b) * 2 + (h)) * HTB)
#define G_STAGE(bufoff, gbase, voff) do { _Pragma("unroll") for (int _i = 0; _i < 2; ++_i) \
        __builtin_amdgcn_global_load_lds((const unsigned*)((const char*)(gbase) + (voff)[_i]), (LAS unsigned*)(lds + (bufoff) + ldsw + _i * 8192), 16, 0, 0); } while (0)
#define G_LDA(dst, b, h) do { _Pragma("unroll") for (int m = 0; m < 4; ++m) _Pragma("unroll") for (int k = 0; k < 2; ++k) dst[m][k] = *(const LAS bf16x8*)(lds + G_SA(b, h) + aoff + m * 2048 + k * 1024); } while (0)
#define G_LDB(dst, b, h) do { _Pragma("unroll") for (int n = 0; n < 2; ++n) _Pragma("unroll") for (int k = 0; k < 2; ++k) dst[n][k] = *(const LAS bf16x8*)(lds + G_SB(b, h) + boff + n * 2048 + k * 1024); } while (0)
#define G_MMA(ai, bj, At, Bt_) do { __builtin_amdgcn_s_setprio(1); _Pragma("unroll") for (int m = 0; m < 4; ++m) _Pragma("unroll") for (int n = 0; n < 2; ++n) _Pragma("unroll") for (int k = 0; k < 2; ++k) \
        acc[ai][bj][m][n] = __builtin_amdgcn_mfma_f32_16x16x32_bf16(Bt_[n][k], At[m][k], acc[ai][bj][m][n], 0, 0, 0); __builtin_amdgcn_s_setprio(0); } while (0)
#define G_WAIT_V(n) asm volatile("s_waitcnt vmcnt(" #n ")" ::: "memory")
#define G_WAIT_L(n) asm volatile("s_waitcnt lgkmcnt(" #n ")" ::: "memory")
#define G_BAR __builtin_amdgcn_s_barrier()
#define G_SCHED __builtin_amdgcn_sched_barrier(0)
    Unit cur, nxt; int ui = 0;
    if (!next_unit(0, nM, nN, cur)) return;
    f32x4 acc[2][2][4][2];
#pragma unroll
    for (int a = 0; a < 2; ++a)
#pragma unroll
        for (int b = 0; b < 2; ++b)
#pragma unroll
            for (int m = 0; m < 4; ++m)
#pragma unroll
                for (int n = 0; n < 2; ++n) acc[a][b][m][n] = (f32x4){0.f, 0.f, 0.f, 0.f};
    bf16x8 At[4][2], B0[2][2], B1[2][2];
    const char* cA = (const char*)A + (size_t)(cur.pn >> ashift) * astride + (size_t)cur.pm * tstepA; const char* cB = (const char*)Bt + (size_t)cur.pn * tstepB;
    G_STAGE(G_SB(0, 0), cB, voffB); G_STAGE(G_SA(0, 0), cA, voffA); G_STAGE(G_SB(0, 1), cB + hstepB, voffB); G_STAGE(G_SA(0, 1), cA + hstepA, voffA);
    if (wr == 1) G_BAR;
    G_WAIT_V(4); G_BAR;
    G_STAGE(G_SB(1, 0), cB + kstep, voffB); G_STAGE(G_SA(1, 0), cA + kstep, voffA); G_STAGE(G_SB(1, 1), cB + hstepB + kstep, voffB);
    G_WAIT_V(6); G_BAR;
    for (;;) {
        const bool has_next = next_unit(ui + 1, nM, nN, nxt);
        const char* nA = has_next ? (const char*)A + (size_t)(nxt.pn >> ashift) * astride + (size_t)nxt.pm * tstepA : cA; const char* nB = has_next ? (const char*)Bt + (size_t)nxt.pn * tstepB : cB;
        for (int t = 0; t < nt; t += 2) {
            const bool last = (t == nt - 2);
            const char* a1 = cA + (size_t)(t + 1) * kstep;
            const char* a2 = last ? nA : cA + (size_t)(t + 2) * kstep; const char* b2 = last ? nB : cB + (size_t)(t + 2) * kstep;
            const char* a3 = a2 + kstep; const char* b3 = b2 + kstep;
            G_LDB(B0, 0, 0); G_SCHED; G_LDA(At, 0, 0); G_STAGE(G_SA(1, 1), a1 + hstepA, voffA);
            G_WAIT_L(8); G_BAR; G_WAIT_L(0); G_MMA(0, 0, At, B0); G_BAR; G_SCHED;
            G_LDB(B1, 0, 1); G_STAGE(G_SB(0, 0), b2, voffB);
            G_BAR; G_WAIT_L(0); G_MMA(0, 1, At, B1); G_BAR;
            G_LDA(At, 0, 1); G_STAGE(G_SA(0, 0), a2, voffA);
            G_BAR; G_WAIT_L(0); G_MMA(1, 0, At, B0); G_BAR; G_SCHED;
            G_STAGE(G_SB(0, 1), b2 + hstepB, voffB);
            G_WAIT_V(6); G_BAR; G_MMA(1, 1, At, B1); G_BAR;
            G_LDB(B0, 1, 0); G_SCHED; G_LDA(At, 1, 0); G_STAGE(G_SA(0, 1), a2 + hstepA, voffA);
            G_WAIT_L(8); G_BAR; G_WAIT_L(0); G_MMA(0, 0, At, B0); G_BAR; G_SCHED;
            G_LDB(B1, 1, 1); G_STAGE(G_SB(1, 0), b3, voffB);
            G_BAR; G_WAIT_L(0); G_MMA(0, 1, At, B1); G_BAR;
            G_LDA(At, 1, 1); G_STAGE(G_SA(1, 0), a3, voffA);
            G_BAR; G_WAIT_L(0); G_MMA(1, 0, At, B0); G_BAR; G_SCHED;
            G_STAGE(G_SB(1, 1), b3 + hstepB, voffB);
            G_WAIT_V(6); G_BAR; G_MMA(1, 1, At, B1); G_BAR;
        }
        {
            const int row0 = cur.pm * 256 + wr * 64 + fr, col0 = cur.pn * 256 + wc * 32 + 8 * fq;
            if constexpr (Epi::PRE == 1) {
#pragma unroll
                for (int ai = 0; ai < 2; ++ai) { u32x4 pre[8];
#pragma unroll
                    for (int m = 0; m < 4; ++m)
#pragma unroll
                        for (int bj = 0; bj < 2; ++bj) pre[m * 2 + bj] = E.pre(row0 + ai * 128 + m * 16, col0 + bj * 128);
#pragma unroll
                    for (int m = 0; m < 4; ++m)
#pragma unroll
                        for (int bj = 0; bj < 2; ++bj) E.store(row0 + ai * 128 + m * 16, col0 + bj * 128, acc[ai][bj][m][0], acc[ai][bj][m][1], pre[m * 2 + bj]); } }
            else if constexpr (Epi::PRE == 2) {
#pragma unroll
                for (int bj = 0; bj < 2; ++bj) { f32x4 cb0, cb1; E.cpre(col0 + bj * 128, cb0, cb1);
#pragma unroll
                    for (int ai = 0; ai < 2; ++ai)
#pragma unroll
                        for (int m = 0; m < 4; ++m) E.store(row0 + ai * 128 + m * 16, col0 + bj * 128, acc[ai][bj][m][0], acc[ai][bj][m][1], cb0, cb1); } }
            else if constexpr (Epi::PRE == 3) {
#pragma unroll
                for (int ai = 0; ai < 2; ++ai)
#pragma unroll
                    for (int mp = 0; mp < 2; ++mp) { f32x4 pa[4], pb[4];
#pragma unroll
                        for (int mm = 0; mm < 2; ++mm)
#pragma unroll
                            for (int bj = 0; bj < 2; ++bj) E.pre2(row0 + ai * 128 + (2 * mp + mm) * 16, col0 + bj * 128, pa[mm * 2 + bj], pb[mm * 2 + bj]);
#pragma unroll
                        for (int mm = 0; mm < 2; ++mm)
#pragma unroll
                            for (int bj = 0; bj < 2; ++bj) E.store(row0 + ai * 128 + (2 * mp + mm) * 16, col0 + bj * 128, acc[ai][bj][2 * mp + mm][0], acc[ai][bj][2 * mp + mm][1], pa[mm * 2 + bj], pb[mm * 2 + bj]); } }
            else {
#pragma unroll
                for (int ai = 0; ai < 2; ++ai)
#pragma unroll
                    for (int m = 0; m < 4; ++m)
#pragma unroll
                        for (int bj = 0; bj < 2; ++bj) E.store(row0 + ai * 128 + m * 16, col0 + bj * 128, acc[ai][bj][m][0], acc[ai][bj][m][1]); }
        }
        if (!has_next) break;
#pragma unroll
        for (int a = 0; a < 2; ++a)
#pragma unroll
            for (int b = 0; b < 2; ++b)
#pragma unroll
                for (int m = 0; m < 4; ++m)
#pragma unroll
                    for (int n = 0; n < 2; ++n) acc[a][b][m][n] = (f32x4){0.f, 0.f, 0.f, 0.f};
        cur = nxt; cA = nA; cB = nB; ++ui;
    }
    G_WAIT_V(0);
    if (wr == 0) G_BAR;
    G_BAR;
#undef G_SA
#undef G_SB
#undef G_STAGE
#undef G_LDA
#undef G_LDB
#undef G_MMA
#undef G_WAIT_V
#undef G_WAIT_L
#undef G_BAR
#undef G_SCHED
}

__device__ __forceinline__ u32x4 pkv(f32x4 v0, f32x4 v1) { u32x4 w; w.x = pk2(v0.x, v0.y); w.y = pk2(v0.z, v0.w); w.z = pk2(v1.x, v1.y); w.w = pk2(v1.z, v1.w); return w; }
struct EpiPlain { static constexpr int PRE = 0; u16* O; size_t ld;
    __device__ __forceinline__ void store(int row, int col, f32x4 v0, f32x4 v1) const { *(u32x4*)(O + (size_t)row * ld + col) = pkv(v0, v1); } };
struct EpiSplit { static constexpr int PRE = 0; u16* O; size_t stride;
    __device__ __forceinline__ void store(int row, int col, f32x4 v0, f32x4 v1) const { const int t = col >> 10; *(u32x4*)(O + (size_t)t * stride + (size_t)row * 1024 + (col & 1023)) = pkv(v0, v1); } };
struct EpiRkvP { static constexpr int PRE = 0; u16* O; size_t stride; u16* Pb;
    __device__ __forceinline__ void store(int row, int col, f32x4 v0, f32x4 v1) const { const int t = col >> 10;
        u16* dst = (t < 3) ? O + (size_t)t * stride + (size_t)row * 1024 + (col & 1023) : Pb + (size_t)row * 768 + (col - 3072);
        *(u32x4*)dst = pkv(v0, v1); } };
struct EpiDft { static constexpr int PRE = 0; u16* CAT;
    __device__ __forceinline__ void store(int row, int col, f32x4 v0, f32x4 v1) const {
        const int ri = row >> 8, k1 = row & 255; int tok;
        if (col < 65536) { const int b = col >> 13, k2 = (col >> 9) & 15; tok = b * 4096 + k1 * 16 + k2; }
        else { const int n2 = col - 65536; const int b = n2 >> 14, k2 = (n2 >> 9) & 31; tok = HT + b * 8192 + k1 * 32 + k2; }
        const int ch = col & 511;
        *(u32x4*)(CAT + (size_t)tok * 1536 + 512 + ri * 512 + ch) = pkv(v0, v1); } };
struct EpiOut0 { static constexpr int PRE = 3; const float* xp; const float* xs; u16* X;
    __device__ __forceinline__ void pre2(int row, int col, f32x4& a, f32x4& b) const {
        const float* src = (row < HT ? xp + (size_t)row * 1024 : xs + (size_t)(row - HT) * 1024) + col; a = *(const f32x4*)src; b = *(const f32x4*)(src + 4); }
    __device__ __forceinline__ void store(int row, int col, f32x4 v0, f32x4 v1, f32x4 a, f32x4 b) const { *(u32x4*)(X + (size_t)row * 1024 + col) = pkv(a + v0, b + v1); } };
struct EpiResid { static constexpr int PRE = 1; u16* X;
    __device__ __forceinline__ u32x4 pre(int row, int col) const { return *(const u32x4*)(X + (size_t)row * 1024 + col); }
    __device__ __forceinline__ void store(int row, int col, f32x4 v0, f32x4 v1, u32x4 w) const {
        f32x4 a = {bflo(w.x), bfhi(w.x), bflo(w.y), bfhi(w.y)}, b = {bflo(w.z), bfhi(w.z), bflo(w.w), bfhi(w.w)};
        *(u32x4*)(X + (size_t)row * 1024 + col) = pkv(a + v0, b + v1); } };
struct EpiUp2 { static constexpr int PRE = 2; u16* D4; const float* w0; const float* a0;
    __device__ __forceinline__ void cpre(int col, f32x4& b0, f32x4& b1) const { const int gi = col >> 10, c = col & 1023; const float* bias = (gi < 2 ? w0 + gi * 1024 : a0 + (gi - 2) * 1024) + c; b0 = *(const f32x4*)bias; b1 = *(const f32x4*)(bias + 4); }
    __device__ __forceinline__ void store(int row, int col, f32x4 v0, f32x4 v1, f32x4 b0, f32x4 b1) const {
        const int gi = col >> 10, c = col & 1023; const float sc = gi < 2 ? -0.60653066f : 1.f; f32x4 x0 = v0 + b0, x1 = v1 + b1;
#pragma unroll
        for (int j = 0; j < 4; ++j) { x0[j] = sc * __builtin_amdgcn_rcpf(1.f + __expf(-x0[j])); x1[j] = sc * __builtin_amdgcn_rcpf(1.f + __expf(-x1[j])); }
        *(u32x4*)(D4 + (size_t)gi * ((size_t)HT * 1024) + (size_t)row * 1024 + c) = pkv(x0, x1); } };
struct Job { const float* src; const float* vec; u16* dst; int ldsrc, lddst, K, N; float c0, c1; };
__device__ __forceinline__ bool get_job(unsigned char* ws, unsigned char* ob, LAS unsigned char* lds, int j, Job& jb) {
    jb.vec = nullptr; jb.c0 = 1.f; jb.c1 = 0.f;
    if (j == 0) { jb.src = IN(5); jb.ldsrc = 2048; jb.dst = (u16*)(ws + OFF_WC); jb.lddst = 1024; jb.K = 1024; jb.N = 1536; return true; }
    if (j == 1) { jb.src = IN(5) + 1536; jb.ldsrc = 2048; jb.dst = (u16*)(ws + OFF_WF); jb.lddst = 1024; jb.K = 1024; jb.N = 512; return true; }
    if (j == 2) { jb.src = IN(7); jb.ldsrc = 1024; jb.dst = (u16*)(ws + OFF_WEFF); jb.lddst = 1536; jb.K = 512; jb.N = 1024; return true; }
    if (j < 5) { const int l = j - 3; jb.src = IN(27) + (size_t)l * 1024 * 5632; jb.ldsrc = 5632; jb.dst = (u16*)(ws + OFF_WUP) + (size_t)l * 5632 * 1024; jb.lddst = 1024; jb.K = 1024; jb.N = 5632; return true; }
    if (j < 7) { const int l = j - 5; jb.src = IN(30) + (size_t)l * 2816 * 1024; jb.ldsrc = 1024; jb.dst = (u16*)(ws + OFF_WDN) + (size_t)l * 1024 * 2816; jb.lddst = 2816; jb.K = 2816; jb.N = 1024; return true; }
    if (j < 10) { const int q = j - 7; jb.src = IN(10 + q); jb.ldsrc = 1024; jb.dst = (u16*)(ws + OFF_WRKV) + (size_t)q * 1024 * 1024; jb.lddst = 1024; jb.K = 1024; jb.N = 1024; return true; }
    if (j < 13) { jb.src = IN(10); jb.ldsrc = 1024; jb.dst = (u16*)(ws + OFF_WRKV); jb.lddst = 1024; jb.K = 0; jb.N = 32; return true; }
    if (j < 21) { const int i = (j - 13) >> 1, part = (j - 13) & 1, z = i & 1, which = i >> 1; jb.src = IN(which ? 18 : 15) + (size_t)z * 1024 * 64; jb.ldsrc = 64; jb.vec = IN(9) + (z * 2 + which) * 1024;
        jb.c0 = part ? 0.f : 1.f; jb.c1 = part ? 1.f : -1.f; jb.dst = (u16*)(ws + OFF_WLORA) + (size_t)(i * 128 + part * 64) * 1024; jb.lddst = 1024; jb.K = 1024; jb.N = 64; return true; }
    if (j < 23) { const int part = j - 21; jb.src = IN(20); jb.ldsrc = 128; jb.vec = IN(8) + 3 * 1024; jb.c0 = part ? 0.f : 1.f; jb.c1 = part ? 0.5f : -1.f;
        jb.dst = (u16*)(ws + OFF_WLORA) + (size_t)(512 + part * 128) * 1024; jb.lddst = 1024; jb.K = 1024; jb.N = 128; return true; }
    if (j == 23) { jb.src = IN(13); jb.ldsrc = 1024; jb.dst = (u16*)(ws + OFF_WO); jb.lddst = 1024; jb.K = 1024; jb.N = 1024; return true; }
    return false;
}
__device__ __forceinline__ void tr_item(const Job& jb, LAS float* scr, int item, int lane) {
    const int nblk = jb.N / 32, kb = item / nblk, nb = item % nblk, k0 = 64 * kb, n0 = 32 * nb;
#pragma unroll 8
    for (int i = 0; i < 32; ++i) { const int kk = 2 * i + (lane >> 5); const float s = jb.vec ? jb.c0 + jb.c1 * jb.vec[k0 + kk] : 1.f;
        scr[kk * 33 + (lane & 31)] = jb.src[(size_t)(k0 + kk) * jb.ldsrc + n0 + (lane & 31)] * s; }
    asm volatile("s_waitcnt lgkmcnt(0)" ::: "memory");
    const int c = lane & 7;
#pragma unroll
    for (int j = 0; j < 4; ++j) { const int n = (lane >> 3) + 8 * j; const LAS float* s = scr + (8 * c) * 33 + n;
        u32x4 o; o.x = pk2(s[0 * 33], s[1 * 33]); o.y = pk2(s[2 * 33], s[3 * 33]); o.z = pk2(s[4 * 33], s[5 * 33]); o.w = pk2(s[6 * 33], s[7 * 33]);
        *(u32x4*)(jb.dst + (size_t)(n0 + n) * jb.lddst + k0 + 8 * c) = o; }
    asm volatile("s_waitcnt lgkmcnt(0)" ::: "memory");
}
__device__ __forceinline__ void prep_phase(unsigned char* ws, unsigned char* ob, LAS unsigned char* lds) {
    const int tid = opaque_tid(), lane = tid & 63, wave = tid >> 6;
    LAS float* scr = (LAS float*)(lds + wave * 16384);
    const int gw = blockIdx.x * 8 + wave, NGW = gridDim.x * 8;
    int base = 0;
    for (int j = 0; j < 24; ++j) { Job jb; get_job(ws, ob, lds, j, jb); const int cnt = (jb.K / 64) * (jb.N / 32);
        int first = (gw - base % NGW + NGW) % NGW;
        for (int it = first; it < cnt; it += NGW) tr_item(jb, scr, it, lane);
        base += cnt; }
    const size_t gt = (size_t)blockIdx.x * 512 + tid, NT = (size_t)gridDim.x * 512;
    {
        u16* WE = (u16*)(ws + OFF_WEFF); const float* wo = IN(7);
        for (size_t i = gt; i < 512ull * 1024; i += NT) { const int d = (int)(i & 1023), gc = (int)(i >> 10), g = gc >> 7, c = gc & 127;
            float sr = 0.f, si = 0.f;
            for (int c2 = 0; c2 < 128; ++c2) { const float fr = (float)((c * c2) & 127) * (1.f / 128.f); const float w = wo[(size_t)(512 + 128 * g + c2) * 1024 + d];
                sr += __builtin_amdgcn_cosf(fr) * w; si += __builtin_amdgcn_sinf(fr) * w; }
            WE[(size_t)d * 1536 + 512 + gc] = f2bf(sr * 0.08838834764f); WE[(size_t)d * 1536 + 1024 + gc] = f2bf(si * 0.08838834764f); }
    }
    {
        u16* DA = (u16*)(ws + OFF_DFTA);
        for (size_t i = gt; i < 512ull * 512; i += NT) { const int kk = (int)(i & 511), m = (int)(i >> 9); const int rio = m >> 8, k1 = m & 255, rii = kk >> 8, t1 = kk & 255;
            const float fr = (float)((k1 * t1) & 255) * (1.f / 256.f); const float c = __builtin_amdgcn_cosf(fr), s = __builtin_amdgcn_sinf(fr);
            DA[i] = f2bf(rio == rii ? c : (rio == 0 ? s : -s)); }
    }
    {
        u16* W2 = (u16*)(ws + OFF_WUP2);
        for (size_t i = gt; i < 4096ull * 256; i += NT) { const int k = (int)(i & 255), n = (int)(i >> 8), gi = n >> 10, c = n & 1023; float v = 0.f;
            if ((k >> 6) == gi) { const int z = gi & 1; const float* src = (gi < 2 ? IN(16) : IN(19)) + (size_t)z * 64 * 1024; v = src[(size_t)(k & 63) * 1024 + c]; }
            W2[i] = f2bf(v); }
        u16* WG = (u16*)(ws + OFF_WG2);
        for (size_t i = gt; i < 1024ull * 256; i += NT) { const int k = (int)(i & 255), n = (int)(i >> 8); WG[i] = f2bf(k < 128 ? IN(21)[(size_t)k * 1024 + n] : 0.f); }
    }
}

__device__ __forceinline__ void load_row_bf(const u16* row, int lane, float* v) { unpk8(*(const u32x4*)(row + 8 * lane), v); unpk8(*(const u32x4*)(row + 512 + 8 * lane), v + 8); }
__device__ __forceinline__ float rstd_of(const float* v) { float s = 0.f;
#pragma unroll
    for (int j = 0; j < 16; ++j) s += v[j] * v[j];
    return 1.f / sqrtf(wave_sum(s) * (1.f / 1024.f) + 1e-6f); }
__device__ __forceinline__ void norm0_phase(unsigned char* ws, unsigned char* ob, LAS unsigned char* lds) {
    const int tix = opaque_tid(); const int lane = tix & 63, gw = blockIdx.x * 8 + (tix >> 6), NGW = gridDim.x * 8;
    u16* H = (u16*)(ws + OFF_H); const float* g = IN(2);
    f32x4 gv[4];
#pragma unroll
    for (int j = 0; j < 4; ++j) gv[j] = *(const f32x4*)(g + 4 * lane + 256 * j);
    for (int t = gw; t < 65536; t += NGW) { const float* xr = t < HT ? IN(0) + (size_t)t * 1024 : IN(1) + (size_t)(t - HT) * 1024;
        f32x4 v[4]; float s = 0.f;
#pragma unroll
        for (int j = 0; j < 4; ++j) { v[j] = *(const f32x4*)(xr + 4 * lane + 256 * j); s += v[j].x * v[j].x + v[j].y * v[j].y + v[j].z * v[j].z + v[j].w * v[j].w; }
        const float r = 1.f / sqrtf(wave_sum(s) * (1.f / 1024.f) + 1e-6f);
#pragma unroll
        for (int j = 0; j < 4; ++j) { const f32x4 o = v[j] * r * gv[j]; u32x2 w; w.x = pk2(o.x, o.y); w.y = pk2(o.z, o.w); *(u32x2*)(H + (size_t)t * 1024 + 4 * lane + 256 * j) = w; } }
}
__device__ __forceinline__ void normx_phase(unsigned char* ws, unsigned char* ob, const float* g, int mode) {
    const int tix = opaque_tid(); const int lane = tix & 63, gw = blockIdx.x * 8 + (tix >> 6), NGW = gridDim.x * 8;
    const u16* X = (const u16*)(ws + OFF_X); u16* H = (u16*)(ws + OFF_H);
    float gv[16];
#pragma unroll
    for (int j = 0; j < 2; ++j)
#pragma unroll
        for (int e = 0; e < 8; ++e) gv[8 * j + e] = g[8 * lane + 512 * j + e];
    for (int t = gw; t < 65536; t += NGW) { float v[16]; load_row_bf(X + (size_t)t * 1024, lane, v); const float r = rstd_of(v);
#pragma unroll
        for (int j = 0; j < 16; ++j) v[j] = v[j] * r * gv[j];
        if (mode == 0) { *(u32x4*)(H + (size_t)t * 1024 + 8 * lane) = pk8(v); *(u32x4*)(H + (size_t)t * 1024 + 512 + 8 * lane) = pk8(v + 8); }
        else { float* o = ((float*)ob) + (size_t)t * 1024;
#pragma unroll
            for (int j = 0; j < 2; ++j) { *(f32x4*)(o + 8 * lane + 512 * j) = (f32x4){v[8 * j], v[8 * j + 1], v[8 * j + 2], v[8 * j + 3]}; *(f32x4*)(o + 8 * lane + 512 * j + 4) = (f32x4){v[8 * j + 4], v[8 * j + 5], v[8 * j + 6], v[8 * j + 7]}; } } }
}
__device__ __forceinline__ void norm1_phase(unsigned char* ws, unsigned char* ob, LAS unsigned char* lds, int hf) {
    const int tix = opaque_tid(); const int lane = tix & 63, gw = blockIdx.x * 8 + (tix >> 6), NGW = gridDim.x * 8;
    const u16* X = (const u16*)(ws + OFF_X) + (size_t)hf * HT * 1024; u16* XO = (u16*)(ws + OFF_HH); const float* g = IN(2) + 1024; const float* mu = IN(8);
    const int T = hf ? 8192 : 4096;
    float gv[16], m1[3][16], m2[3][16];
#pragma unroll
    for (int j = 0; j < 2; ++j)
#pragma unroll
        for (int e = 0; e < 8; ++e) { gv[8 * j + e] = g[8 * lane + 512 * j + e];
#pragma unroll
            for (int q = 0; q < 3; ++q) { const float mm = mu[q * 1024 + 8 * lane + 512 * j + e]; m1[q][8 * j + e] = 1.f - mm; m2[q][8 * j + e] = 0.5f * mm; } }
    for (int r0 = gw * 8; r0 < HT; r0 += NGW * 8) {
        const int pos0 = r0 & (T - 1);
        float pv[16], cv[16], nv[16];
        if (pos0 > 0) { load_row_bf(X + (size_t)(r0 - 1) * 1024, lane, pv); const float r = rstd_of(pv);
#pragma unroll
            for (int j = 0; j < 16; ++j) pv[j] = pv[j] * r * gv[j]; }
        else {
#pragma unroll
            for (int j = 0; j < 16; ++j) pv[j] = 0.f; }
        { load_row_bf(X + (size_t)r0 * 1024, lane, cv); const float r = rstd_of(cv);
#pragma unroll
            for (int j = 0; j < 16; ++j) cv[j] = cv[j] * r * gv[j]; }
        u32x4 nq0 = *(const u32x4*)(X + (size_t)(r0 + 1) * 1024 + 8 * lane), nq1 = *(const u32x4*)(X + (size_t)(r0 + 1) * 1024 + 512 + 8 * lane);
#pragma unroll 2
        for (int i = 0; i < 8; ++i) { const int t = r0 + i; const bool hn = (pos0 + i) < T - 1;
            if (hn) { unpk8(nq0, nv); unpk8(nq1, nv + 8); const float r = rstd_of(nv);
#pragma unroll
                for (int j = 0; j < 16; ++j) nv[j] = nv[j] * r * gv[j]; }
            else {
#pragma unroll
                for (int j = 0; j < 16; ++j) nv[j] = 0.f; }
            if (i < 7 && (pos0 + i + 1) < T - 1) { nq0 = *(const u32x4*)(X + (size_t)(t + 2) * 1024 + 8 * lane); nq1 = *(const u32x4*)(X + (size_t)(t + 2) * 1024 + 512 + 8 * lane); }
            u16* o = XO + (size_t)t * 1024;
#pragma unroll
            for (int q = 0; q < 3; ++q) { float m[16];
#pragma unroll
                for (int j = 0; j < 16; ++j) m[j] = cv[j] * m1[q][j] + m2[q][j] * (pv[j] + nv[j]);
                *(u32x4*)(o + (size_t)q * HT * 1024 + 8 * lane) = pk8(m); *(u32x4*)(o + (size_t)q * HT * 1024 + 512 + 8 * lane) = pk8(m + 8); }
            *(u32x4*)(o + 3ull * HT * 1024 + 8 * lane) = pk8(cv); *(u32x4*)(o + 3ull * HT * 1024 + 512 + 8 * lane) = pk8(cv + 8);
#pragma unroll
            for (int j = 0; j < 16; ++j) { pv[j] = cv[j]; cv[j] = nv[j]; } } }
}

__device__ __forceinline__ void yconv_phase(unsigned char* ws, unsigned char* ob, LAS unsigned char* lds) {
    const int tix = opaque_tid(); const int lane = tix & 63, gw = blockIdx.x * 8 + (tix >> 6), NGW = gridDim.x * 8;
    const u16* PR = (const u16*)(ob + OUT_PROJ); u16* CAT = (u16*)(ws + OFF_CAT); const float* cw = IN(6);
    float w[3][8];
#pragma unroll
    for (int j = 0; j < 3; ++j)
#pragma unroll
        for (int e = 0; e < 8; ++e) w[j][e] = cw[j * 512 + 8 * lane + e];
    for (int t = gw; t < 65536; t += NGW) { const int T = seqT(t), pos = t & (T - 1);
        float acc[8], gb[8];
#pragma unroll
        for (int e = 0; e < 8; ++e) acc[e] = 0.f;
#pragma unroll
        for (int j = 0; j < 3; ++j) { const int pp = pos + j - 1; if (pp < 0 || pp >= T) continue;
            const u16* r = PR + (size_t)(t + j - 1) * 1536 + 8 * lane; float a[8], b[8]; unpk8(*(const u32x4*)(r + 512), a); unpk8(*(const u32x4*)(r + 1024), b);
#pragma unroll
            for (int e = 0; e < 8; ++e) acc[e] += w[j][e] * a[e] * b[e]; }
        unpk8(*(const u32x4*)(PR + (size_t)t * 1536 + 8 * lane), gb);
#pragma unroll
        for (int e = 0; e < 8; ++e) acc[e] *= gb[e];
        *(u32x4*)(CAT + (size_t)t * 1536 + 8 * lane) = pk8(acc); }
}
template <int T2>
__device__ __forceinline__ void stageA_item(const u16* FT, u16* YP, int tokbase, size_t nbase, int ch, int t1) {
    constexpr float C32[32] = {1.000000000f, 0.980785280f, 0.923879533f, 0.831469612f, 0.707106781f, 0.555570233f, 0.382683432f, 0.195090322f, 0.000000000f, -0.195090322f, -0.382683432f, -0.555570233f, -0.707106781f, -0.831469612f, -0.923879533f, -0.980785280f, -1.000000000f, -0.980785280f, -0.923879533f, -0.831469612f, -0.707106781f, -0.555570233f, -0.382683432f, -0.195090322f, -0.000000000f, 0.195090322f, 0.382683432f, 0.555570233f, 0.707106781f, 0.831469612f, 0.923879533f, 0.980785280f};
    constexpr float S32[32] = {0.000000000f, 0.195090322f, 0.382683432f, 0.555570233f, 0.707106781f, 0.831469612f, 0.923879533f, 0.980785280f, 1.000000000f, 0.980785280f, 0.923879533f, 0.831469612f, 0.707106781f, 0.555570233f, 0.382683432f, 0.195090322f, 0.000000000f, -0.195090322f, -0.382683432f, -0.555570233f, -0.707106781f, -0.831469612f, -0.923879533f, -0.980785280f, -1.000000000f, -0.980785280f, -0.923879533f, -0.831469612f, -0.707106781f, -0.555570233f, -0.382683432f, -0.195090322f};
    float xv[T2];
#pragma unroll
    for (int t2 = 0; t2 < T2; ++t2) xv[t2] = bf2f(FT[(size_t)ch * 65536 + tokbase + t1 + 256 * t2]);
    const float invs = 1.f / sqrtf((float)(256 * T2));
#pragma unroll
    for (int k2 = 0; k2 <= T2 / 2; ++k2) { float yr = 0.f, yi = 0.f;
#pragma unroll
        for (int t2 = 0; t2 < T2; ++t2) { const int j = ((k2 * t2) & (T2 - 1)) * (32 / T2); yr += xv[t2] * C32[j]; yi -= xv[t2] * S32[j]; }
#pragma unroll
        for (int mir = 0; mir < 2; ++mir) { const int kk = mir ? T2 - k2 : k2; if (mir && (k2 == 0 || k2 == T2 / 2)) continue; const float yim = mir ? -yi : yi;
            const float fr = (float)(kk * t1) * (1.f / (256.f * T2)); const float c = __builtin_amdgcn_cosf(fr), sn = __builtin_amdgcn_sinf(fr);
            u16* o = YP + (nbase + (size_t)kk * 512 + ch) * 512 + t1;
            o[0] = f2bf((yr * c + yim * sn) * invs); o[256] = f2bf((yim * c - yr * sn) * invs); } }
}
__device__ __forceinline__ void stageA_phase(unsigned char* ws, unsigned char* ob, LAS unsigned char* lds) {
    const int tid = opaque_tid();
    const u16* FT = (const u16*)(ob + OUT_FT); u16* YP = (u16*)(ws + OFF_YP);
    for (int it = blockIdx.x; it < 12 * 256; it += gridDim.x) { const int sq = it >> 8, ch = 2 * (it & 255) + (tid >> 8), t1 = tid & 255;
        if (sq < 8) stageA_item<16>(FT, YP, sq * 4096, (size_t)sq * 16 * 512, ch, t1);
        else stageA_item<32>(FT, YP, HT + (sq - 8) * 8192, 65536 + (size_t)(sq - 8) * 32 * 512, ch, t1); }
}

__device__ __forceinline__ void act_phase(unsigned char* ws, unsigned char* ob, LAS unsigned char* lds, int l, int chunk) {
    const u16* U = (const u16*)(ws + OFF_U); u16* ACT = (u16*)(ob + OUT_ACT);
    const float* cw = IN(28) + (size_t)l * 3 * 5632; const float* cb = IN(29) + (size_t)l * 5632;
    const size_t gt = (size_t)blockIdx.x * 512 + opaque_tid(), NT = (size_t)gridDim.x * 512;
    for (size_t i = gt; i < 1024ull * 352; i += NT) {
        const int rbk = (int)(i / 352), c = 8 * (int)(i % 352), row0 = rbk * 16; const int tg0 = chunk * 16384 + row0, T = seqT(tg0), pos0 = tg0 & (T - 1);
        float wg[3][8], wv[3][8], bg[8], bv[8];
#pragma unroll
        for (int j = 0; j < 3; ++j) { const f32x4 a0 = *(const f32x4*)(cw + j * 5632 + c), a1 = *(const f32x4*)(cw + j * 5632 + c + 4), b0 = *(const f32x4*)(cw + j * 5632 + 2816 + c), b1 = *(const f32x4*)(cw + j * 5632 + 2816 + c + 4);
            wg[j][0] = a0.x; wg[j][1] = a0.y; wg[j][2] = a0.z; wg[j][3] = a0.w; wg[j][4] = a1.x; wg[j][5] = a1.y; wg[j][6] = a1.z; wg[j][7] = a1.w;
            wv[j][0] = b0.x; wv[j][1] = b0.y; wv[j][2] = b0.z; wv[j][3] = b0.w; wv[j][4] = b1.x; wv[j][5] = b1.y; wv[j][6] = b1.z; wv[j][7] = b1.w; }
        { const f32x4 a0 = *(const f32x4*)(cb + c), a1 = *(const f32x4*)(cb + c + 4), b0 = *(const f32x4*)(cb + 2816 + c), b1 = *(const f32x4*)(cb + 2816 + c + 4);
            bg[0] = a0.x; bg[1] = a0.y; bg[2] = a0.z; bg[3] = a0.w; bg[4] = a1.x; bg[5] = a1.y; bg[6] = a1.z; bg[7] = a1.w;
            bv[0] = b0.x; bv[1] = b0.y; bv[2] = b0.z; bv[3] = b0.w; bv[4] = b1.x; bv[5] = b1.y; bv[6] = b1.z; bv[7] = b1.w; }
        float pg[8], pv[8], cg_[8], cv[8];
        const u16* r = U + (size_t)row0 * 5632 + c;
        u32x4 bufg[2][4], bufv[2][4];
        const bool tail_ok = pos0 + 16 < T;
#define ACT_LOAD(g_, b_) do { _Pragma("unroll") for (int k = 0; k < 4; ++k) { const int rn = 4 * (g_) + k + 1; \
            if (rn < 16 || tail_ok) { bufg[b_][k] = *(const u32x4*)(r + (size_t)rn * 5632); bufv[b_][k] = *(const u32x4*)(r + (size_t)rn * 5632 + 2816); } \
            else { bufg[b_][k] = (u32x4){0u, 0u, 0u, 0u}; bufv[b_][k] = (u32x4){0u, 0u, 0u, 0u}; } } } while (0)
        ACT_LOAD(0, 0);
        if (pos0 > 0) { unpk8(*(const u32x4*)(r - 5632), pg); unpk8(*(const u32x4*)(r - 5632 + 2816), pv); }
        else {
#pragma unroll
            for (int e = 0; e < 8; ++e) { pg[e] = 0.f; pv[e] = 0.f; } }
        unpk8(*(const u32x4*)r, cg_); unpk8(*(const u32x4*)(r + 2816), cv);
#pragma unroll
        for (int g = 0; g < 4; ++g) {
            if (g < 3) ACT_LOAD(g + 1, (g + 1) & 1);
#pragma unroll
            for (int k = 0; k < 4; ++k) { float ng[8], nv[8], o[8]; unpk8(bufg[g & 1][k], ng); unpk8(bufv[g & 1][k], nv);
#pragma unroll
                for (int e = 0; e < 8; ++e) { const float gg = bg[e] + wg[0][e] * pg[e] + wg[1][e] * cg_[e] + wg[2][e] * ng[e]; const float v = bv[e] + wv[0][e] * pv[e] + wv[1][e] * cv[e] + wv[2][e] * nv[e];
                    o[e] = gg * sigmoidf_(gg) * v; pg[e] = cg_[e]; pv[e] = cv[e]; cg_[e] = ng[e]; cv[e] = nv[e]; }
                *(u32x4*)(ACT + (size_t)(row0 + 4 * g + k) * 2816 + c) = pk8(o); } }
#undef ACT_LOAD
    }
}

__device__ __forceinline__ void lprep_phase(unsigned char* ws, unsigned char* ob, int hf) {
    const int tix = opaque_tid(); const int lane = tix & 63, gw = blockIdx.x * 8 + (tix >> 6), NGW = gridDim.x * 8;
    const u16* PB = (const u16*)(ob + OUT_P); u16* L = (u16*)(ws + OFF_L); u16* LG = (u16*)(ws + OFF_LG);
    const int T = hf ? 8192 : 4096;
    for (int t = gw; t < HT; t += NGW) { const int pos = t & (T - 1); const u16* r = PB + (size_t)t * 768; float a[8], b[8];
        if (lane < 32) { const int i = lane >> 3, r0 = (lane & 7) * 8, sh = (i & 1) ? 1 : -1; const bool ok = (i & 1) ? (pos < T - 1) : (pos > 0);
            unpk8(*(const u32x4*)(r + i * 128 + r0), a);
            if (ok) { unpk8(*(const u32x4*)(r + sh * 768 + i * 128 + 64 + r0), b);
#pragma unroll
                for (int e = 0; e < 8; ++e) a[e] += b[e]; }
            if (i < 2) {
#pragma unroll
                for (int e = 0; e < 8; ++e) a[e] = 1.f - 2.f * __builtin_amdgcn_rcpf(1.f + __expf(2.f * a[e])); }
            *(u32x4*)(L + (size_t)t * 256 + 8 * lane) = pk8(a); }
        else if (lane < 48) { const int r0 = (lane - 32) * 8; unpk8(*(const u32x4*)(r + 512 + r0), a);
            if (pos > 0) { unpk8(*(const u32x4*)(r - 768 + 640 + r0), b);
#pragma unroll
                for (int e = 0; e < 8; ++e) a[e] += b[e]; }
            if (pos < T - 1) { unpk8(*(const u32x4*)(r + 768 + 640 + r0), b);
#pragma unroll
                for (int e = 0; e < 8; ++e) a[e] += b[e]; }
#pragma unroll
            for (int e = 0; e < 8; ++e) a[e] = sigmoidf_(a[e]);
            *(u32x4*)(LG + (size_t)t * 256 + r0) = pk8(a); }
        else { unsigned zz = 0u; asm volatile("" : "+v"(zz)); *(u32x4*)(LG + (size_t)t * 256 + 128 + (lane - 48) * 8) = (u32x4){zz, zz, zz, zz}; } }
}
__device__ __forceinline__ void rwprep_phase(unsigned char* ws, unsigned char* ob, LAS unsigned char* lds) {
    const int tix = opaque_tid(); const int lane = tix & 63, gw = blockIdx.x * 8 + (tix >> 6), NGW = gridDim.x * 8;
    const u16* R = (const u16*)(ob + OUT_RKV); const u16* Kp = R + (size_t)HT * 1024;
    const u16* A0 = (const u16*)(ws + OFF_D4) + 2ull * HT * 1024; const u16* A1 = A0 + (size_t)HT * 1024;
    float* INV = (float*)(ws + OFF_INV); float* BON = (float*)(ws + OFF_BON);
    const float* kkp = IN(22) + 16 * lane; const float* kap = IN(23) + 16 * lane; const float* rkp = IN(24) + 16 * lane;
    float kk[16], ka[16], rk[16];
#pragma unroll
    for (int e = 0; e < 16; ++e) { kk[e] = kkp[e]; ka[e] = kap[e]; rk[e] = rkp[e]; }
    for (int t0 = gw; t0 < HT; t0 += 2 * NGW) {
        u32x4 q[2][8];
#pragma unroll
        for (int u2 = 0; u2 < 2; ++u2) { const int t = t0 + u2 * NGW; if (t < HT) { const size_t o = (size_t)t * 1024 + 16 * lane;
            q[u2][0] = *(const u32x4*)(Kp + o); q[u2][1] = *(const u32x4*)(Kp + o + 8); q[u2][2] = *(const u32x4*)(R + o); q[u2][3] = *(const u32x4*)(R + o + 8);
            q[u2][4] = *(const u32x4*)(A0 + o); q[u2][5] = *(const u32x4*)(A0 + o + 8); q[u2][6] = *(const u32x4*)(A1 + o); q[u2][7] = *(const u32x4*)(A1 + o + 8); } }
#pragma unroll
        for (int u2 = 0; u2 < 2; ++u2) { const int t = t0 + u2 * NGW; if (t < HT) { float k[16], r[16], a0[16], a1[16];
            unpk8(q[u2][0], k); unpk8(q[u2][1], k + 8); unpk8(q[u2][2], r); unpk8(q[u2][3], r + 8); unpk8(q[u2][4], a0); unpk8(q[u2][5], a0 + 8); unpk8(q[u2][6], a1); unpk8(q[u2][7], a1 + 8);
            float ss = 0.f, bn = 0.f;
#pragma unroll
            for (int e = 0; e < 16; ++e) { const float qq = k[e] * kk[e]; ss += qq * qq; bn += r[e] * k[e] * rk[e] * (2.f + (a0[e] + a1[e] - 2.f) * ka[e]); }
            ss = allreduce4(ss); bn = allreduce4(bn);
            if ((lane & 3) == 0) { INV[(size_t)t * 16 + (lane >> 2)] = 1.f / fmaxf(sqrtf(ss), 1e-12f); BON[(size_t)t * 16 + (lane >> 2)] = bn; } } } }
}
__device__ __forceinline__ void gn_phase(unsigned char* ws, unsigned char* ob, LAS unsigned char* lds) {
    const int tix = opaque_tid(); const int lane = tix & 63, gw = blockIdx.x * 8 + (tix >> 6), NGW = gridDim.x * 8;
    const u16* Y = (const u16*)(ob + OUT_Y); const u16* V = (const u16*)(ob + OUT_RKV) + 2ull * HT * 1024;
    const u16* G = (const u16*)(ws + OFF_G); u16* YG = (u16*)(ws + OFF_YG); const float* BON = (const float*)(ws + OFF_BON); const u16* YB = (const u16*)(ws + OFF_D4) + 3ull * HT * 1024;
    float gw_[16], gb_[16];
#pragma unroll
    for (int e = 0; e < 16; ++e) { gw_[e] = IN(25)[16 * lane + e]; gb_[e] = IN(26)[16 * lane + e]; }
    for (int t0 = gw; t0 < HT; t0 += 2 * NGW) {
        u32x4 q[2][8]; float bnv[2] = {0.f, 0.f};
#pragma unroll
        for (int u2 = 0; u2 < 2; ++u2) { const int t = t0 + u2 * NGW; if (t < HT) { const size_t o = (size_t)t * 1024 + 16 * lane;
            q[u2][0] = *(const u32x4*)(Y + o); q[u2][1] = *(const u32x4*)(Y + o + 8); q[u2][2] = *(const u32x4*)(YB + o); q[u2][3] = *(const u32x4*)(YB + o + 8);
            q[u2][4] = *(const u32x4*)(V + o); q[u2][5] = *(const u32x4*)(V + o + 8); q[u2][6] = *(const u32x4*)(G + o); q[u2][7] = *(const u32x4*)(G + o + 8); bnv[u2] = BON[(size_t)t * 16 + (lane >> 2)]; } }
#pragma unroll
        for (int u2 = 0; u2 < 2; ++u2) { const int t = t0 + u2 * NGW; if (t < HT) { const size_t o = (size_t)t * 1024 + 16 * lane; float y[16], yb[16], v[16], g[16];
            unpk8(q[u2][0], y); unpk8(q[u2][1], y + 8); unpk8(q[u2][2], yb); unpk8(q[u2][3], yb + 8); unpk8(q[u2][4], v); unpk8(q[u2][5], v + 8); unpk8(q[u2][6], g); unpk8(q[u2][7], g + 8);
            float s = 0.f;
#pragma unroll
            for (int e = 0; e < 16; ++e) { y[e] += yb[e]; s += y[e]; }
            const float mean = allreduce4(s) * (1.f / 64.f); float qv = 0.f;
#pragma unroll
            for (int e = 0; e < 16; ++e) { y[e] -= mean; qv += y[e] * y[e]; }
            const float rstd = 1.f / sqrtf(allreduce4(qv) * (1.f / 64.f) + 64e-5f); const float bn = bnv[u2];
#pragma unroll
            for (int e = 0; e < 16; ++e) y[e] = (y[e] * rstd * gw_[e] + gb_[e] + bn * v[e]) * g[e];
            *(u32x4*)(YG + o) = pk8(y); *(u32x4*)(YG + o + 8) = pk8(y + 8); } } }
}

typedef float f32x16 __attribute__((ext_vector_type(16)));
#define MFMA32(a, b, c) __builtin_amdgcn_mfma_f32_32x32x16_bf16((a), (b), (c), 0, 0, 0)
__device__ __forceinline__ unsigned pkc(float lo, float hi) { typedef __bf16 bf2 __attribute__((ext_vector_type(2))); typedef float f2 __attribute__((ext_vector_type(2))); const f2 v = {lo, hi}; const bf2 b = __builtin_convertvector(v, bf2); return __builtin_bit_cast(unsigned, b); }
__device__ __forceinline__ u16 bfc(float v) { return (u16)(pkc(v, 0.f) & 0xffffu); }
__device__ __forceinline__ bf16x8 pack_lo(const f32x16& x) { u32x4 p; p.x = pkc(x[0], x[1]); p.y = pkc(x[2], x[3]); p.z = pkc(x[4], x[5]); p.w = pkc(x[6], x[7]); return __builtin_bit_cast(bf16x8, p); }
__device__ __forceinline__ bf16x8 pack_hi(const f32x16& x) { u32x4 p; p.x = pkc(x[8], x[9]); p.y = pkc(x[10], x[11]); p.z = pkc(x[12], x[13]); p.w = pkc(x[14], x[15]); return __builtin_bit_cast(bf16x8, p); }
constexpr int SL_QS = 1056;
constexpr int SL_AR = 0, SL_BK = 4 * SL_QS, SL_BT = 8 * SL_QS, SL_KT = SL_BT + 2048, SL_VT = SL_KT + 2048, SL_MK = SL_VT + 2048, SL_T2 = SL_MK + 1024, SL_WL = SL_T2 + 1024, SL_SIZE = SL_WL + 256;
static_assert(SL_VT >= 10240 && 8 * SL_SIZE <= LDS_TAB, "scan slot layout");
__device__ __forceinline__ void scan_phase(unsigned char* ws, unsigned char* ob, LAS unsigned char* lds, int hf) {
    const int T = hf ? 8192 : 4096, nunits = (hf ? 4 : 8) * 16 * 2, nblk = T / 16, nbatch = nblk / 8;
    const int tid = opaque_tid(), lane = tid & 63, wave = __builtin_amdgcn_readfirstlane(tid >> 6), r = lane & 31, h = lane >> 5;
    const u16* R = (const u16*)(ob + OUT_RKV); const u16* Kp = R + (size_t)HT * 1024; const u16* V = Kp + (size_t)HT * 1024;
    const u16* D4 = (const u16*)(ws + OFF_D4); const float* INV = (const float*)(ws + OFF_INV);
    const int ci = wave;
    const int jb = lane >> 5, jl = lane & 31, js = jl >> 4, jh = (jl >> 2) & 1, je = ((jl >> 3) & 1) * 4 + (jl & 3);
    const unsigned posj = (unsigned)((jb * 2 + js) * SL_QS + jh * 16 + je * 2);
    LAS unsigned char* sb = lds + wave * SL_SIZE;
#define SC_BAR() do { asm volatile("s_waitcnt lgkmcnt(0)" ::: "memory"); __builtin_amdgcn_s_barrier(); asm volatile("" ::: "memory"); } while (0)
    const int nroles = (hf && gridDim.x >= 256) ? 2 : 1;
    const int bx = blockIdx.x, role = nroles == 2 ? ((bx >> 3) & 1) : 0, u0 = nroles == 2 ? (((bx >> 4) << 3) | (bx & 7)) : bx;
    unsigned* hflag = (unsigned*)(ws + OFF_BAR + 16384); float* hslot = (float*)(ws + OFF_HSLOT);
    for (int u = u0; u < nunits; u += (nroles == 2 ? 1 << 30 : (int)gridDim.x)) {
        if (nroles == 2 && bx >= 256) break;
        const int z = u & 1, hd = (u >> 1) & 15, b = u >> 5; const size_t seqbase = (size_t)b * T;
        u16* Y = z ? (u16*)(ws + OFF_D4) + 3ull * HT * 1024 : (u16*)(ob + OUT_Y);
        const float kkc = IN(22)[hd * 64 + lane], kac = IN(23)[hd * 64 + lane];
        f32x16 X0, X1;
#pragma unroll
        for (int g = 0; g < 16; ++g) { X0[g] = 0.f; X1[g] = 0.f; }
        const unsigned lanepart = (unsigned)((hd * 64 + 8 * (lane & 7)) * 2); const u16* Dz = D4 + (size_t)z * HT * 1024; const u16* Az = D4 + (size_t)(2 + z) * HT * 1024;
        u32x4 graw[5][2]; float inv = 0.f;
#define SC_LOAD(bt_) do { int nb_ = (bt_); asm volatile("" : "+s"(nb_)); const int n_ = nb_ * 8 + ci;     \
            _Pragma("unroll") for (int i2 = 0; i2 < 2; ++i2) { const int t_ = (lane >> 3) + 8 * i2; const int tl_ = z ? (T - 1 - (16 * n_ + t_)) : (16 * n_ + t_); \
                const unsigned off_ = (unsigned)(((int)seqbase + tl_) * 2048) + lanepart;            \
                graw[0][i2] = *(const u32x4*)((const char*)R + off_); graw[1][i2] = *(const u32x4*)((const char*)Kp + off_); graw[2][i2] = *(const u32x4*)((const char*)V + off_); \
                graw[3][i2] = *(const u32x4*)((const char*)Dz + off_); graw[4][i2] = *(const u32x4*)((const char*)Az + off_); } \
            { const int t_ = lane & 15; const int tl_ = z ? (T - 1 - (16 * n_ + t_)) : (16 * n_ + t_); inv = *(const float*)((const char*)INV + (unsigned)((((int)seqbase + tl_) * 16 + hd) * 4)); } } while (0)
        SC_LOAD(role);
        __syncthreads();
        for (int bt = role; bt < nbatch; bt += nroles) {
            {
#pragma unroll
                for (int a5 = 0; a5 < 5; ++a5) { *(LAS u32x4*)(sb + a5 * 2048 + lane * 16) = graw[a5][0]; *(LAS u32x4*)(sb + a5 * 2048 + 1024 + lane * 16) = graw[a5][1]; }
                asm volatile("s_waitcnt lgkmcnt(0)" ::: "memory");
                unsigned rr[16], kr[16], lr[16], ar[16], vr[16];
#pragma unroll
                for (int t = 0; t < 16; ++t) { rr[t] = *(const LAS u16*)(sb + 0 * 2048 + t * 128 + 2 * lane); kr[t] = *(const LAS u16*)(sb + 1 * 2048 + t * 128 + 2 * lane); vr[t] = *(const LAS u16*)(sb + 2 * 2048 + t * 128 + 2 * lane);
                    lr[t] = *(const LAS u16*)(sb + 3 * 2048 + t * 128 + 2 * lane); ar[t] = *(const LAS u16*)(sb + 4 * 2048 + t * 128 + 2 * lane); }
                asm volatile("s_waitcnt lgkmcnt(0)" ::: "memory");
#define PK16(a_, t0_) ((a_)[t0_] | ((a_)[(t0_) + 1] << 16))
                *(LAS u32x4*)(sb + SL_VT + lane * 32) = (u32x4){PK16(vr, 0), PK16(vr, 2), PK16(vr, 8), PK16(vr, 10)}; *(LAS u32x4*)(sb + SL_VT + lane * 32 + 16) = (u32x4){PK16(vr, 4), PK16(vr, 6), PK16(vr, 12), PK16(vr, 14)};
                float L = 0.f, Eprev = 1.f; unsigned b16[8], k16[8];
#pragma unroll
                for (int t = 0; t < 16; ++t) { const float invt = __int_as_float(__builtin_amdgcn_readlane(__float_as_int(inv), t));
                    const float kf = __uint_as_float(kr[t] << 16), rf = __uint_as_float(rr[t] << 16), lw = __uint_as_float(lr[t] << 16), af = __uint_as_float(ar[t] << 16);
                    const float kk_ = kf * kkc * invt; L += lw; const float E = __expf(L), Einv = __builtin_amdgcn_rcpf(E);
                    const u16 At = bfc(-kk_ * Eprev), Rt = bfc(rf * E), Bt = bfc(kk_ * af * Einv), Kt = bfc(kf * (1.f + (af - 1.f) * kac) * Einv); Eprev = E;
                    constexpr int dummy = 0; (void)dummy;
                    const int ht = (t >> 2) & 1, et = ((t >> 3) & 1) * 4 + (t & 3);
                    *(LAS u16*)(sb + SL_AR + posj + 32 * t) = At; *(LAS u16*)(sb + SL_AR + posj + 32 * (16 + t)) = Rt;
                    *(LAS u16*)(sb + SL_BK + posj + 32 * t) = Bt; *(LAS u16*)(sb + SL_BK + posj + 32 * (16 + t)) = Kt;
                    if (t & 1) { b16[t >> 1] |= (unsigned)Bt << 16; k16[t >> 1] |= (unsigned)Kt << 16; } else { b16[t >> 1] = Bt; k16[t >> 1] = Kt; } (void)ht; (void)et; }
                *(LAS u32x4*)(sb + SL_BT + lane * 32) = (u32x4){b16[0], b16[1], b16[4], b16[5]}; *(LAS u32x4*)(sb + SL_BT + lane * 32 + 16) = (u32x4){b16[2], b16[3], b16[6], b16[7]};
                *(LAS u32x4*)(sb + SL_KT + lane * 32) = (u32x4){k16[0], k16[1], k16[4], k16[5]}; *(LAS u32x4*)(sb + SL_KT + lane * 32 + 16) = (u32x4){k16[2], k16[3], k16[6], k16[7]};
#undef PK16
                *(LAS float*)(sb + SL_WL + 4 * lane) = Eprev; }
            if (bt + nroles < nbatch) SC_LOAD(bt + nroles);
            asm volatile("s_waitcnt lgkmcnt(0)" ::: "memory");
            {   f32x16 M;
#pragma unroll
                for (int g = 0; g < 16; ++g) M[g] = 0.f;
#pragma unroll
                for (int q = 0; q < 4; ++q) { const bf16x8 a = *(const LAS bf16x8*)(sb + SL_AR + q * SL_QS + r * 32 + h * 16), bq = *(const LAS bf16x8*)(sb + SL_BK + q * SL_QS + r * 32 + h * 16); M = MFMA32(a, bq, M); }
                LAS float* Mf = (LAS float*)(sb + SL_BK);
                int rl = r, hl = h; asm volatile("" : "+v"(rl), "+v"(hl));
#pragma unroll
                for (int g = 0; g < 16; ++g) { const int tp = (g & 3) + 8 * (g >> 2) + 4 * hl, tt = tp & 15, ss = rl & 15; const bool keep = (tp < 16) ? (ss < tt) : (ss <= tt); Mf[tp * 32 + rl] = keep ? M[g] : 0.f; }
                asm volatile("s_waitcnt lgkmcnt(0)" ::: "memory");
                const int c = lane & 15, hc = (c >> 2) & 1, ec = ((c >> 3) & 1) * 4 + (c & 3); float x[16];
#pragma unroll
                for (int gq = 0; gq < 4; ++gq) { f32x4 mr[4][4];
#pragma unroll
                    for (int i = 0; i < 4; ++i)
#pragma unroll
                        for (int q4 = 0; q4 <= gq; ++q4) mr[i][q4] = *(const LAS f32x4*)(Mf + (4 * gq + i) * 32 + 4 * q4);
#pragma unroll
                    for (int i = 0; i < 4; ++i) { const int t = 4 * gq + i; float acc = (t == c) ? 1.f : 0.f;
#pragma unroll
                        for (int q4 = 0; q4 <= gq; ++q4)
#pragma unroll
                            for (int e = 0; e < 4; ++e) if (4 * q4 + e < t) acc += mr[i][q4][e] * x[4 * q4 + e];
                        x[t] = acc; if (lane < 16) *(LAS u16*)(sb + SL_T2 + (t * 2 + hc) * 16 + 2 * ec) = bfc(acc); } }
#pragma unroll
                for (int gq = 0; gq < 4; ++gq) { f32x4 mr[4][4];
#pragma unroll
                    for (int i = 0; i < 4; ++i)
#pragma unroll
                        for (int q4 = 0; q4 <= gq; ++q4) mr[i][q4] = *(const LAS f32x4*)(Mf + (16 + 4 * gq + i) * 32 + 4 * q4);
#pragma unroll
                    for (int i = 0; i < 4; ++i) { const int t = 4 * gq + i; float acc = 0.f;
#pragma unroll
                        for (int q4 = 0; q4 <= gq; ++q4)
#pragma unroll
                            for (int e = 0; e < 4; ++e) if (4 * q4 + e <= t) acc += mr[i][q4][e] * x[4 * q4 + e];
                        if (lane < 16) *(LAS u16*)(sb + SL_T2 + ((16 + t) * 2 + hc) * 16 + 2 * ec) = bfc(acc); } }
                {   const f32x4 m0 = *(const LAS f32x4*)(Mf + r * 32 + 16 + 4 * h), m1 = *(const LAS f32x4*)(Mf + r * 32 + 24 + 4 * h);
                    u32x4 w; w.x = pkc(m0.x, m0.y); w.y = pkc(m0.z, m0.w); w.z = pkc(m1.x, m1.y); w.w = pkc(m1.z, m1.w);
                    *(LAS u32x4*)(sb + SL_MK + (r * 2 + h) * 16) = w; }
            }
            SC_BAR();
            if (wave < 2) { const int ib = wave;
                if (nroles == 2 && bt > 0) {
                    unsigned* fl = hflag + (u * 2 + ib) * 16;
                    while (__hip_atomic_load(fl, __ATOMIC_RELAXED, __HIP_MEMORY_SCOPE_AGENT) < (unsigned)bt) __builtin_amdgcn_s_sleep(1);
                    const unsigned* sl = (const unsigned*)(hslot + (size_t)((u * 2 + ib) * 2 + (role ^ 1)) * 2048);
#pragma unroll
                    for (int g = 0; g < 16; ++g) { X0[g] = __uint_as_float(__hip_atomic_load(sl + g * 64 + lane, __ATOMIC_RELAXED, __HIP_MEMORY_SCOPE_AGENT)); X1[g] = __uint_as_float(__hip_atomic_load(sl + 1024 + g * 64 + lane, __ATOMIC_RELAXED, __HIP_MEMORY_SCOPE_AGENT)); } }
                for (int c2 = 0; c2 < 8; ++c2) { LAS unsigned char* s2 = lds + c2 * SL_SIZE;
                    const bf16x8 vfrag = *(const LAS bf16x8*)(s2 + SL_VT + (ib * 32 + r) * 32 + h * 16), mk = *(const LAS bf16x8*)(s2 + SL_MK + (r * 2 + h) * 16);
                    f32x16 out;
#pragma unroll
                    for (int g = 0; g < 16; ++g) out[g] = 0.f;
                    out = MFMA32(mk, vfrag, out);
                    out = MFMA32(*(const LAS bf16x8*)(s2 + SL_AR + 0 * SL_QS + r * 32 + h * 16), pack_lo(X0), out);
                    out = MFMA32(*(const LAS bf16x8*)(s2 + SL_AR + 1 * SL_QS + r * 32 + h * 16), pack_hi(X0), out);
                    out = MFMA32(*(const LAS bf16x8*)(s2 + SL_AR + 2 * SL_QS + r * 32 + h * 16), pack_lo(X1), out);
                    out = MFMA32(*(const LAS bf16x8*)(s2 + SL_AR + 3 * SL_QS + r * 32 + h * 16), pack_hi(X1), out);
                    f32x16 sat;
#pragma unroll
                    for (int g = 0; g < 16; ++g) sat[g] = 0.f;
                    sat = MFMA32(*(const LAS bf16x8*)(s2 + SL_T2 + (r * 2 + h) * 16), pack_lo(out), sat);
                    LAS float* yb = (LAS float*)(s2 + SL_BK);
#pragma unroll
                    for (int e = 0; e < 8; ++e) { const int tm = 8 * (e >> 2) + 4 * h + (e & 3); yb[tm * 64 + ib * 32 + r] = out[8 + e] + sat[8 + e]; }
                    const bf16x8 sfrag = pack_lo(sat);
                    X0 = MFMA32(*(const LAS bf16x8*)(s2 + SL_KT + r * 32 + h * 16), vfrag, X0);
                    X1 = MFMA32(*(const LAS bf16x8*)(s2 + SL_KT + (32 + r) * 32 + h * 16), vfrag, X1);
                    X0 = MFMA32(*(const LAS bf16x8*)(s2 + SL_BT + r * 32 + h * 16), sfrag, X0);
                    X1 = MFMA32(*(const LAS bf16x8*)(s2 + SL_BT + (32 + r) * 32 + h * 16), sfrag, X1);
#pragma unroll
                    for (int q4 = 0; q4 < 4; ++q4) { const f32x4 w0 = *(const LAS f32x4*)(s2 + SL_WL + (8 * q4 + 4 * h) * 4), w1 = *(const LAS f32x4*)(s2 + SL_WL + (32 + 8 * q4 + 4 * h) * 4);
#pragma unroll
                        for (int e = 0; e < 4; ++e) { X0[4 * q4 + e] *= w0[e]; X1[4 * q4 + e] *= w1[e]; } } }
                if (nroles == 2 && bt + 1 < nbatch) {
                    unsigned* sl = (unsigned*)(hslot + (size_t)((u * 2 + ib) * 2 + role) * 2048);
#pragma unroll
                    for (int g = 0; g < 16; ++g) { __hip_atomic_store(sl + g * 64 + lane, __float_as_uint(X0[g]), __ATOMIC_RELAXED, __HIP_MEMORY_SCOPE_AGENT); __hip_atomic_store(sl + 1024 + g * 64 + lane, __float_as_uint(X1[g]), __ATOMIC_RELAXED, __HIP_MEMORY_SCOPE_AGENT); }
                    asm volatile("s_waitcnt vmcnt(0)" ::: "memory");
                    if (lane == 0) __hip_atomic_store(hflag + (u * 2 + ib) * 16, (unsigned)(bt + 1), __ATOMIC_RELAXED, __HIP_MEMORY_SCOPE_AGENT); } }
            SC_BAR();
            int tf = tid; asm volatile("" : "+v"(tf));
#pragma unroll
            for (int k8 = 0; k8 < 8; ++k8) { const int idx = tf + 512 * k8, slot = idx >> 9, tm = (idx >> 5) & 15, cp = idx & 31; const int n = bt * 8 + slot;
                const int tl = z ? (T - 1 - (16 * n + tm)) : (16 * n + tm); unsigned* addr = (unsigned*)((char*)Y + (unsigned)((((int)seqbase + tl) * 1024 + hd * 64 + 2 * cp) * 2));
                const LAS float* yb = (const LAS float*)(lds + slot * SL_SIZE + SL_BK); *addr = pk2(yb[tm * 64 + 2 * cp], yb[tm * 64 + 2 * cp + 1]); }
            SC_BAR();
        }
#undef SC_LOAD
#undef SC_BAR
    }
}

enum { PH_PREP = 0, PH_L0_NORM, PH_L0_GEMM_IN, PH_L0_CONV_FFTA, PH_L0_GEMM_DFT, PH_L0_GEMM_OUT, PH_F0_NORM, PH_F0 = 7  , PH_L1 = 19  , PH_F1_NORM = 37, PH_F1 = 38  , PH_FINAL = 50, PH_COUNT = 51 };

__device__ __forceinline__ void ffn_phase(unsigned char* ws, unsigned char* ob, LAS unsigned char* lds, int l, int sub) {
    const int chunk = sub / 3, op = sub % 3;
    if (op == 0) { EpiPlain E{(u16*)(ws + OFF_U), 5632}; gemm_phase(lds, (const u16*)(ws + OFF_H) + (size_t)chunk * 16384 * 1024, 1024, (const u16*)(ws + OFF_WUP) + (size_t)l * 5632 * 1024, 1024, 64, 22, 1024, E); }
    else if (op == 1) act_phase(ws, ob, lds, l, chunk);
    else { EpiResid E{(u16*)(ws + OFF_X) + (size_t)chunk * 16384 * 1024}; gemm_phase(lds, (const u16*)(ob + OUT_ACT), 2816, (const u16*)(ws + OFF_WDN) + (size_t)l * 1024 * 2816, 2816, 64, 4, 2816, E); }
}

__global__ void __launch_bounds__(512, 2) mk_fwd(P p) {
    extern __shared__ __attribute__((aligned(16))) unsigned char smem[];
    LAS unsigned char* lds = (LAS unsigned char*)smem;
    if (threadIdx.x < 31) ((LAS unsigned long long*)(lds + LDS_TAB))[threadIdx.x] = (unsigned long long)p.in[threadIdx.x];
    if (threadIdx.x == 0) { volatile LAS unsigned* xst = (volatile LAS unsigned*)(lds + LDS_TAB + 256); xst[0] = 0u; xst[1] = 0u; xst[2] = 0u;
        (void)xb_add(&((unsigned*)(p.ws + OFF_BAR))[XB_XCNT(xb_xcc_id())], 1u); }
    __syncthreads();
    for (int ph = p.ph_lo; ph < p.ph_hi; ++ph) {
        size_t oz = 0; asm volatile("" : "+s"(oz));
        unsigned char* ws = p.ws + oz; unsigned char* ob = (unsigned char*)p.out + oz;
        if (TM(0) && ph == PH_PREP) { prep_phase(ws, ob, lds); __syncthreads(); norm0_phase(ws, ob, lds); }
        else if (ph == PH_L0_NORM) continue;
        else if (TM(2) && ph == PH_L0_GEMM_IN) {
            { EpiPlain E{(u16*)(ob + OUT_PROJ), 1536}; gemm_phase(lds, (const u16*)(ws + OFF_H), 1024, (const u16*)(ws + OFF_WC), 1024, 256, 6, 1024, E); }
            __syncthreads();
            { EpiPlain E{(u16*)(ob + OUT_FT), 65536}; gemm_phase(lds, (const u16*)(ws + OFF_WF), 1024, (const u16*)(ws + OFF_H), 1024, 2, 256, 1024, E); }
        }
        else if (TM(3) && ph == PH_L0_CONV_FFTA) { yconv_phase(ws, ob, lds); __syncthreads(); stageA_phase(ws, ob, lds); }
        else if (TM(4) && ph == PH_L0_GEMM_DFT) { EpiDft E{(u16*)(ws + OFF_CAT)}; gemm_phase(lds, (const u16*)(ws + OFF_DFTA), 512, (const u16*)(ws + OFF_YP), 512, 2, 512, 512, E); }
        else if (TM(5) && ph == PH_L0_GEMM_OUT) { EpiOut0 E{IN_G(0), IN_G(1), (u16*)(ws + OFF_X)}; gemm_phase(lds, (const u16*)(ws + OFF_CAT), 1536, (const u16*)(ws + OFF_WEFF), 1536, 256, 4, 1536, E); }
        else if (TM(6) && ph == PH_F0_NORM) normx_phase(ws, ob, IN(3), 0);
        else if (TM(7) && ph >= PH_F0 && ph < PH_F0 + 12) ffn_phase(ws, ob, lds, 0, ph - PH_F0);
        else if (TM(8) && ph >= PH_L1 && ph < PH_L1 + 18) { const int hf = (ph - PH_L1) / 9, op = (ph - PH_L1) % 9;
            if (TM(10) && op == 0) norm1_phase(ws, ob, lds, hf);
            else if (TM(11) && op == 1) {
                { EpiRkvP E{(u16*)(ob + OUT_RKV), (size_t)HT * 1024, (u16*)(ob + OUT_P)};
                    gemm_phase(lds, (const u16*)(ws + OFF_HH), 1024, (const u16*)(ws + OFF_WRKV), 1024, 128, 15, 1024, E, 2, (size_t)HT * 1024 * 2); }
            }
            else if (TM(12) && op == 2) lprep_phase(ws, ob, hf);
            else if (TM(13) && op == 3) { EpiUp2 E{(u16*)(ws + OFF_D4), IN(14), IN(17)}; gemm_phase(lds, (const u16*)(ws + OFF_L), 256, (const u16*)(ws + OFF_WUP2), 256, 128, 16, 256, E); }
            else if (TM(14) && op == 4) rwprep_phase(ws, ob, lds);
            else if (TM(15) && op == 5) scan_phase(ws, ob, lds, hf);
            else if (TM(16) && op == 6) { EpiPlain E{(u16*)(ws + OFF_G), 1024}; gemm_phase(lds, (const u16*)(ws + OFF_LG), 256, (const u16*)(ws + OFF_WG2), 256, 128, 4, 256, E); }
            else if (TM(17) && op == 7) gn_phase(ws, ob, lds);
            else if (TM(18)) { EpiResid E{(u16*)(ws + OFF_X) + (size_t)hf * HT * 1024}; gemm_phase(lds, (const u16*)(ws + OFF_YG), 1024, (const u16*)(ws + OFF_WO), 1024, 128, 4, 1024, E); }
        }
        else if (TM(6) && ph == PH_F1_NORM) normx_phase(ws, ob, IN(3) + 1024, 0);
        else if (TM(7) && ph >= PH_F1 && ph < PH_F1 + 12) ffn_phase(ws, ob, lds, 1, ph - PH_F1);
        else if (TM(9) && ph == PH_FINAL) normx_phase(ws, ob, IN(4), 1);
        if (ph + 1 < p.ph_hi) {
            if (p.ph_hi < 0) cg::this_grid().sync();
            grid_bar((unsigned*)(p.ws + OFF_BAR), (volatile LAS unsigned*)(lds + LDS_TAB + 256));
        }
    }
}

extern "C" void kernel_launch(void* const* d_in, const int* in_sizes, int n_in, void* d_out, int out_size, void* d_ws, size_t ws_size, hipStream_t stream) {
    static int grid = 0;
    if (grid == 0) {
        if (n_in != 31 || ws_size < WS_NEED || out_size != 65536 * 1024) { fprintf(stderr, "kernel_launch: unexpected shapes (n_in %d, ws %zu, out %d)\n", n_in, ws_size, out_size); grid = -1; return; }
        int dev = 0, cus = 0, per_cu = 0;
        hipGetDevice(&dev); hipDeviceGetAttribute(&cus, hipDeviceAttributeMultiprocessorCount, dev);
        if (hipFuncSetAttribute((const void*)mk_fwd, hipFuncAttributeMaxDynamicSharedMemorySize, LDS_BYTES) != hipSuccess) { fprintf(stderr, "kernel_launch: hipFuncSetAttribute failed\n"); grid = -1; return; }
        if (hipOccupancyMaxActiveBlocksPerMultiprocessor(&per_cu, (const void*)mk_fwd, 512, LDS_BYTES) != hipSuccess || per_cu < 1) { fprintf(stderr, "kernel_launch: occupancy query says %d\n", per_cu); per_cu = 1; }
        (void)hipGetLastError();
        grid = cus * per_cu;
    }
    if (grid < 0) return;
    if (hipMemsetAsync((unsigned char*)d_ws + OFF_BAR, 0, 16384 + 128 * 2 * 64, stream) != hipSuccess) { fprintf(stderr, "kernel_launch: memset failed\n"); return; }
    P p{};
    for (int i = 0; i < 31; ++i) p.in[i] = (const float*)d_in[i];
    p.out = (float*)d_out; p.ws = (unsigned char*)d_ws;
#if MK_PER_PHASE
    for (int ph = 0; ph < PH_COUNT; ++ph) { p.ph_lo = ph; p.ph_hi = ph + 1; hipLaunchKernelGGL(mk_fwd, dim3(grid), dim3(512), LDS_BYTES, stream, p); }
#else
    p.ph_lo = 0; p.ph_hi = PH_COUNT;
    void* args[] = {&p};
    hipError_t e = hipLaunchCooperativeKernel((const void*)mk_fwd, dim3(grid), dim3(512), args, LDS_BYTES, stream);
    if (e != hipSuccess) fprintf(stderr, "kernel_launch: cooperative launch failed: %s (grid %d)\n", hipGetErrorString(e), grid);
#endif
}
```

```cpp
#include <hip/hip_runtime.h>
#include <hip/hip_cooperative_groups.h>
#include <cstdio>
namespace cg = cooperative_groups;

#ifndef PROBE_DUP
#define PROBE_DUP 0
#define PROBE_LO 0
#define PROBE_HI 0
#endif
#ifndef MK_PER_PHASE
#define MK_PER_PHASE 0
#endif

#ifndef TESTMASK
#define TESTMASK 0xFFFFFFF
#endif
#define TM(k) ((TESTMASK >> (k)) & 1)
#define LAS __attribute__((address_space(3)))
typedef unsigned short u16;
typedef short bf16x8 __attribute__((ext_vector_type(8)));
typedef float f32x4 __attribute__((ext_vector_type(4)));
typedef unsigned u32x4 __attribute__((ext_vector_type(4)));
typedef unsigned u32x2 __attribute__((ext_vector_type(2)));

__device__ __forceinline__ int opaque_tid() { int t = threadIdx.x; asm volatile("" : "+v"(t)); return t; }
constexpr int LDS_BYTES = 160 * 1024;
constexpr int LDS_TAB = LDS_BYTES - 512;
__device__ __forceinline__ const float* in_ptr(LAS unsigned char* lds, int i) {
    const LAS unsigned* t = (const LAS unsigned*)(lds + LDS_TAB) + 2 * i; const unsigned lo = __builtin_amdgcn_readfirstlane(t[0]), hi = __builtin_amdgcn_readfirstlane(t[1]);
    return (const float*)(((unsigned long long)hi << 32) | lo); }
__device__ __forceinline__ const float* in_ptr_g(LAS unsigned char* lds, int i, const unsigned char* gbase) {
    const unsigned long long a = (unsigned long long)in_ptr(lds, i); return (const float*)(gbase + (long long)(a - (unsigned long long)gbase)); }
#define IN(i) in_ptr(lds, (i))
#define IN_G(i) in_ptr_g(lds, (i), ws)
constexpr size_t MiB = 1ull << 20;
constexpr int HT = 32768;
constexpr size_t OFF_WC = 0;
constexpr size_t OFF_WF = OFF_WC + 1536ull * 1024 * 2;
constexpr size_t OFF_WEFF = OFF_WF + 512ull * 1024 * 2;
constexpr size_t OFF_DFTA = OFF_WEFF + 1024ull * 1536 * 2;
constexpr size_t OFF_WUP = OFF_DFTA + 512ull * 512 * 2;
constexpr size_t OFF_WDN = OFF_WUP + 2ull * 5632 * 1024 * 2;
constexpr size_t OFF_WRKV = OFF_WDN + 2ull * 1024 * 2816 * 2;
constexpr size_t OFF_WLORA = OFF_WRKV + 3072ull * 1024 * 2;
constexpr size_t OFF_WRKV_END = OFF_WRKV + 3072ull * 2048 * 2;
constexpr size_t OFF_WUP2 = OFF_WRKV_END + 768ull * 1024 * 2;
constexpr size_t OFF_WG2 = OFF_WUP2 + 4096ull * 256 * 2;
constexpr size_t OFF_WO = OFF_WG2 + 1024ull * 256 * 2;
constexpr size_t OFF_WEND = OFF_WO + 1024ull * 1024 * 2;
static_assert(OFF_WEND <= 60 * MiB, "weights region");
constexpr size_t OFF_X = 64 * MiB;
constexpr size_t OFF_R0 = 192 * MiB;
constexpr size_t WS_NEED = 512 * MiB;
constexpr size_t OFF_H = OFF_R0;
constexpr size_t OFF_YP = OFF_R0;
constexpr size_t OFF_CAT = OFF_R0 + 128 * MiB;
constexpr size_t OUT_PROJ = 0;
constexpr size_t OUT_FT = 192 * MiB;
constexpr size_t OFF_U = OFF_R0 + 128 * MiB;
constexpr size_t OUT_ACT = 0;
constexpr size_t OFF_HH = OFF_R0;
constexpr size_t OUT_RKV = 0;
constexpr size_t OUT_P = 192 * MiB;
constexpr size_t OUT_Y = 192 * MiB;
constexpr size_t OFF_D4 = OFF_R0;
constexpr size_t OFF_L = OFF_R0 + 256 * MiB;
constexpr size_t OFF_LG = OFF_R0 + 272 * MiB;
constexpr size_t OFF_INV = OFF_R0 + 288 * MiB;
constexpr size_t OFF_BON = OFF_R0 + 290 * MiB;
constexpr size_t OFF_G = OFF_R0;
constexpr size_t OFF_YG = OFF_R0 + 64 * MiB;

constexpr size_t OFF_HSLOT = 60 * MiB;
constexpr size_t OFF_BAR = 59 * MiB;
struct P { const float* in[31]; float* out; unsigned char* ws; int ph_lo, ph_hi; };

__device__ __forceinline__ float bflo(unsigned w) { return __uint_as_float(w << 16); }
__device__ __forceinline__ float bfhi(unsigned w) { return __uint_as_float(w & 0xffff0000u); }
__device__ __forceinline__ float bf2f(u16 v) { return __uint_as_float((unsigned)v << 16); }
__device__ __forceinline__ unsigned pk2(float lo, float hi) { unsigned r; asm("v_cvt_pk_bf16_f32 %0, %1, %2" : "=v"(r) : "v"(lo), "v"(hi)); return r; }
__device__ __forceinline__ u16 f2bf(float v) { return (u16)(pk2(v, 0.f) & 0xffffu); }
__device__ __forceinline__ u32x4 pk8(const float* v) { u32x4 o; o.x = pk2(v[0], v[1]); o.y = pk2(v[2], v[3]); o.z = pk2(v[4], v[5]); o.w = pk2(v[6], v[7]); return o; }
__device__ __forceinline__ void unpk8(u32x4 w, float* v) { v[0] = bflo(w.x); v[1] = bfhi(w.x); v[2] = bflo(w.y); v[3] = bfhi(w.y); v[4] = bflo(w.z); v[5] = bfhi(w.z); v[6] = bflo(w.w); v[7] = bfhi(w.w); }
#define DPP_ADD(v, ctrl) v += __int_as_float(__builtin_amdgcn_update_dpp(0, __float_as_int(v), ctrl, 0xF, 0xF, true))
__device__ __forceinline__ float allreduce16(float v) { DPP_ADD(v, 0xB1); DPP_ADD(v, 0x4E); DPP_ADD(v, 0x141); DPP_ADD(v, 0x140); return v; }
__device__ __forceinline__ float wave_sum(float v) {
    v = allreduce16(v);
    const float a = __int_as_float(__builtin_amdgcn_readlane(__float_as_int(v), 0)), b = __int_as_float(__builtin_amdgcn_readlane(__float_as_int(v), 16)),
                c = __int_as_float(__builtin_amdgcn_readlane(__float_as_int(v), 32)), d = __int_as_float(__builtin_amdgcn_readlane(__float_as_int(v), 48));
    return (a + b) + (c + d); }
__device__ __forceinline__ float allreduce4(float v) { DPP_ADD(v, 0xB1); DPP_ADD(v, 0x4E); return v; }
__device__ __forceinline__ float sigmoidf_(float x) { return __builtin_amdgcn_rcpf(1.f + __expf(-x)); }
__device__ __forceinline__ int seqT(int t) { return t < HT ? 4096 : 8192; }

#define XB_XCNT(j)  (256  + 64 * (j))
#define XB_XSUB(j)  (1280 + 64 * (j))
#define XB_XGEN(j)  (2304 + 64 * (j))
#define XB_TOP      3328
#define XB_TOPGEN   3392
#define XCD_BAR_WORDS 3456
__device__ __forceinline__ unsigned xb_ld(unsigned* p)              { return __hip_atomic_load(p, __ATOMIC_RELAXED, __HIP_MEMORY_SCOPE_AGENT); }
__device__ __forceinline__ unsigned xb_add(unsigned* p, unsigned v) { return __hip_atomic_fetch_add(p, v, __ATOMIC_RELAXED, __HIP_MEMORY_SCOPE_AGENT); }
__device__ __forceinline__ unsigned xb_xcc_id() { return (unsigned)__builtin_amdgcn_s_getreg((3 << 11) | 20) & 0xFu; }
__device__ __forceinline__ void grid_bar(unsigned* bar, volatile LAS unsigned* st) {
    asm volatile("s_waitcnt vmcnt(0)" ::: "memory");
    __syncthreads();
    if (threadIdx.x == 0) {
        __builtin_amdgcn_s_waitcnt(0);
        const unsigned x = xb_xcc_id();
        unsigned nloc = st[0], nx = st[1]; const unsigned gen = st[2]; st[2] = gen + 1u;
        if (nloc == 0u) {
            for (;;) { unsigned sum = 0u, cnt = 0u, mine = 0u;
#pragma unroll 1
                for (unsigned j = 0; j < 16; ++j) { const unsigned c = xb_ld(&bar[XB_XCNT(j)]); sum += c; cnt += (c > 0u) ? 1u : 0u; mine = (j == x) ? c : mine; }
                if (sum == gridDim.x) { nloc = mine; nx = cnt; break; }
                __builtin_amdgcn_s_sleep(1); }
            st[0] = nloc; st[1] = nx; }
        const unsigned old = xb_add(&bar[XB_XSUB(x)], 1u);
        if (old + 1u == (gen + 1u) * nloc) {
            __builtin_amdgcn_fence(__ATOMIC_RELEASE, "agent");
            asm volatile("s_waitcnt vmcnt(0)" ::: "memory");
            const unsigned og = xb_add(&bar[XB_TOP], 1u);
            if (og + 1u == (gen + 1u) * nx) xb_add(&bar[XB_TOPGEN], 1u);
            else while (xb_ld(&bar[XB_TOPGEN]) == gen) __builtin_amdgcn_s_sleep(1);
            __builtin_amdgcn_fence(__ATOMIC_ACQUIRE, "agent");
            xb_add(&bar[XB_XGEN(x)], 1u);
            asm volatile("s_waitcnt vmcnt(0)" ::: "memory");
        } else {
            while (xb_ld(&bar[XB_XGEN(x)]) == gen) __builtin_amdgcn_s_sleep(1);
            __builtin_amdgcn_fence(__ATOMIC_ACQUIRE, "agent");
            asm volatile("s_waitcnt vmcnt(0)" ::: "memory");
        }
    }
    __syncthreads();
}
constexpr int HTB = 128 * 64 * 2;
__device__ __forceinline__ int lds_byte(int r, int c) { const int st = (r >> 4) * 2 + (c >> 5), rr = r & 15, cc = c & 31, ob = rr * 64 + cc * 2; return st * 1024 + (ob ^ (((ob >> 9) & 1) << 5)); }
__device__ __forceinline__ void stage_rc(int b, int& R, int& C) { const int st = b / 1024, sb = b % 1024, swz = sb ^ (((sb >> 9) & 1) << 5); R = (st >> 1) * 16 + swz / 64; C = (st & 1) * 32 + (swz % 64) / 2; }
__device__ __forceinline__ int perm32(int rho) { const int n = rho >> 4, i = rho & 15; return 8 * (i >> 2) + 4 * n + (i & 3); }
struct Unit { int pm, pn; };
__device__ __forceinline__ bool next_unit(int i, int nM, int nN, Unit& u) {
    const int nwg = nM * nN; const long L = (long)i * (long)gridDim.x + blockIdx.x; if (L >= nwg) return false;
    int wgid = (int)L; { const int q = nwg / 8, r = nwg % 8, xcd = wgid % 8, off = wgid / 8; wgid = (xcd < r ? xcd * (q + 1) : r * (q + 1) + (xcd - r) * q) + off; }
    const int nig = 8 * nN, gid = wgid / nig, fm = gid * 8, gsz = (nM - fm) < 8 ? (nM - fm) : 8;
    u.pm = fm + ((wgid % nig) % gsz); u.pn = (wgid % nig) / gsz; return true;
}

template <class Epi>
__device__ __forceinline__ void gemm_phase(LAS unsigned char* lds, const u16* A, int lda, const u16* Bt, int ldb, int nM, int nN, int K, const Epi& E, int ashift = 31, size_t astride = 0) {
    int tid = opaque_tid();
    const int wid = __builtin_amdgcn_readfirstlane(tid >> 6), lane = tid & 63, wr = wid >> 2, wc = wid & 3, fr = lane & 15, fq = lane >> 4;
    const int nt = K / 64;
    unsigned voffA[2], voffB[2];
#pragma unroll
    for (int i = 0; i < 2; ++i) { int R, C; stage_rc(tid * 16 + i * 8192, R, C); const int Rb = (R & ~31) + perm32(R & 31);
        voffA[i] = (unsigned)(R * lda + C) * 2u; voffB[i] = (unsigned)(Rb * ldb + C) * 2u; }
    const size_t kstep = 128;
    const size_t hstepA = (size_t)128 * lda * 2, hstepB = (size_t)128 * ldb * 2, tstepA = 2 * hstepA, tstepB = 2 * hstepB;
    const unsigned ldsw = (unsigned)wid * 1024u;
    const int aoff = lds_byte(wr * 64 + fr, fq * 8), boff = lds_byte(wc * 32 + fr, fq * 8);
#define G_SA(b, h) (((b) * 2 + (h)) * HTB)
#define G_SB(b, h) ((4 + (b) * 2 + (h)) * HTB)
#define G_STAGE(bufoff, gbase, voff) do { _Pragma("unroll") for (int _i = 0; _i < 2; ++_i) \
        __builtin_amdgcn_global_load_lds((const unsigned*)((const char*)(gbase) + (voff)[_i]), (LAS unsigned*)(lds + (bufoff) + ldsw + _i * 8192), 16, 0, 0); } while (0)
#define G_LDA(dst, b, h) do { _Pragma("unroll") for (int m = 0; m < 4; ++m) _Pragma("unroll") for (int k = 0; k < 2; ++k) dst[m][k] = *(const LAS bf16x8*)(lds + G_SA(b, h) + aoff + m * 2048 + k * 1024); } while (0)
#define G_LDB(dst, b, h) do { _Pragma("unroll") for (int n = 0; n < 2; ++n) _Pragma("unroll") for (int k = 0; k < 2; ++k) dst[n][k] = *(const LAS bf16x8*)(lds + G_SB(b, h) + boff + n * 2048 + k * 1024); } while (0)
#define G_MMA(ai, bj, At, Bt_) do { __builtin_amdgcn_s_setprio(1); _Pragma("unroll") for (int m = 0; m < 4; ++m) _Pragma("unroll") for (int n = 0; n < 2; ++n) _Pragma("unroll") for (int k = 0; k < 2; ++k) \
        acc[ai][bj][m][n] = __builtin_amdgcn_mfma_f32_16x16x32_bf16(Bt_[n][k], At[m][k], acc[ai][bj][m][n], 0, 0, 0); __builtin_amdgcn_s_setprio(0); } while (0)
#define G_WAIT_V(n) asm volatile("s_waitcnt vmcnt(" #n ")" ::: "memory")
#define G_WAIT_L(n) asm volatile("s_waitcnt lgkmcnt(" #n ")" ::: "memory")
#define G_BAR __builtin_amdgcn_s_barrier()
#define G_SCHED __builtin_amdgcn_sched_barrier(0)
    Unit cur, nxt; int ui = 0;
    if (!next_unit(0, nM, nN, cur)) return;
    f32x4 acc[2][2][4][2];
#pragma unroll
    for (int a = 0; a < 2; ++a)
#pragma unroll
        for (int b = 0; b < 2; ++b)
#pragma unroll
            for (int m = 0; m < 4; ++m)
#pragma unroll
                for (int n = 0; n < 2; ++n) acc[a][b][m][n] = (f32x4){0.f, 0.f, 0.f, 0.f};
    bf16x8 At[4][2], B0[2][2], B1[2][2];
    const char* cA = (const char*)A + (size_t)(cur.pn >> ashift) * astride + (size_t)cur.pm * tstepA; const char* cB = (const char*)Bt + (size_t)cur.pn * tstepB;
    G_STAGE(G_SB(0, 0), cB, voffB); G_STAGE(G_SA(0, 0), cA, voffA); G_STAGE(G_SB(0, 1), cB + hstepB, voffB); G_STAGE(G_SA(0, 1), cA + hstepA, voffA);
    if (wr == 1) G_BAR;
    G_WAIT_V(4); G_BAR;
    G_STAGE(G_SB(1, 0), cB + kstep, voffB); G_STAGE(G_SA(1, 0), cA + kstep, voffA); G_STAGE(G_SB(1, 1), cB + hstepB + kstep, voffB);
    G_WAIT_V(6); G_BAR;
    for (;;) {
        const bool has_next = next_unit(ui + 1, nM, nN, nxt);
        const char* nA = has_next ? (const char*)A + (size_t)(nxt.pn >> ashift) * astride + (size_t)nxt.pm * tstepA : cA; const char* nB = has_next ? (const char*)Bt + (size_t)nxt.pn * tstepB : cB;
        for (int t = 0; t < nt; t += 2) {
            const bool last = (t == nt - 2);
            const char* a1 = cA + (size_t)(t + 1) * kstep;
            const char* a2 = last ? nA : cA + (size_t)(t + 2) * kstep; const char* b2 = last ? nB : cB + (size_t)(t + 2) * kstep;
            const char* a3 = a2 + kstep; const char* b3 = b2 + kstep;
            G_LDB(B0, 0, 0); G_SCHED; G_LDA(At, 0, 0); G_STAGE(G_SA(1, 1), a1 + hstepA, voffA);
            G_WAIT_L(8); G_BAR; G_WAIT_L(0); G_MMA(0, 0, At, B0); G_BAR; G_SCHED;
            G_LDB(B1, 0, 1); G_STAGE(G_SB(0, 0), b2, voffB);
            G_BAR; G_WAIT_L(0); G_MMA(0, 1, At, B1); G_BAR;
            G_LDA(At, 0, 1); G_STAGE(G_SA(0, 0), a2, voffA);
            G_BAR; G_WAIT_L(0); G_MMA(1, 0, At, B0); G_BAR; G_SCHED;
            G_STAGE(G_SB(0, 1), b2 + hstepB, voffB);
            G_WAIT_V(6); G_BAR; G_MMA(1, 1, At, B1); G_BAR;
            G_LDB(B0, 1, 0); G_SCHED; G_LDA(At, 1, 0); G_STAGE(G_SA(0, 1), a2 + hstepA, voffA);
            G_WAIT_L(8); G_BAR; G_WAIT_L(0); G_MMA(0, 0, At, B0); G_BAR; G_SCHED;
            G_LDB(B1, 1, 1); G_STAGE(G_SB(1, 0), b3, voffB);
            G_BAR; G_WAIT_L(0); G_MMA(0, 1, At, B1); G_BAR;
            G_LDA(At, 1, 1); G_STAGE(G_SA(1, 0), a3, voffA);
            G_BAR; G_WAIT_L(0); G_MMA(1, 0, At, B0); G_BAR; G_SCHED;
            G_STAGE(G_SB(1, 1), b3 + hstepB, voffB);
            G_WAIT_V(6); G_BAR; G_MMA(1, 1, At, B1); G_BAR;
        }
        {
            const int row0 = cur.pm * 256 + wr * 64 + fr, col0 = cur.pn * 256 + wc * 32 + 8 * fq;
            if constexpr (Epi::PRE == 1) {
#pragma unroll
                for (int ai = 0; ai < 2; ++ai) { u32x4 pre[8];
#pragma unroll
                    for (int m = 0; m < 4; ++m)
#pragma unroll
                        for (int bj = 0; bj < 2; ++bj) pre[m * 2 + bj] = E.pre(row0 + ai * 128 + m * 16, col0 + bj * 128);
#pragma unroll
                    for (int m = 0; m < 4; ++m)
#pragma unroll
                        for (int bj = 0; bj < 2; ++bj) E.store(row0 + ai * 128 + m * 16, col0 + bj * 128, acc[ai][bj][m][0], acc[ai][bj][m][1], pre[m * 2 + bj]); } }
            else if constexpr (Epi::PRE == 2) {
#pragma unroll
                for (int bj = 0; bj < 2; ++bj) { f32x4 cb0, cb1; E.cpre(col0 + bj * 128, cb0, cb1);
#pragma unroll
                    for (int ai = 0; ai < 2; ++ai)
#pragma unroll
                        for (int m = 0; m < 4; ++m) E.store(row0 + ai * 128 + m * 16, col0 + bj * 128, acc[ai][bj][m][0], acc[ai][bj][m][1], cb0, cb1); } }
            else if constexpr (Epi::PRE == 3) {
#pragma unroll
                for (int ai = 0; ai < 2; ++ai)
#pragma unroll
                    for (int mp = 0; mp < 2; ++mp) { f32x4 pa[4], pb[4];
#pragma unroll
                        for (int mm = 0; mm < 2; ++mm)
#pragma unroll
                            for (int bj = 0; bj < 2; ++bj) E.pre2(row0 + ai * 128 + (2 * mp + mm) * 16, col0 + bj * 128, pa[mm * 2 + bj], pb[mm * 2 + bj]);
#pragma unroll
                        for (int mm = 0; mm < 2; ++mm)
#pragma unroll
                            for (int bj = 0; bj < 2; ++bj) E.store(row0 + ai * 128 + (2 * mp + mm) * 16, col0 + bj * 128, acc[ai][bj][2 * mp + mm][0], acc[ai][bj][2 * mp + mm][1], pa[mm * 2 + bj], pb[mm * 2 + bj]); } }
            else {
#pragma unroll
                for (int ai = 0; ai < 2; ++ai)
#pragma unroll
                    for (int m = 0; m < 4; ++m)
#pragma unroll
                        for (int bj = 0; bj < 2; ++bj) E.store(row0 + ai * 128 + m * 16, col0 + bj * 128, acc[ai][bj][m][0], acc[ai][bj][m][1]); }
        }
        if (!has_next) break;
#pragma unroll
        for (int a = 0; a < 2; ++a)
#pragma unroll
            for (int b = 0; b < 2; ++b)
#pragma unroll
                for (int m = 0; m < 4; ++m)
#pragma unroll
                    for (int n = 0; n < 2; ++n) acc[a][b][m][n] = (f32x4){0.f, 0.f, 0.f, 0.f};
        cur = nxt; cA = nA; cB = nB; ++ui;
    }
    G_WAIT_V(0);
    if (wr == 0) G_BAR;
    G_BAR;
#undef G_SA
#undef G_SB
#undef G_STAGE
#undef G_LDA
#undef G_LDB
#undef G_MMA
#undef G_WAIT_V
#undef G_WAIT_L
#undef G_BAR
#undef G_SCHED
}

__device__ __forceinline__ u32x4 pkv(f32x4 v0, f32x4 v1) { u32x4 w; w.x = pk2(v0.x, v0.y); w.y = pk2(v0.z, v0.w); w.z = pk2(v1.x, v1.y); w.w = pk2(v1.z, v1.w); return w; }
struct EpiPlain { static constexpr int PRE = 0; u16* O; size_t ld;
    __device__ __forceinline__ void store(int row, int col, f32x4 v0, f32x4 v1) const { *(u32x4*)(O + (size_t)row * ld + col) = pkv(v0, v1); } };
struct EpiSplit { static constexpr int PRE = 0; u16* O; size_t stride;
    __device__ __forceinline__ void store(int row, int col, f32x4 v0, f32x4 v1) const { const int t = col >> 10; *(u32x4*)(O + (size_t)t * stride + (size_t)row * 1024 + (col & 1023)) = pkv(v0, v1); } };
struct EpiRkvP { static constexpr int PRE = 0; u16* O; size_t stride; u16* Pb;
    __device__ __forceinline__ void store(int row, int col, f32x4 v0, f32x4 v1) const { const int t = col >> 10;
        u16* dst = (t < 3) ? O + (size_t)t * stride + (size_t)row * 1024 + (col & 1023) : Pb + (size_t)row * 768 + (col - 3072);
        *(u32x4*)dst = pkv(v0, v1); } };
struct EpiDft { static constexpr int PRE = 0; u16* CAT;
    __device__ __forceinline__ void store(int row, int col, f32x4 v0, f32x4 v1) const {
        const int ri = row >> 8, k1 = row & 255; int tok;
        if (col < 65536) { const int b = col >> 13, k2 = (col >> 9) & 15; tok = b * 4096 + k1 * 16 + k2; }
        else { const int n2 = col - 65536; const int b = n2 >> 14, k2 = (n2 >> 9) & 31; tok = HT + b * 8192 + k1 * 32 + k2; }
        const int ch = col & 511;
        *(u32x4*)(CAT + (size_t)tok * 1536 + 512 + ri * 512 + ch) = pkv(v0, v1); } };
struct EpiOut0 { static constexpr int PRE = 3; const float* xp; const float* xs; u16* X;
    __device__ __forceinline__ void pre2(int row, int col, f32x4& a, f32x4& b) const {
        const float* src = (row < HT ? xp + (size_t)row * 1024 : xs + (size_t)(row - HT) * 1024) + col; a = *(const f32x4*)src; b = *(const f32x4*)(src + 4); }
    __device__ __forceinline__ void store(int row, int col, f32x4 v0, f32x4 v1, f32x4 a, f32x4 b) const { *(u32x4*)(X + (size_t)row * 1024 + col) = pkv(a + v0, b + v1); } };
struct EpiResid { static constexpr int PRE = 1; u16* X;
    __device__ __forceinline__ u32x4 pre(int row, int col) const { return *(const u32x4*)(X + (size_t)row * 1024 + col); }
    __device__ __forceinline__ void store(int row, int col, f32x4 v0, f32x4 v1, u32x4 w) const {
        f32x4 a = {bflo(w.x), bfhi(w.x), bflo(w.y), bfhi(w.y)}, b = {bflo(w.z), bfhi(w.z), bflo(w.w), bfhi(w.w)};
        *(u32x4*)(X + (size_t)row * 1024 + col) = pkv(a + v0, b + v1); } };
struct EpiUp2 { static constexpr int PRE = 2; u16* D4; const float* w0; const float* a0;
    __device__ __forceinline__ void cpre(int col, f32x4& b0, f32x4& b1) const { const int gi = col >> 10, c = col & 1023; const float* bias = (gi < 2 ? w0 + gi * 1024 : a0 + (gi - 2) * 1024) + c; b0 = *(const f32x4*)bias; b1 = *(const f32x4*)(bias + 4); }
    __device__ __forceinline__ void store(int row, int col, f32x4 v0, f32x4 v1, f32x4 b0, f32x4 b1) const {
        const int gi = col >> 10, c = col & 1023; const float sc = gi < 2 ? -0.60653066f : 1.f; f32x4 x0 = v0 + b0, x1 = v1 + b1;
#pragma unroll
        for (int j = 0; j < 4; ++j) { x0[j] = sc * __builtin_amdgcn_rcpf(1.f + __expf(-x0[j])); x1[j] = sc * __builtin_amdgcn_rcpf(1.f + __expf(-x1[j])); }
        *(u32x4*)(D4 + (size_t)gi * ((size_t)HT * 1024) + (size_t)row * 1024 + c) = pkv(x0, x1); } };
struct Job { const float* src; const float* vec; u16* dst; int ldsrc, lddst, K, N; float c0, c1; };
__device__ __forceinline__ bool get_job(unsigned char* ws, unsigned char* ob, LAS unsigned char* lds, int j, Job& jb) {
    jb.vec = nullptr; jb.c0 = 1.f; jb.c1 = 0.f;
    if (j == 0) { jb.src = IN(5); jb.ldsrc = 2048; jb.dst = (u16*)(ws + OFF_WC); jb.lddst = 1024; jb.K = 1024; jb.N = 1536; return true; }
    if (j == 1) { jb.src = IN(5) + 1536; jb.ldsrc = 2048; jb.dst = (u16*)(ws + OFF_WF); jb.lddst = 1024; jb.K = 1024; jb.N = 512; return true; }
    if (j == 2) { jb.src = IN(7); jb.ldsrc = 1024; jb.dst = (u16*)(ws + OFF_WEFF); jb.lddst = 1536; jb.K = 512; jb.N = 1024; return true; }
    if (j < 5) { const int l = j - 3; jb.src = IN(27) + (size_t)l * 1024 * 5632; jb.ldsrc = 5632; jb.dst = (u16*)(ws + OFF_WUP) + (size_t)l * 5632 * 1024; jb.lddst = 1024; jb.K = 1024; jb.N = 5632; return true; }
    if (j < 7) { const int l = j - 5; jb.src = IN(30) + (size_t)l * 2816 * 1024; jb.ldsrc = 1024; jb.dst = (u16*)(ws + OFF_WDN) + (size_t)l * 1024 * 2816; jb.lddst = 2816; jb.K = 2816; jb.N = 1024; return true; }
    if (j < 10) { const int q = j - 7; jb.src = IN(10 + q); jb.ldsrc = 1024; jb.dst = (u16*)(ws + OFF_WRKV) + (size_t)q * 1024 * 1024; jb.lddst = 1024; jb.K = 1024; jb.N = 1024; return true; }
    if (j < 13) { jb.src = IN(10); jb.ldsrc = 1024; jb.dst = (u16*)(ws + OFF_WRKV); jb.lddst = 1024; jb.K = 0; jb.N = 32; return true; }
    if (j < 21) { const int i = (j - 13) >> 1, part = (j - 13) & 1, z = i & 1, which = i >> 1; jb.src = IN(which ? 18 : 15) + (size_t)z * 1024 * 64; jb.ldsrc = 64; jb.vec = IN(9) + (z * 2 + which) * 1024;
        jb.c0 = part ? 0.f : 1.f; jb.c1 = part ? 1.f : -1.f; jb.dst = (u16*)(ws + OFF_WLORA) + (size_t)(i * 128 + part * 64) * 1024; jb.lddst = 1024; jb.K = 1024; jb.N = 64; return true; }
    if (j < 23) { const int part = j - 21; jb.src = IN(20); jb.ldsrc = 128; jb.vec = IN(8) + 3 * 1024; jb.c0 = part ? 0.f : 1.f; jb.c1 = part ? 0.5f : -1.f;
        jb.dst = (u16*)(ws + OFF_WLORA) + (size_t)(512 + part * 128) * 1024; jb.lddst = 1024; jb.K = 1024; jb.N = 128; return true; }
    if (j == 23) { jb.src = IN(13); jb.ldsrc = 1024; jb.dst = (u16*)(ws + OFF_WO); jb.lddst = 1024; jb.K = 1024; jb.N = 1024; return true; }
    return false;
}
__device__ __forceinline__ void tr_item(const Job& jb, LAS float* scr, int item, int lane) {
    const int nblk = jb.N / 32, kb = item / nblk, nb = item % nblk, k0 = 64 * kb, n0 = 32 * nb;
#pragma unroll 8
    for (int i = 0; i < 32; ++i) { const int kk = 2 * i + (lane >> 5); const float s = jb.vec ? jb.c0 + jb.c1 * jb.vec[k0 + kk] : 1.f;
        scr[kk * 33 + (lane & 31)] = jb.src[(size_t)(k0 + kk) * jb.ldsrc + n0 + (lane & 31)] * s; }
    asm volatile("s_waitcnt lgkmcnt(0)" ::: "memory");
    const int c = lane & 7;
#pragma unroll
    for (int j = 0; j < 4; ++j) { const int n = (lane >> 3) + 8 * j; const LAS float* s = scr + (8 * c) * 33 + n;
        u32x4 o; o.x = pk2(s[0 * 33], s[1 * 33]); o.y = pk2(s[2 * 33], s[3 * 33]); o.z = pk2(s[4 * 33], s[5 * 33]); o.w = pk2(s[6 * 33], s[7 * 33]);
        *(u32x4*)(jb.dst + (size_t)(n0 + n) * jb.lddst + k0 + 8 * c) = o; }
    asm volatile("s_waitcnt lgkmcnt(0)" ::: "memory");
}
__device__ __forceinline__ void prep_phase(unsigned char* ws, unsigned char* ob, LAS unsigned char* lds) {
    const int tid = opaque_tid(), lane = tid & 63, wave = tid >> 6;
    LAS float* scr = (LAS float*)(lds + wave * 16384);
    const int gw = blockIdx.x * 8 + wave, NGW = gridDim.x * 8;
    int base = 0;
    for (int j = 0; j < 24; ++j) { Job jb; get_job(ws, ob, lds, j, jb); const int cnt = (jb.K / 64) * (jb.N / 32);
        int first = (gw - base % NGW + NGW) % NGW;
        for (int it = first; it < cnt; it += NGW) tr_item(jb, scr, it, lane);
        base += cnt; }
    const size_t gt = (size_t)blockIdx.x * 512 + tid, NT = (size_t)gridDim.x * 512;
    {
        u16* WE = (u16*)(ws + OFF_WEFF); const float* wo = IN(7);
        for (size_t i = gt; i < 512ull * 1024; i += NT) { const int d = (int)(i & 1023), gc = (int)(i >> 10), g = gc >> 7, c = gc & 127;
            float sr = 0.f, si = 0.f;
            for (int c2 = 0; c2 < 128; ++c2) { const float fr = (float)((c * c2) & 127) * (1.f / 128.f); const float w = wo[(size_t)(512 + 128 * g + c2) * 1024 + d];
                sr += __builtin_amdgcn_cosf(fr) * w; si += __builtin_amdgcn_sinf(fr) * w; }
            WE[(size_t)d * 1536 + 512 + gc] = f2bf(sr * 0.08838834764f); WE[(size_t)d * 1536 + 1024 + gc] = f2bf(si * 0.08838834764f); }
    }
    {
        u16* DA = (u16*)(ws + OFF_DFTA);
        for (size_t i = gt; i < 512ull * 512; i += NT) { const int kk = (int)(i & 511), m = (int)(i >> 9); const int rio = m >> 8, k1 = m & 255, rii = kk >> 8, t1 = kk & 255;
            const float fr = (float)((k1 * t1) & 255) * (1.f / 256.f); const float c = __builtin_amdgcn_cosf(fr), s = __builtin_amdgcn_sinf(fr);
            DA[i] = f2bf(rio == rii ? c : (rio == 0 ? s : -s)); }
    }
    {
        u16* W2 = (u16*)(ws + OFF_WUP2);
        for (size_t i = gt; i < 4096ull * 256; i += NT) { const int k = (int)(i & 255), n = (int)(i >> 8), gi = n >> 10, c = n & 1023; float v = 0.f;
            if ((k >> 6) == gi) { const int z = gi & 1; const float* src = (gi < 2 ? IN(16) : IN(19)) + (size_t)z * 64 * 1024; v = src[(size_t)(k & 63) * 1024 + c]; }
            W2[i] = f2bf(v); }
        u16* WG = (u16*)(ws + OFF_WG2);
        for (size_t i = gt; i < 1024ull * 256; i += NT) { const int k = (int)(i & 255), n = (int)(i >> 8); WG[i] = f2bf(k < 128 ? IN(21)[(size_t)k * 1024 + n] : 0.f); }
    }
}

__device__ __forceinline__ void load_row_bf(const u16* row, int lane, float* v) { unpk8(*(const u32x4*)(row + 8 * lane), v); unpk8(*(const u32x4*)(row + 512 + 8 * lane), v + 8); }
__device__ __forceinline__ float rstd_of(const float* v) { float s = 0.f;
#pragma unroll
    for (int j = 0; j < 16; ++j) s += v[j] * v[j];
    return 1.f / sqrtf(wave_sum(s) * (1.f / 1024.f) + 1e-6f); }
__device__ __forceinline__ void norm0_phase(unsigned char* ws, unsigned char* ob, LAS unsigned char* lds) {
    const int tix = opaque_tid(); const int lane = tix & 63, gw = blockIdx.x * 8 + (tix >> 6), NGW = gridDim.x * 8;
    u16* H = (u16*)(ws + OFF_H); const float* g = IN(2);
    f32x4 gv[4];
#pragma unroll
    for (int j = 0; j < 4; ++j) gv[j] = *(const f32x4*)(g + 4 * lane + 256 * j);
    const float* xp0 = IN_G(0); const float* xs0 = IN_G(1);
    for (int t = gw; t < 65536; t += NGW) { const float* xr = t < HT ? xp0 + (size_t)t * 1024 : xs0 + (size_t)(t - HT) * 1024;
        f32x4 v[4]; float s = 0.f;
#pragma unroll
        for (int j = 0; j < 4; ++j) { v[j] = *(const f32x4*)(xr + 4 * lane + 256 * j); s += v[j].x * v[j].x + v[j].y * v[j].y + v[j].z * v[j].z + v[j].w * v[j].w; }
        const float r = 1.f / sqrtf(wave_sum(s) * (1.f / 1024.f) + 1e-6f);
#pragma unroll
        for (int j = 0; j < 4; ++j) { const f32x4 o = v[j] * r * gv[j]; u32x2 w; w.x = pk2(o.x, o.y); w.y = pk2(o.z, o.w); *(u32x2*)(H + (size_t)t * 1024 + 4 * lane + 256 * j) = w; } }
}
__device__ __forceinline__ void normx_phase(unsigned char* ws, unsigned char* ob, const float* g, int mode) {
    const int tix = opaque_tid(); const int lane = tix & 63, gw = blockIdx.x * 8 + (tix >> 6), NGW = gridDim.x * 8;
    const u16* X = (const u16*)(ws + OFF_X); u16* H = (u16*)(ws + OFF_H);
    float gv[16];
#pragma unroll
    for (int j = 0; j < 2; ++j)
#pragma unroll
        for (int e = 0; e < 8; ++e) gv[8 * j + e] = g[8 * lane + 512 * j + e];
    for (int t = gw; t < 65536; t += NGW) { float v[16]; load_row_bf(X + (size_t)t * 1024, lane, v); const float r = rstd_of(v);
#pragma unroll
        for (int j = 0; j < 16; ++j) v[j] = v[j] * r * gv[j];
        if (mode == 0) { *(u32x4*)(H + (size_t)t * 1024 + 8 * lane) = pk8(v); *(u32x4*)(H + (size_t)t * 1024 + 512 + 8 * lane) = pk8(v + 8); }
        else { float* o = ((float*)ob) + (size_t)t * 1024;
#pragma unroll
            for (int j = 0; j < 2; ++j) { *(f32x4*)(o + 8 * lane + 512 * j) = (f32x4){v[8 * j], v[8 * j + 1], v[8 * j + 2], v[8 * j + 3]}; *(f32x4*)(o + 8 * lane + 512 * j + 4) = (f32x4){v[8 * j + 4], v[8 * j + 5], v[8 * j + 6], v[8 * j + 7]}; } } }
}
__device__ __forceinline__ void norm1_phase(unsigned char* ws, unsigned char* ob, LAS unsigned char* lds, int hf) {
    const int tix = opaque_tid(); const int lane = tix & 63, gw = blockIdx.x * 8 + (tix >> 6), NGW = gridDim.x * 8;
    const u16* X = (const u16*)(ws + OFF_X) + (size_t)hf * HT * 1024; u16* XO = (u16*)(ws + OFF_HH); const float* g = IN(2) + 1024; const float* mu = IN(8);
    const int T = hf ? 8192 : 4096;
    float gv[16], m1[3][16], m2[3][16];
#pragma unroll
    for (int j = 0; j < 2; ++j)
#pragma unroll
        for (int e = 0; e < 8; ++e) { gv[8 * j + e] = g[8 * lane + 512 * j + e];
#pragma unroll
            for (int q = 0; q < 3; ++q) { const float mm = mu[q * 1024 + 8 * lane + 512 * j + e]; m1[q][8 * j + e] = 1.f - mm; m2[q][8 * j + e] = 0.5f * mm; } }
    for (int r0 = gw * 8; r0 < HT; r0 += NGW * 8) {
        const int pos0 = r0 & (T - 1);
        float pv[16], cv[16], nv[16];
        if (pos0 > 0) { load_row_bf(X + (size_t)(r0 - 1) * 1024, lane, pv); const float r = rstd_of(pv);
#pragma unroll
            for (int j = 0; j < 16; ++j) pv[j] = pv[j] * r * gv[j]; }
        else {
#pragma unroll
            for (int j = 0; j < 16; ++j) pv[j] = 0.f; }
        { load_row_bf(X + (size_t)r0 * 1024, lane, cv); const float r = rstd_of(cv);
#pragma unroll
            for (int j = 0; j < 16; ++j) cv[j] = cv[j] * r * gv[j]; }
        u32x4 nq0 = *(const u32x4*)(X + (size_t)(r0 + 1) * 1024 + 8 * lane), nq1 = *(const u32x4*)(X + (size_t)(r0 + 1) * 1024 + 512 + 8 * lane);
#pragma unroll 2
        for (int i = 0; i < 8; ++i) { const int t = r0 + i; const bool hn = (pos0 + i) < T - 1;
            if (hn) { unpk8(nq0, nv); unpk8(nq1, nv + 8); const float r = rstd_of(nv);
#pragma unroll
                for (int j = 0; j < 16; ++j) nv[j] = nv[j] * r * gv[j]; }
            else {
#pragma unroll
                for (int j = 0; j < 16; ++j) nv[j] = 0.f; }
            if (i < 7 && (pos0 + i + 1) < T - 1) { nq0 = *(const u32x4*)(X + (size_t)(t + 2) * 1024 + 8 * lane); nq1 = *(const u32x4*)(X + (size_t)(t + 2) * 1024 + 512 + 8 * lane); }
            u16* o = XO + (size_t)t * 1024;
#pragma unroll
            for (int q = 0; q < 3; ++q) { float m[16];
#pragma unroll
                for (int j = 0; j < 16; ++j) m[j] = cv[j] * m1[q][j] + m2[q][j] * (pv[j] + nv[j]);
                *(u32x4*)(o + (size_t)q * HT * 1024 + 8 * lane) = pk8(m); *(u32x4*)(o + (size_t)q * HT * 1024 + 512 + 8 * lane) = pk8(m + 8); }
            *(u32x4*)(o + 3ull * HT * 1024 + 8 * lane) = pk8(cv); *(u32x4*)(o + 3ull * HT * 1024 + 512 + 8 * lane) = pk8(cv + 8);
#pragma unroll
            for (int j = 0; j < 16; ++j) { pv[j] = cv[j]; cv[j] = nv[j]; } } }
}

__device__ __forceinline__ void yconv_phase(unsigned char* ws, unsigned char* ob, LAS unsigned char* lds) {
    const int tix = opaque_tid(); const int lane = tix & 63, gw = blockIdx.x * 8 + (tix >> 6), NGW = gridDim.x * 8;
    const u16* PR = (const u16*)(ob + OUT_PROJ); u16* CAT = (u16*)(ws + OFF_CAT); const float* cw = IN(6);
    float w[3][8];
#pragma unroll
    for (int j = 0; j < 3; ++j)
#pragma unroll
        for (int e = 0; e < 8; ++e) w[j][e] = cw[j * 512 + 8 * lane + e];
    for (int t = gw; t < 65536; t += NGW) { const int T = seqT(t), pos = t & (T - 1);
        float acc[8], gb[8];
#pragma unroll
        for (int e = 0; e < 8; ++e) acc[e] = 0.f;
#pragma unroll
        for (int j = 0; j < 3; ++j) { const int pp = pos + j - 1; if (pp < 0 || pp >= T) continue;
            const u16* r = PR + (size_t)(t + j - 1) * 1536 + 8 * lane; float a[8], b[8]; unpk8(*(const u32x4*)(r + 512), a); unpk8(*(const u32x4*)(r + 1024), b);
#pragma unroll
            for (int e = 0; e < 8; ++e) acc[e] += w[j][e] * a[e] * b[e]; }
        unpk8(*(const u32x4*)(PR + (size_t)t * 1536 + 8 * lane), gb);
#pragma unroll
        for (int e = 0; e < 8; ++e) acc[e] *= gb[e];
        *(u32x4*)(CAT + (size_t)t * 1536 + 8 * lane) = pk8(acc); }
}
template <int T2>
__device__ __forceinline__ void stageA_item(const u16* FT, u16* YP, int tokbase, size_t nbase, int ch, int t1) {
    constexpr float C32[32] = {1.000000000f, 0.980785280f, 0.923879533f, 0.831469612f, 0.707106781f, 0.555570233f, 0.382683432f, 0.195090322f, 0.000000000f, -0.195090322f, -0.382683432f, -0.555570233f, -0.707106781f, -0.831469612f, -0.923879533f, -0.980785280f, -1.000000000f, -0.980785280f, -0.923879533f, -0.831469612f, -0.707106781f, -0.555570233f, -0.382683432f, -0.195090322f, -0.000000000f, 0.195090322f, 0.382683432f, 0.555570233f, 0.707106781f, 0.831469612f, 0.923879533f, 0.980785280f};
    constexpr float S32[32] = {0.000000000f, 0.195090322f, 0.382683432f, 0.555570233f, 0.707106781f, 0.831469612f, 0.923879533f, 0.980785280f, 1.000000000f, 0.980785280f, 0.923879533f, 0.831469612f, 0.707106781f, 0.555570233f, 0.382683432f, 0.195090322f, 0.000000000f, -0.195090322f, -0.382683432f, -0.555570233f, -0.707106781f, -0.831469612f, -0.923879533f, -0.980785280f, -1.000000000f, -0.980785280f, -0.923879533f, -0.831469612f, -0.707106781f, -0.555570233f, -0.382683432f, -0.195090322f};
    float xv[T2];
#pragma unroll
    for (int t2 = 0; t2 < T2; ++t2) xv[t2] = bf2f(FT[(size_t)ch * 65536 + tokbase + t1 + 256 * t2]);
    const float invs = 1.f / sqrtf((float)(256 * T2));
#pragma unroll
    for (int k2 = 0; k2 <= T2 / 2; ++k2) { float yr = 0.f, yi = 0.f;
#pragma unroll
        for (int t2 = 0; t2 < T2; ++t2) { const int j = ((k2 * t2) & (T2 - 1)) * (32 / T2); yr += xv[t2] * C32[j]; yi -= xv[t2] * S32[j]; }
#pragma unroll
        for (int mir = 0; mir < 2; ++mir) { const int kk = mir ? T2 - k2 : k2; if (mir && (k2 == 0 || k2 == T2 / 2)) continue; const float yim = mir ? -yi : yi;
            const float fr = (float)(kk * t1) * (1.f / (256.f * T2)); const float c = __builtin_amdgcn_cosf(fr), sn = __builtin_amdgcn_sinf(fr);
            u16* o = YP + (nbase + (size_t)kk * 512 + ch) * 512 + t1;
            o[0] = f2bf((yr * c + yim * sn) * invs); o[256] = f2bf((yim * c - yr * sn) * invs); } }
}
__device__ __forceinline__ void stageA_phase(unsigned char* ws, unsigned char* ob, LAS unsigned char* lds) {
    const int tid = opaque_tid();
    const u16* FT = (const u16*)(ob + OUT_FT); u16* YP = (u16*)(ws + OFF_YP);
    for (int it = blockIdx.x; it < 12 * 256; it += gridDim.x) { const int sq = it >> 8, ch = 2 * (it & 255) + (tid >> 8), t1 = tid & 255;
        if (sq < 8) stageA_item<16>(FT, YP, sq * 4096, (size_t)sq * 16 * 512, ch, t1);
        else stageA_item<32>(FT, YP, HT + (sq - 8) * 8192, 65536 + (size_t)(sq - 8) * 32 * 512, ch, t1); }
}

__device__ __forceinline__ void act_phase(unsigned char* ws, unsigned char* ob, LAS unsigned char* lds, int l, int chunk) {
    const u16* U = (const u16*)(ws + OFF_U); u16* ACT = (u16*)(ob + OUT_ACT);
    const float* cw = IN(28) + (size_t)l * 3 * 5632; const float* cb = IN(29) + (size_t)l * 5632;
    const size_t gt = (size_t)blockIdx.x * 512 + opaque_tid(), NT = (size_t)gridDim.x * 512;
    for (size_t i = gt; i < 1024ull * 352; i += NT) {
        const int rbk = (int)(i / 352), c = 8 * (int)(i % 352), row0 = rbk * 16; const int tg0 = chunk * 16384 + row0, T = seqT(tg0), pos0 = tg0 & (T - 1);
        float wg[3][8], wv[3][8], bg[8], bv[8];
#pragma unroll
        for (int j = 0; j < 3; ++j) { const f32x4 a0 = *(const f32x4*)(cw + j * 5632 + c), a1 = *(const f32x4*)(cw + j * 5632 + c + 4), b0 = *(const f32x4*)(cw + j * 5632 + 2816 + c), b1 = *(const f32x4*)(cw + j * 5632 + 2816 + c + 4);
            wg[j][0] = a0.x; wg[j][1] = a0.y; wg[j][2] = a0.z; wg[j][3] = a0.w; wg[j][4] = a1.x; wg[j][5] = a1.y; wg[j][6] = a1.z; wg[j][7] = a1.w;
            wv[j][0] = b0.x; wv[j][1] = b0.y; wv[j][2] = b0.z; wv[j][3] = b0.w; wv[j][4] = b1.x; wv[j][5] = b1.y; wv[j][6] = b1.z; wv[j][7] = b1.w; }
        { const f32x4 a0 = *(const f32x4*)(cb + c), a1 = *(const f32x4*)(cb + c + 4), b0 = *(const f32x4*)(cb + 2816 + c), b1 = *(const f32x4*)(cb + 2816 + c + 4);
            bg[0] = a0.x; bg[1] = a0.y; bg[2] = a0.z; bg[3] = a0.w; bg[4] = a1.x; bg[5] = a1.y; bg[6] = a1.z; bg[7] = a1.w;
            bv[0] = b0.x; bv[1] = b0.y; bv[2] = b0.z; bv[3] = b0.w; bv[4] = b1.x; bv[5] = b1.y; bv[6] = b1.z; bv[7] = b1.w; }
        float pg[8], pv[8], cg_[8], cv[8];
        const u16* r = U + (size_t)row0 * 5632 + c;
        u32x4 bufg[2][4], bufv[2][4];
        const bool tail_ok = pos0 + 16 < T;
#define ACT_LOAD(g_, b_) do { _Pragma("unroll") for (int k = 0; k < 4; ++k) { const int rn = 4 * (g_) + k + 1; \
            if (rn < 16 || tail_ok) { bufg[b_][k] = *(const u32x4*)(r + (size_t)rn * 5632); bufv[b_][k] = *(const u32x4*)(r + (size_t)rn * 5632 + 2816); } \
            else { bufg[b_][k] = (u32x4){0u, 0u, 0u, 0u}; bufv[b_][k] = (u32x4){0u, 0u, 0u, 0u}; } } } while (0)
        ACT_LOAD(0, 0);
        if (pos0 > 0) { unpk8(*(const u32x4*)(r - 5632), pg); unpk8(*(const u32x4*)(r - 5632 + 2816), pv); }
        else {
#pragma unroll
            for (int e = 0; e < 8; ++e) { pg[e] = 0.f; pv[e] = 0.f; } }
        unpk8(*(const u32x4*)r, cg_); unpk8(*(const u32x4*)(r + 2816), cv);
#pragma unroll
        for (int g = 0; g < 4; ++g) {
            if (g < 3) ACT_LOAD(g + 1, (g + 1) & 1);
#pragma unroll
            for (int k = 0; k < 4; ++k) { float ng[8], nv[8], o[8]; unpk8(bufg[g & 1][k], ng); unpk8(bufv[g & 1][k], nv);
#pragma unroll
                for (int e = 0; e < 8; ++e) { const float gg = bg[e] + wg[0][e] * pg[e] + wg[1][e] * cg_[e] + wg[2][e] * ng[e]; const float v = bv[e] + wv[0][e] * pv[e] + wv[1][e] * cv[e] + wv[2][e] * nv[e];
                    o[e] = gg * sigmoidf_(gg) * v; pg[e] = cg_[e]; pv[e] = cv[e]; cg_[e] = ng[e]; cv[e] = nv[e]; }
                *(u32x4*)(ACT + (size_t)(row0 + 4 * g + k) * 2816 + c) = pk8(o); } }
#undef ACT_LOAD
    }
}

__device__ __forceinline__ void lprep_phase(unsigned char* ws, unsigned char* ob, int hf) {
    const int tix = opaque_tid(); const int lane = tix & 63, gw = blockIdx.x * 8 + (tix >> 6), NGW = gridDim.x * 8;
    const u16* PB = (const u16*)(ob + OUT_P); u16* L = (u16*)(ws + OFF_L); u16* LG = (u16*)(ws + OFF_LG);
    const int T = hf ? 8192 : 4096;
    for (int t = gw; t < HT; t += NGW) { const int pos = t & (T - 1); const u16* r = PB + (size_t)t * 768; float a[8], b[8];
        if (lane < 32) { const int i = lane >> 3, r0 = (lane & 7) * 8, sh = (i & 1) ? 1 : -1; const bool ok = (i & 1) ? (pos < T - 1) : (pos > 0);
            unpk8(*(const u32x4*)(r + i * 128 + r0), a);
            if (ok) { unpk8(*(const u32x4*)(r + sh * 768 + i * 128 + 64 + r0), b);
#pragma unroll
                for (int e = 0; e < 8; ++e) a[e] += b[e]; }
            if (i < 2) {
#pragma unroll
                for (int e = 0; e < 8; ++e) a[e] = 1.f - 2.f * __builtin_amdgcn_rcpf(1.f + __expf(2.f * a[e])); }
            *(u32x4*)(L + (size_t)t * 256 + 8 * lane) = pk8(a); }
        else if (lane < 48) { const int r0 = (lane - 32) * 8; unpk8(*(const u32x4*)(r + 512 + r0), a);
            if (pos > 0) { unpk8(*(const u32x4*)(r - 768 + 640 + r0), b);
#pragma unroll
                for (int e = 0; e < 8; ++e) a[e] += b[e]; }
            if (pos < T - 1) { unpk8(*(const u32x4*)(r + 768 + 640 + r0), b);
#pragma unroll
                for (int e = 0; e < 8; ++e) a[e] += b[e]; }
#pragma unroll
            for (int e = 0; e < 8; ++e) a[e] = sigmoidf_(a[e]);
            *(u32x4*)(LG + (size_t)t * 256 + r0) = pk8(a); }
        else { unsigned zz = 0u; asm volatile("" : "+v"(zz)); *(u32x4*)(LG + (size_t)t * 256 + 128 + (lane - 48) * 8) = (u32x4){zz, zz, zz, zz}; } }
}
__device__ __forceinline__ void rwprep_phase(unsigned char* ws, unsigned char* ob, LAS unsigned char* lds) {
    const int tix = opaque_tid(); const int lane = tix & 63, gw = blockIdx.x * 8 + (tix >> 6), NGW = gridDim.x * 8;
    const u16* R = (const u16*)(ob + OUT_RKV); const u16* Kp = R + (size_t)HT * 1024;
    const u16* A0 = (const u16*)(ws + OFF_D4) + 2ull * HT * 1024; const u16* A1 = A0 + (size_t)HT * 1024;
    float* INV = (float*)(ws + OFF_INV); float* BON = (float*)(ws + OFF_BON);
    const float* kkp = IN(22) + 16 * lane; const float* kap = IN(23) + 16 * lane; const float* rkp = IN(24) + 16 * lane;
    float kk[16], ka[16], rk[16];
#pragma unroll
    for (int e = 0; e < 16; ++e) { kk[e] = kkp[e]; ka[e] = kap[e]; rk[e] = rkp[e]; }
    for (int t0 = gw; t0 < HT; t0 += 2 * NGW) {
        u32x4 q[2][8];
#pragma unroll
        for (int u2 = 0; u2 < 2; ++u2) { const int t = t0 + u2 * NGW; if (t < HT) { const size_t o = (size_t)t * 1024 + 16 * lane;
            q[u2][0] = *(const u32x4*)(Kp + o); q[u2][1] = *(const u32x4*)(Kp + o + 8); q[u2][2] = *(const u32x4*)(R + o); q[u2][3] = *(const u32x4*)(R + o + 8);
            q[u2][4] = *(const u32x4*)(A0 + o); q[u2][5] = *(const u32x4*)(A0 + o + 8); q[u2][6] = *(const u32x4*)(A1 + o); q[u2][7] = *(const u32x4*)(A1 + o + 8); } }
#pragma unroll
        for (int u2 = 0; u2 < 2; ++u2) { const int t = t0 + u2 * NGW; if (t < HT) { float k[16], r[16], a0[16], a1[16];
            unpk8(q[u2][0], k); unpk8(q[u2][1], k + 8); unpk8(q[u2][2], r); unpk8(q[u2][3], r + 8); unpk8(q[u2][4], a0); unpk8(q[u2][5], a0 + 8); unpk8(q[u2][6], a1); unpk8(q[u2][7], a1 + 8);
            float ss = 0.f, bn = 0.f;
#pragma unroll
            for (int e = 0; e < 16; ++e) { const float qq = k[e] * kk[e]; ss += qq * qq; bn += r[e] * k[e] * rk[e] * (2.f + (a0[e] + a1[e] - 2.f) * ka[e]); }
            ss = allreduce4(ss); bn = allreduce4(bn);
            if ((lane & 3) == 0) { INV[(size_t)t * 16 + (lane >> 2)] = 1.f / fmaxf(sqrtf(ss), 1e-12f); BON[(size_t)t * 16 + (lane >> 2)] = bn; } } } }
}
__device__ __forceinline__ void gn_phase(unsigned char* ws, unsigned char* ob, LAS unsigned char* lds) {
    const int tix = opaque_tid(); const int lane = tix & 63, gw = blockIdx.x * 8 + (tix >> 6), NGW = gridDim.x * 8;
    const u16* Y = (const u16*)(ob + OUT_Y); const u16* V = (const u16*)(ob + OUT_RKV) + 2ull * HT * 1024;
    const u16* G = (const u16*)(ws + OFF_G); u16* YG = (u16*)(ws + OFF_YG); const float* BON = (const float*)(ws + OFF_BON); const u16* YB = (const u16*)(ws + OFF_D4) + 3ull * HT * 1024;
    float gw_[16], gb_[16];
#pragma unroll
    for (int e = 0; e < 16; ++e) { gw_[e] = IN(25)[16 * lane + e]; gb_[e] = IN(26)[16 * lane + e]; }
    for (int t0 = gw; t0 < HT; t0 += 2 * NGW) {
        u32x4 q[2][8]; float bnv[2] = {0.f, 0.f};
#pragma unroll
        for (int u2 = 0; u2 < 2; ++u2) { const int t = t0 + u2 * NGW; if (t < HT) { const size_t o = (size_t)t * 1024 + 16 * lane;
            q[u2][0] = *(const u32x4*)(Y + o); q[u2][1] = *(const u32x4*)(Y + o + 8); q[u2][2] = *(const u32x4*)(YB + o); q[u2][3] = *(const u32x4*)(YB + o + 8);
            q[u2][4] = *(const u32x4*)(V + o); q[u2][5] = *(const u32x4*)(V + o + 8); q[u2][6] = *(const u32x4*)(G + o); q[u2][7] = *(const u32x4*)(G + o + 8); bnv[u2] = BON[(size_t)t * 16 + (lane >> 2)]; } }
#pragma unroll
        for (int u2 = 0; u2 < 2; ++u2) { const int t = t0 + u2 * NGW; if (t < HT) { const size_t o = (size_t)t * 1024 + 16 * lane; float y[16], yb[16], v[16], g[16];
            unpk8(q[u2][0], y); unpk8(q[u2][1], y + 8); unpk8(q[u2][2], yb); unpk8(q[u2][3], yb + 8); unpk8(q[u2][4], v); unpk8(q[u2][5], v + 8); unpk8(q[u2][6], g); unpk8(q[u2][7], g + 8);
            float s = 0.f;
#pragma unroll
            for (int e = 0; e < 16; ++e) { y[e] += yb[e]; s += y[e]; }
            const float mean = allreduce4(s) * (1.f / 64.f); float qv = 0.f;
#pragma unroll
            for (int e = 0; e < 16; ++e) { y[e] -= mean; qv += y[e] * y[e]; }
            const float rstd = 1.f / sqrtf(allreduce4(qv) * (1.f / 64.f) + 64e-5f); const float bn = bnv[u2];
#pragma unroll
            for (int e = 0; e < 16; ++e) y[e] = (y[e] * rstd * gw_[e] + gb_[e] + bn * v[e]) * g[e];
            *(u32x4*)(YG + o) = pk8(y); *(u32x4*)(YG + o + 8) = pk8(y + 8); } } }
}

typedef float f32x16 __attribute__((ext_vector_type(16)));
#define MFMA32(a, b, c) __builtin_amdgcn_mfma_f32_32x32x16_bf16((a), (b), (c), 0, 0, 0)
__device__ __forceinline__ unsigned pkc(float lo, float hi) { typedef __bf16 bf2 __attribute__((ext_vector_type(2))); typedef float f2 __attribute__((ext_vector_type(2))); const f2 v = {lo, hi}; const bf2 b = __builtin_convertvector(v, bf2); return __builtin_bit_cast(unsigned, b); }
__device__ __forceinline__ u16 bfc(float v) { return (u16)(pkc(v, 0.f) & 0xffffu); }
__device__ __forceinline__ bf16x8 pack_lo(const f32x16& x) { u32x4 p; p.x = pkc(x[0], x[1]); p.y = pkc(x[2], x[3]); p.z = pkc(x[4], x[5]); p.w = pkc(x[6], x[7]); return __builtin_bit_cast(bf16x8, p); }
__device__ __forceinline__ bf16x8 pack_hi(const f32x16& x) { u32x4 p; p.x = pkc(x[8], x[9]); p.y = pkc(x[10], x[11]); p.z = pkc(x[12], x[13]); p.w = pkc(x[14], x[15]); return __builtin_bit_cast(bf16x8, p); }
constexpr int SL_QS = 1056;
constexpr int SL_AR = 0, SL_BK = 4 * SL_QS, SL_BT = 8 * SL_QS, SL_KT = SL_BT + 2048, SL_VT = SL_KT + 2048, SL_MK = SL_VT + 2048, SL_T2 = SL_MK + 1024, SL_WL = SL_T2 + 1024, SL_SIZE = SL_WL + 256;
static_assert(SL_VT >= 10240 && 8 * SL_SIZE <= LDS_TAB, "scan slot layout");
__device__ __forceinline__ void scan_phase(unsigned char* ws, unsigned char* ob, LAS unsigned char* lds, int hf) {
    const int T = hf ? 8192 : 4096, nunits = (hf ? 4 : 8) * 16 * 2, nblk = T / 16, nbatch = nblk / 8;
    const int tid = opaque_tid(), lane = tid & 63, wave = __builtin_amdgcn_readfirstlane(tid >> 6), r = lane & 31, h = lane >> 5;
    const u16* R = (const u16*)(ob + OUT_RKV); const u16* Kp = R + (size_t)HT * 1024; const u16* V = Kp + (size_t)HT * 1024;
    const u16* D4 = (const u16*)(ws + OFF_D4); const float* INV = (const float*)(ws + OFF_INV);
    const int ci = wave;
    const int jb = lane >> 5, jl = lane & 31, js = jl >> 4, jh = (jl >> 2) & 1, je = ((jl >> 3) & 1) * 4 + (jl & 3);
    const unsigned posj = (unsigned)((jb * 2 + js) * SL_QS + jh * 16 + je * 2);
    LAS unsigned char* sb = lds + wave * SL_SIZE;
#define SC_BAR() do { asm volatile("s_waitcnt lgkmcnt(0)" ::: "memory"); __builtin_amdgcn_s_barrier(); asm volatile("" ::: "memory"); } while (0)
    const int nroles = (hf && gridDim.x >= 256) ? 2 : 1;
    const int bx = blockIdx.x, role = nroles == 2 ? ((bx >> 3) & 1) : 0, u0 = nroles == 2 ? (((bx >> 4) << 3) | (bx & 7)) : bx;
    unsigned* hflag = (unsigned*)(ws + OFF_BAR + 16384); float* hslot = (float*)(ws + OFF_HSLOT);
    for (int u = u0; u < nunits; u += (nroles == 2 ? 1 << 30 : (int)gridDim.x)) {
        if (nroles == 2 && bx >= 256) break;
        const int z = u & 1, hd = (u >> 1) & 15, b = u >> 5; const size_t seqbase = (size_t)b * T;
        u16* Y = z ? (u16*)(ws + OFF_D4) + 3ull * HT * 1024 : (u16*)(ob + OUT_Y);
        const float kkc = IN(22)[hd * 64 + lane], kac = IN(23)[hd * 64 + lane];
        f32x16 X0, X1;
#pragma unroll
        for (int g = 0; g < 16; ++g) { X0[g] = 0.f; X1[g] = 0.f; }
        const unsigned lanepart = (unsigned)((hd * 64 + 8 * (lane & 7)) * 2); const u16* Dz = D4 + (size_t)z * HT * 1024; const u16* Az = D4 + (size_t)(2 + z) * HT * 1024;
        u32x4 graw[5][2]; float inv = 0.f;
#define SC_LOAD(bt_) do { int nb_ = (bt_); asm volatile("" : "+s"(nb_)); const int n_ = nb_ * 8 + ci;     \
            _Pragma("unroll") for (int i2 = 0; i2 < 2; ++i2) { const int t_ = (lane >> 3) + 8 * i2; const int tl_ = z ? (T - 1 - (16 * n_ + t_)) : (16 * n_ + t_); \
                const unsigned off_ = (unsigned)(((int)seqbase + tl_) * 2048) + lanepart;            \
                graw[0][i2] = *(const u32x4*)((const char*)R + off_); graw[1][i2] = *(const u32x4*)((const char*)Kp + off_); graw[2][i2] = *(const u32x4*)((const char*)V + off_); \
                graw[3][i2] = *(const u32x4*)((const char*)Dz + off_); graw[4][i2] = *(const u32x4*)((const char*)Az + off_); } \
            { const int t_ = lane & 15; const int tl_ = z ? (T - 1 - (16 * n_ + t_)) : (16 * n_ + t_); inv = *(const float*)((const char*)INV + (unsigned)((((int)seqbase + tl_) * 16 + hd) * 4)); } } while (0)
        SC_LOAD(role);
        __syncthreads();
        for (int bt = role; bt < nbatch; bt += nroles) {
            {
#pragma unroll
                for (int a5 = 0; a5 < 5; ++a5) { *(LAS u32x4*)(sb + a5 * 2048 + lane * 16) = graw[a5][0]; *(LAS u32x4*)(sb + a5 * 2048 + 1024 + lane * 16) = graw[a5][1]; }
                asm volatile("s_waitcnt lgkmcnt(0)" ::: "memory");
                unsigned rr[16], kr[16], lr[16], ar[16], vr[16];
#pragma unroll
                for (int t = 0; t < 16; ++t) { rr[t] = *(const LAS u16*)(sb + 0 * 2048 + t * 128 + 2 * lane); kr[t] = *(const LAS u16*)(sb + 1 * 2048 + t * 128 + 2 * lane); vr[t] = *(const LAS u16*)(sb + 2 * 2048 + t * 128 + 2 * lane);
                    lr[t] = *(const LAS u16*)(sb + 3 * 2048 + t * 128 + 2 * lane); ar[t] = *(const LAS u16*)(sb + 4 * 2048 + t * 128 + 2 * lane); }
                asm volatile("s_waitcnt lgkmcnt(0)" ::: "memory");
#define PK16(a_, t0_) ((a_)[t0_] | ((a_)[(t0_) + 1] << 16))
                *(LAS u32x4*)(sb + SL_VT + lane * 32) = (u32x4){PK16(vr, 0), PK16(vr, 2), PK16(vr, 8), PK16(vr, 10)}; *(LAS u32x4*)(sb + SL_VT + lane * 32 + 16) = (u32x4){PK16(vr, 4), PK16(vr, 6), PK16(vr, 12), PK16(vr, 14)};
                float L = 0.f, Eprev = 1.f; unsigned b16[8], k16[8];
#pragma unroll
                for (int t = 0; t < 16; ++t) { const float invt = __int_as_float(__builtin_amdgcn_readlane(__float_as_int(inv), t));
                    const float kf = __uint_as_float(kr[t] << 16), rf = __uint_as_float(rr[t] << 16), lw = __uint_as_float(lr[t] << 16), af = __uint_as_float(ar[t] << 16);
                    const float kk_ = kf * kkc * invt; L += lw; const float E = __expf(L), Einv = __builtin_amdgcn_rcpf(E);
                    const u16 At = bfc(-kk_ * Eprev), Rt = bfc(rf * E), Bt = bfc(kk_ * af * Einv), Kt = bfc(kf * (1.f + (af - 1.f) * kac) * Einv); Eprev = E;
                    constexpr int dummy = 0; (void)dummy;
                    const int ht = (t >> 2) & 1, et = ((t >> 3) & 1) * 4 + (t & 3);
                    *(LAS u16*)(sb + SL_AR + posj + 32 * t) = At; *(LAS u16*)(sb + SL_AR + posj + 32 * (16 + t)) = Rt;
                    *(LAS u16*)(sb + SL_BK + posj + 32 * t) = Bt; *(LAS u16*)(sb + SL_BK + posj + 32 * (16 + t)) = Kt;
                    if (t & 1) { b16[t >> 1] |= (unsigned)Bt << 16; k16[t >> 1] |= (unsigned)Kt << 16; } else { b16[t >> 1] = Bt; k16[t >> 1] = Kt; } (void)ht; (void)et; }
                *(LAS u32x4*)(sb + SL_BT + lane * 32) = (u32x4){b16[0], b16[1], b16[4], b16[5]}; *(LAS u32x4*)(sb + SL_BT + lane * 32 + 16) = (u32x4){b16[2], b16[3], b16[6], b16[7]};
                *(LAS u32x4*)(sb + SL_KT + lane * 32) = (u32x4){k16[0], k16[1], k16[4], k16[5]}; *(LAS u32x4*)(sb + SL_KT + lane * 32 + 16) = (u32x4){k16[2], k16[3], k16[6], k16[7]};
#undef PK16
                *(LAS float*)(sb + SL_WL + 4 * lane) = Eprev; }
            if (bt + nroles < nbatch) SC_LOAD(bt + nroles);
            asm volatile("s_waitcnt lgkmcnt(0)" ::: "memory");
            {   f32x16 M;
#pragma unroll
                for (int g = 0; g < 16; ++g) M[g] = 0.f;
#pragma unroll
                for (int q = 0; q < 4; ++q) { const bf16x8 a = *(const LAS bf16x8*)(sb + SL_AR + q * SL_QS + r * 32 + h * 16), bq = *(const LAS bf16x8*)(sb + SL_BK + q * SL_QS + r * 32 + h * 16); M = MFMA32(a, bq, M); }
                LAS float* Mf = (LAS float*)(sb + SL_BK);
                int rl = r, hl = h; asm volatile("" : "+v"(rl), "+v"(hl));
#pragma unroll
                for (int g = 0; g < 16; ++g) { const int tp = (g & 3) + 8 * (g >> 2) + 4 * hl, tt = tp & 15, ss = rl & 15; const bool keep = (tp < 16) ? (ss < tt) : (ss <= tt); Mf[tp * 32 + rl] = keep ? M[g] : 0.f; }
                asm volatile("s_waitcnt lgkmcnt(0)" ::: "memory");
                const int c = lane & 15, hc = (c >> 2) & 1, ec = ((c >> 3) & 1) * 4 + (c & 3); float x[16];
#pragma unroll
                for (int gq = 0; gq < 4; ++gq) { f32x4 mr[4][4];
#pragma unroll
                    for (int i = 0; i < 4; ++i)
#pragma unroll
                        for (int q4 = 0; q4 <= gq; ++q4) mr[i][q4] = *(const LAS f32x4*)(Mf + (4 * gq + i) * 32 + 4 * q4);
#pragma unroll
                    for (int i = 0; i < 4; ++i) { const int t = 4 * gq + i; float acc = (t == c) ? 1.f : 0.f;
#pragma unroll
                        for (int q4 = 0; q4 <= gq; ++q4)
#pragma unroll
                            for (int e = 0; e < 4; ++e) if (4 * q4 + e < t) acc += mr[i][q4][e] * x[4 * q4 + e];
                        x[t] = acc; if (lane < 16) *(LAS u16*)(sb + SL_T2 + (t * 2 + hc) * 16 + 2 * ec) = bfc(acc); } }
#pragma unroll
                for (int gq = 0; gq < 4; ++gq) { f32x4 mr[4][4];
#pragma unroll
                    for (int i = 0; i < 4; ++i)
#pragma unroll
                        for (int q4 = 0; q4 <= gq; ++q4) mr[i][q4] = *(const LAS f32x4*)(Mf + (16 + 4 * gq + i) * 32 + 4 * q4);
#pragma unroll
                    for (int i = 0; i < 4; ++i) { const int t = 4 * gq + i; float acc = 0.f;
#pragma unroll
                        for (int q4 = 0; q4 <= gq; ++q4)
#pragma unroll
                            for (int e = 0; e < 4; ++e) if (4 * q4 + e <= t) acc += mr[i][q4][e] * x[4 * q4 + e];
                        if (lane < 16) *(LAS u16*)(sb + SL_T2 + ((16 + t) * 2 + hc) * 16 + 2 * ec) = bfc(acc); } }
                {   const f32x4 m0 = *(const LAS f32x4*)(Mf + r * 32 + 16 + 4 * h), m1 = *(const LAS f32x4*)(Mf + r * 32 + 24 + 4 * h);
                    u32x4 w; w.x = pkc(m0.x, m0.y); w.y = pkc(m0.z, m0.w); w.z = pkc(m1.x, m1.y); w.w = pkc(m1.z, m1.w);
                    *(LAS u32x4*)(sb + SL_MK + (r * 2 + h) * 16) = w; }
            }
            SC_BAR();
            if (wave < 2) { const int ib = wave;
                if (nroles == 2 && bt > 0) {
                    unsigned* fl = hflag + (u * 2 + ib) * 16;
                    while (__hip_atomic_load(fl, __ATOMIC_RELAXED, __HIP_MEMORY_SCOPE_AGENT) < (unsigned)bt) __builtin_amdgcn_s_sleep(1);
                    const unsigned* sl = (const unsigned*)(hslot + (size_t)((u * 2 + ib) * 2 + (role ^ 1)) * 2048);
#pragma unroll
                    for (int g = 0; g < 16; ++g) { X0[g] = __uint_as_float(__hip_atomic_load(sl + g * 64 + lane, __ATOMIC_RELAXED, __HIP_MEMORY_SCOPE_AGENT)); X1[g] = __uint_as_float(__hip_atomic_load(sl + 1024 + g * 64 + lane, __ATOMIC_RELAXED, __HIP_MEMORY_SCOPE_AGENT)); } }
                for (int c2 = 0; c2 < 8; ++c2) { LAS unsigned char* s2 = lds + c2 * SL_SIZE;
                    const bf16x8 vfrag = *(const LAS bf16x8*)(s2 + SL_VT + (ib * 32 + r) * 32 + h * 16), mk = *(const LAS bf16x8*)(s2 + SL_MK + (r * 2 + h) * 16);
                    f32x16 out;
#pragma unroll
                    for (int g = 0; g < 16; ++g) out[g] = 0.f;
                    out = MFMA32(mk, vfrag, out);
                    out = MFMA32(*(const LAS bf16x8*)(s2 + SL_AR + 0 * SL_QS + r * 32 + h * 16), pack_lo(X0), out);
                    out = MFMA32(*(const LAS bf16x8*)(s2 + SL_AR + 1 * SL_QS + r * 32 + h * 16), pack_hi(X0), out);
                    out = MFMA32(*(const LAS bf16x8*)(s2 + SL_AR + 2 * SL_QS + r * 32 + h * 16), pack_lo(X1), out);
                    out = MFMA32(*(const LAS bf16x8*)(s2 + SL_AR + 3 * SL_QS + r * 32 + h * 16), pack_hi(X1), out);
                    f32x16 sat;
#pragma unroll
                    for (int g = 0; g < 16; ++g) sat[g] = 0.f;
                    sat = MFMA32(*(const LAS bf16x8*)(s2 + SL_T2 + (r * 2 + h) * 16), pack_lo(out), sat);
                    LAS float* yb = (LAS float*)(s2 + SL_BK);
#pragma unroll
                    for (int e = 0; e < 8; ++e) { const int tm = 8 * (e >> 2) + 4 * h + (e & 3); yb[tm * 64 + ib * 32 + r] = out[8 + e] + sat[8 + e]; }
                    const bf16x8 sfrag = pack_lo(sat);
                    X0 = MFMA32(*(const LAS bf16x8*)(s2 + SL_KT + r * 32 + h * 16), vfrag, X0);
                    X1 = MFMA32(*(const LAS bf16x8*)(s2 + SL_KT + (32 + r) * 32 + h * 16), vfrag, X1);
                    X0 = MFMA32(*(const LAS bf16x8*)(s2 + SL_BT + r * 32 + h * 16), sfrag, X0);
                    X1 = MFMA32(*(const LAS bf16x8*)(s2 + SL_BT + (32 + r) * 32 + h * 16), sfrag, X1);
#pragma unroll
                    for (int q4 = 0; q4 < 4; ++q4) { const f32x4 w0 = *(const LAS f32x4*)(s2 + SL_WL + (8 * q4 + 4 * h) * 4), w1 = *(const LAS f32x4*)(s2 + SL_WL + (32 + 8 * q4 + 4 * h) * 4);
#pragma unroll
                        for (int e = 0; e < 4; ++e) { X0[4 * q4 + e] *= w0[e]; X1[4 * q4 + e] *= w1[e]; } } }
                if (nroles == 2 && bt + 1 < nbatch) {
                    unsigned* sl = (unsigned*)(hslot + (size_t)((u * 2 + ib) * 2 + role) * 2048);
#pragma unroll
                    for (int g = 0; g < 16; ++g) { __hip_atomic_store(sl + g * 64 + lane, __float_as_uint(X0[g]), __ATOMIC_RELAXED, __HIP_MEMORY_SCOPE_AGENT); __hip_atomic_store(sl + 1024 + g * 64 + lane, __float_as_uint(X1[g]), __ATOMIC_RELAXED, __HIP_MEMORY_SCOPE_AGENT); }
                    asm volatile("s_waitcnt vmcnt(0)" ::: "memory");
                    if (lane == 0) __hip_atomic_store(hflag + (u * 2 + ib) * 16, (unsigned)(bt + 1), __ATOMIC_RELAXED, __HIP_MEMORY_SCOPE_AGENT); } }
            SC_BAR();
            int tf = tid; asm volatile("" : "+v"(tf));
#pragma unroll
            for (int k8 = 0; k8 < 8; ++k8) { const int idx = tf + 512 * k8, slot = idx >> 9, tm = (idx >> 5) & 15, cp = idx & 31; const int n = bt * 8 + slot;
                const int tl = z ? (T - 1 - (16 * n + tm)) : (16 * n + tm); unsigned* addr = (unsigned*)((char*)Y + (unsigned)((((int)seqbase + tl) * 1024 + hd * 64 + 2 * cp) * 2));
                const LAS float* yb = (const LAS float*)(lds + slot * SL_SIZE + SL_BK); *addr = pk2(yb[tm * 64 + 2 * cp], yb[tm * 64 + 2 * cp + 1]); }
            SC_BAR();
        }
#undef SC_LOAD
#undef SC_BAR
    }
}

enum { PH_PREP = 0, PH_L0_NORM, PH_L0_GEMM_IN, PH_L0_CONV_FFTA, PH_L0_GEMM_DFT, PH_L0_GEMM_OUT, PH_F0_NORM, PH_F0 = 7  , PH_L1 = 19  , PH_F1_NORM = 37, PH_F1 = 38  , PH_FINAL = 50, PH_COUNT = 51 };

__device__ __forceinline__ void ffn_phase(unsigned char* ws, unsigned char* ob, LAS unsigned char* lds, int l, int sub) {
    const int chunk = sub / 3, op = sub % 3;
    if (op == 0) { EpiPlain E{(u16*)(ws + OFF_U), 5632}; gemm_phase(lds, (const u16*)(ws + OFF_H) + (size_t)chunk * 16384 * 1024, 1024, (const u16*)(ws + OFF_WUP) + (size_t)l * 5632 * 1024, 1024, 64, 22, 1024, E); }
    else if (op == 1) act_phase(ws, ob, lds, l, chunk);
    else { EpiResid E{(u16*)(ws + OFF_X) + (size_t)chunk * 16384 * 1024}; gemm_phase(lds, (const u16*)(ob + OUT_ACT), 2816, (const u16*)(ws + OFF_WDN) + (size_t)l * 1024 * 2816, 2816, 64, 4, 2816, E); }
}

__global__ void __launch_bounds__(512, 2) mk_fwd(P p) {
    extern __shared__ __attribute__((aligned(16))) unsigned char smem[];
    LAS unsigned char* lds = (LAS unsigned char*)smem;
    if (threadIdx.x < 31) ((LAS unsigned long long*)(lds + LDS_TAB))[threadIdx.x] = (unsigned long long)p.in[threadIdx.x];
    if (threadIdx.x == 0) { volatile LAS unsigned* xst = (volatile LAS unsigned*)(lds + LDS_TAB + 256); xst[0] = 0u; xst[1] = 0u; xst[2] = 0u;
        (void)xb_add(&((unsigned*)(p.ws + OFF_BAR))[XB_XCNT(xb_xcc_id())], 1u); }
    __syncthreads();
    for (int ph = p.ph_lo; ph < p.ph_hi; ++ph) {
        size_t oz = 0; asm volatile("" : "+s"(oz));
        unsigned char* ws = p.ws + oz; unsigned char* ob = (unsigned char*)p.out + oz;
        if (TM(0) && ph == PH_PREP) { prep_phase(ws, ob, lds); __syncthreads(); norm0_phase(ws, ob, lds); }
        else if (ph == PH_L0_NORM) continue;
        else if (TM(2) && ph == PH_L0_GEMM_IN) {
            { EpiPlain E{(u16*)(ob + OUT_PROJ), 1536}; gemm_phase(lds, (const u16*)(ws + OFF_H), 1024, (const u16*)(ws + OFF_WC), 1024, 256, 6, 1024, E); }
            __syncthreads();
            { EpiPlain E{(u16*)(ob + OUT_FT), 65536}; gemm_phase(lds, (const u16*)(ws + OFF_WF), 1024, (const u16*)(ws + OFF_H), 1024, 2, 256, 1024, E); }
        }
        else if (TM(3) && ph == PH_L0_CONV_FFTA) { yconv_phase(ws, ob, lds); __syncthreads(); stageA_phase(ws, ob, lds); }
        else if (TM(4) && ph == PH_L0_GEMM_DFT) { EpiDft E{(u16*)(ws + OFF_CAT)}; gemm_phase(lds, (const u16*)(ws + OFF_DFTA), 512, (const u16*)(ws + OFF_YP), 512, 2, 512, 512, E); }
        else if (TM(5) && ph == PH_L0_GEMM_OUT) { EpiOut0 E{IN_G(0), IN_G(1), (u16*)(ws + OFF_X)}; gemm_phase(lds, (const u16*)(ws + OFF_CAT), 1536, (const u16*)(ws + OFF_WEFF), 1536, 256, 4, 1536, E); }
        else if (TM(6) && ph == PH_F0_NORM) normx_phase(ws, ob, IN(3), 0);
        else if (TM(7) && ph >= PH_F0 && ph < PH_F0 + 12) ffn_phase(ws, ob, lds, 0, ph - PH_F0);
        else if (TM(8) && ph >= PH_L1 && ph < PH_L1 + 18) { const int hf = (ph - PH_L1) / 9, op = (ph - PH_L1) % 9;
            if (TM(10) && op == 0) norm1_phase(ws, ob, lds, hf);
            else if (TM(11) && op == 1) {
                { EpiRkvP E{(u16*)(ob + OUT_RKV), (size_t)HT * 1024, (u16*)(ob + OUT_P)};
                    gemm_phase(lds, (const u16*)(ws + OFF_HH), 1024, (const u16*)(ws + OFF_WRKV), 1024, 128, 15, 1024, E, 2, (size_t)HT * 1024 * 2); }
            }
            else if (TM(12) && op == 2) lprep_phase(ws, ob, hf);
            else if (TM(13) && op == 3) { EpiUp2 E{(u16*)(ws + OFF_D4), IN(14), IN(17)}; gemm_phase(lds, (const u16*)(ws + OFF_L), 256, (const u16*)(ws + OFF_WUP2), 256, 128, 16, 256, E); }
            else if (TM(14) && op == 4) rwprep_phase(ws, ob, lds);
            else if (TM(15) && op == 5) scan_phase(ws, ob, lds, hf);
            else if (TM(16) && op == 6) { EpiPlain E{(u16*)(ws + OFF_G), 1024}; gemm_phase(lds, (const u16*)(ws + OFF_LG), 256, (const u16*)(ws + OFF_WG2), 256, 128, 4, 256, E); }
            else if (TM(17) && op == 7) gn_phase(ws, ob, lds);
            else if (TM(18)) { EpiResid E{(u16*)(ws + OFF_X) + (size_t)hf * HT * 1024}; gemm_phase(lds, (const u16*)(ws + OFF_YG), 1024, (const u16*)(ws + OFF_WO), 1024, 128, 4, 1024, E); }
        }
        else if (TM(6) && ph == PH_F1_NORM) normx_phase(ws, ob, IN(3) + 1024, 0);
        else if (TM(7) && ph >= PH_F1 && ph < PH_F1 + 12) ffn_phase(ws, ob, lds, 1, ph - PH_F1);
        else if (TM(9) && ph == PH_FINAL) normx_phase(ws, ob, IN(4), 1);
        if (ph + 1 < p.ph_hi) {
            if (p.ph_hi < 0) cg::this_grid().sync();
            grid_bar((unsigned*)(p.ws + OFF_BAR), (volatile LAS unsigned*)(lds + LDS_TAB + 256));
        }
    }
}

extern "C" void kernel_launch(void* const* d_in, const int* in_sizes, int n_in, void* d_out, int out_size, void* d_ws, size_t ws_size, hipStream_t stream) {
    static int grid = 0;
    if (grid == 0) {
        if (n_in != 31 || ws_size < WS_NEED || out_size != 65536 * 1024) { fprintf(stderr, "kernel_launch: unexpected shapes (n_in %d, ws %zu, out %d)\n", n_in, ws_size, out_size); grid = -1; return; }
        int dev = 0, cus = 0, per_cu = 0;
        hipGetDevice(&dev); hipDeviceGetAttribute(&cus, hipDeviceAttributeMultiprocessorCount, dev);
        if (hipFuncSetAttribute((const void*)mk_fwd, hipFuncAttributeMaxDynamicSharedMemorySize, LDS_BYTES) != hipSuccess) { fprintf(stderr, "kernel_launch: hipFuncSetAttribute failed\n"); grid = -1; return; }
        if (hipOccupancyMaxActiveBlocksPerMultiprocessor(&per_cu, (const void*)mk_fwd, 512, LDS_BYTES) != hipSuccess || per_cu < 1) { fprintf(stderr, "kernel_launch: occupancy query says %d\n", per_cu); per_cu = 1; }
        (void)hipGetLastError();
        grid = cus * per_cu;
    }
    if (grid < 0) return;
    if (hipMemsetAsync((unsigned char*)d_ws + OFF_BAR, 0, 16384 + 128 * 2 * 64, stream) != hipSuccess) { fprintf(stderr, "kernel_launch: memset failed\n"); return; }
    P p{};
    for (int i = 0; i < 31; ++i) p.in[i] = (const float*)d_in[i];
    p.out = (float*)d_out; p.ws = (unsigned char*)d_ws;
#if MK_PER_PHASE
    for (int ph = 0; ph < PH_COUNT; ++ph) { p.ph_lo = ph; p.ph_hi = ph + 1; hipLaunchKernelGGL(mk_fwd, dim3(grid), dim3(512), LDS_BYTES, stream, p); }
#else
    p.ph_lo = 0; p.ph_hi = PH_COUNT;
    void* args[] = {&p};
    hipError_t e = hipLaunchCooperativeKernel((const void*)mk_fwd, dim3(grid), dim3(512), args, LDS_BYTES, stream);
    if (e != hipSuccess) fprintf(stderr, "kernel_launch: cooperative launch failed: %s (grid %d)\n", hipGetErrorString(e), grid);
#endif
}
```
